# Optimizing an MI355X kernel written in HIP

```python
import jax, jax.numpy as jnp
from jax import lax
import numpy as np

D_MODEL = 1024
BATCH = 32
SEQ = 2048
DEPTH = 4

GRID_W = 64
CTX_LEN = 256
N_MIXERS = 3
N_MOD = 6
EPS = 1e-6
RET_HEADS = 4
RET_DK = D_MODEL // RET_HEADS
RET_DV = 2 * RET_DK
RET_CHUNK = 128
ROPE_BASE = 10000.0
LRU_WIDTH = (4 * D_MODEL // 3) // 128 * 128
LRU_BLOCKS = 8
LRU_BS = LRU_WIDTH // LRU_BLOCKS
LRU_CONV = 4
LRU_C = 8.0
NA_HEADS = 16
NA_HD = D_MODEL // NA_HEADS
NA_KH = 8
NA_KW = 16
FFN_DIM = (8 * D_MODEL // 3 + 127) // 128 * 128
FFN_CONV = 3

kernel_name = 'hybrid_dit_retention_rglru_natten'


def rmsnorm(x, gain):
    x32 = x.astype(jnp.float32)
    y = x32 * lax.rsqrt(jnp.mean(jnp.square(x32), axis=-1, keepdims=True) + EPS)
    return (y * gain.astype(jnp.float32)).astype(x.dtype)


def modulate(h, shift, scale):
    return h * (1.0 + scale) + shift


def flip(t):
    return t[:, ::-1]


def dwconv(x, w, b, left):
    k_w, n = w.shape[0], x.shape[1]
    xp = jnp.pad(x, ((0, 0), (left, k_w - 1 - left), (0, 0)))
    out = b
    for k in range(k_w):
        out = out + xp[:, k:k + n] * w[k]
    return out


def rope_2d(x):
    n, d = x.shape[1], x.shape[-1]
    t = jnp.arange(n)
    half = d // 2
    freqs = ROPE_BASE ** (-jnp.arange(0, half, 2, dtype=jnp.float32) / half)

    def rot(xa, pos):
        ang = pos.astype(jnp.float32)[:, None] * freqs
        cos = jnp.cos(ang)[None, :, None, :].astype(x.dtype)
        sin = jnp.sin(ang)[None, :, None, :].astype(x.dtype)
        x1, x2 = jnp.split(xa, 2, axis=-1)
        return jnp.concatenate([x1 * cos - x2 * sin, x1 * sin + x2 * cos], axis=-1)

    return jnp.concatenate([rot(x[..., :half], t // GRID_W), rot(x[..., half:], t % GRID_W)], axis=-1)


def head_groupnorm(y, gain):
    b, n, h, dv = y.shape
    y32 = y.astype(jnp.float32)
    mu = jnp.mean(y32, axis=-1, keepdims=True)
    var = jnp.mean(jnp.square(y32 - mu), axis=-1, keepdims=True)
    yn = ((y32 - mu) * lax.rsqrt(var + EPS)).reshape(b, n, h * dv)
    return (yn * gain.astype(jnp.float32)).astype(y.dtype)


def retention_scan(q, k, v, log_gamma, s0):
    b, n, h, _ = q.shape
    dv = v.shape[-1]
    ch = RET_CHUNK
    nc = n // ch

    def chunks(t):
        return t.reshape(b, nc, ch, h, t.shape[-1]).transpose(1, 0, 3, 2, 4)

    idx = jnp.arange(ch, dtype=jnp.float32)
    lg = log_gamma.astype(jnp.float32)
    diff = idx[:, None] - idx[None, :]
    dmat = jnp.where(diff >= 0, jnp.exp(lg[:, None, None] * jnp.maximum(diff, 0.0)), 0.0).astype(q.dtype)
    xi = jnp.exp(lg[:, None] * (idx + 1.0))[..., None].astype(q.dtype)
    zeta = jnp.exp(lg[:, None] * (ch - 1.0 - idx))[..., None].astype(q.dtype)
    g_chunk = jnp.exp(lg * ch)[:, None, None].astype(q.dtype)

    def step(state, qkv):
        qc, kc, vc = qkv
        inner = jnp.einsum('bhid,bhjd->bhij', qc, kc) * dmat
        y = jnp.einsum('bhij,bhjv->bhiv', inner, vc) + jnp.einsum('bhid,bhdv->bhiv', qc, state) * xi
        state = state * g_chunk + jnp.einsum('bhjd,bhjv->bhdv', kc * zeta, vc)
        return state, y

    s_fin, ys = lax.scan(step, s0, (chunks(q), chunks(k), chunks(v)))
    return ys.transpose(1, 0, 3, 2, 4).reshape(b, n, h, dv), s_fin


def retention_mixer(h_c, h_l, w_in, logit_decay, gn, w_out, need_ctx):
    b = h_l.shape[0]
    qk_w = RET_HEADS * RET_DK
    split_at = [qk_w, 2 * qk_w, 2 * qk_w + RET_HEADS * RET_DV]

    def project(h, rotate):
        n = h.shape[1]
        q, k, v, g = jnp.split(h @ w_in, split_at, axis=-1)
        q = q.reshape(b, n, RET_HEADS, RET_DK)
        k = k.reshape(b, n, RET_HEADS, RET_DK) * (RET_DK ** -0.5)
        v = v.reshape(b, n, RET_HEADS, RET_DV)
        if rotate:
            q, k = rope_2d(q), rope_2d(k)
        return q, k, v, g

    log_gamma = jax.nn.log_sigmoid(logit_decay.astype(jnp.float32))
    qc, kc, vc, gc = project(h_c, False)
    ql, kl, vl, gl = project(h_l, True)
    s0 = jnp.zeros((b, RET_HEADS, RET_DK, RET_DV), h_l.dtype)
    yc_f, sc_f = retention_scan(qc, kc, vc, log_gamma[0], s0)
    yc_b, sc_b = retention_scan(flip(qc), flip(kc), flip(vc), log_gamma[1], s0)
    yl_f, _ = retention_scan(ql, kl, vl, log_gamma[0], sc_f)
    yl_b, _ = retention_scan(flip(ql), flip(kl), flip(vl), log_gamma[1], sc_b)

    def readout(y, g):
        return (jax.nn.silu(g) * head_groupnorm(y, gn)) @ w_out

    out_l = readout(yl_f + flip(yl_b), gl)
    out_c = readout(yc_f + flip(yc_b), gc) if need_ctx else None
    return out_c, out_l


def _affine_combine(left, right):
    a_l, b_l = left
    a_r, b_r = right
    return a_l * a_r, a_r * b_l + b_r


def rglru_scan(x, gate_w, gate_b, lam, h0):
    b, n, w = x.shape
    xb = x.reshape(b, n, LRU_BLOCKS, LRU_BS)
    gates = jnp.einsum('bnkc,gkcd->gbnkd', xb, gate_w).reshape(2, b, n, w) + gate_b[:, None, None, :]
    r, i = jax.nn.sigmoid(gates[0]), jax.nn.sigmoid(gates[1])
    log_a = -LRU_C * r * jax.nn.softplus(-lam)
    a = jnp.exp(log_a)
    u = jnp.sqrt(-jnp.expm1(2.0 * log_a)) * (i * x)
    a_cum, h_part = lax.associative_scan(_affine_combine, (a, u), axis=1)
    return a_cum * h0[:, None, :] + h_part


def lru_mixer(h_c, h_l, w_in, conv_w, conv_b, gate_w, gate_b, lam, w_out, need_ctx):
    def branches(h):
        y_br, x_br = jnp.split(h @ w_in, 2, axis=-1)
        return y_br, dwconv(x_br, conv_w, conv_b, LRU_CONV // 2)

    yc, xc = branches(h_c)
    yl, xl = branches(h_l)
    h0 = jnp.zeros((h_l.shape[0], LRU_WIDTH), h_l.dtype)
    hc_f = rglru_scan(xc, gate_w[0], gate_b[0], lam[0], h0)
    hc_b = flip(rglru_scan(flip(xc), gate_w[1], gate_b[1], lam[1], h0))
    hl_f = rglru_scan(xl, gate_w[0], gate_b[0], lam[0], hc_f[:, -1])
    hl_b = flip(rglru_scan(flip(xl), gate_w[1], gate_b[1], lam[1], hc_b[:, 0]))

    def readout(hf, hb, y_br):
        return ((hf + hb) * jax.nn.gelu(y_br)) @ w_out

    out_l = readout(hl_f, hl_b, yl)
    out_c = readout(hc_f, hc_b, yc) if need_ctx else None
    return out_c, out_l


def na_mixer(h_c, h_l, w_qkv, rpb, w_out, need_ctx):
    b, n, _ = h_l.shape
    rows = n // GRID_W
    kh, kw = min(NA_KH, rows), NA_KW
    scale = NA_HD ** -0.5

    def heads(h):
        return [t.reshape(b, h.shape[1], NA_HEADS, NA_HD) for t in jnp.split(h @ w_qkv, 3, axis=-1)]

    qc, kc, vc = heads(h_c)
    ql, kl, vl = heads(h_l)
    k_grid = kl.reshape(b, rows, GRID_W, NA_HEADS, NA_HD)
    v_grid = vl.reshape(b, rows, GRID_W, NA_HEADS, NA_HD)
    q_rows = ql.reshape(b, rows, GRID_W, NA_HEADS, NA_HD).transpose(1, 0, 2, 3, 4)

    col = jnp.arange(GRID_W)
    col_start = jnp.clip(col - kw // 2, 0, GRID_W - kw)
    col_in = (col[None, :] >= col_start[:, None]) & (col[None, :] < col_start[:, None] + kw)
    dc_idx = jnp.clip(col[None, :] - col[:, None], -(kw - 1), kw - 1) + (kw - 1)
    rpb32 = rpb.astype(jnp.float32)

    def row_block(args):
        r, q_r = args
        start = jnp.clip(r - kh // 2, 0, rows - kh)
        k_blk = lax.dynamic_slice_in_dim(k_grid, start, kh, axis=1)
        v_blk = lax.dynamic_slice_in_dim(v_grid, start, kh, axis=1)
        dr_idx = start + jnp.arange(kh) - r + (NA_KH - 1)
        bias = rpb32[:, dr_idx][:, :, dc_idx]
        bias = jnp.where(col_in[None, None], bias, -jnp.inf).transpose(0, 2, 1, 3)
        s_lat = jnp.einsum('bqhd,bkwhd->bhqkw', q_r, k_blk).astype(jnp.float32) * scale + bias
        s_ctx = jnp.einsum('bqhd,bkhd->bhqk', q_r, kc).astype(jnp.float32) * scale
        s = jnp.concatenate([s_lat.reshape(b, NA_HEADS, GRID_W, kh * GRID_W), s_ctx], axis=-1)
        p = jax.nn.softmax(s, axis=-1).astype(q_r.dtype)
        p_lat = p[..., :kh * GRID_W].reshape(b, NA_HEADS, GRID_W, kh, GRID_W)
        p_ctx = p[..., kh * GRID_W:]
        return (jnp.einsum('bhqkw,bkwhd->bqhd', p_lat, v_blk)
                + jnp.einsum('bhqk,bkhd->bqhd', p_ctx, vc))

    o = lax.map(row_block, (jnp.arange(rows), q_rows))
    out_l = o.transpose(1, 0, 2, 3, 4).reshape(b, n, D_MODEL) @ w_out
    out_c = None
    if need_ctx:
        s = jnp.einsum('bqhd,bkhd->bhqk', qc, kc).astype(jnp.float32) * scale
        p = jax.nn.softmax(s, axis=-1).astype(vc.dtype)
        out_c = jnp.einsum('bhqk,bkhd->bqhd', p, vc).reshape(b, h_c.shape[1], D_MODEL) @ w_out
    return out_c, out_l


def conv_ffn(h, w_up, conv_w, conv_b, w_down):
    u = dwconv(h @ w_up, conv_w, conv_b, FFN_CONV // 2)
    g, v = jnp.split(u, 2, axis=-1)
    return (jax.nn.silu(g) * v) @ w_down


def setup_inputs(seed: int = 0) -> dict:
    key = jax.random.key(seed)
    ks = iter(jax.random.split(key, 40))
    f32 = jnp.float32

    def nrm(shape, scale):
        return jax.random.normal(next(ks), shape, f32) * scale

    n_ret = len(range(0, DEPTH, N_MIXERS))
    n_lru = len(range(1, DEPTH, N_MIXERS))
    n_na = len(range(2, DEPTH, N_MIXERS))
    ret_logit0 = jnp.asarray(np.log(2.0 ** (5.0 + np.arange(RET_HEADS)) - 1.0), f32)
    a0 = jax.random.uniform(next(ks), (n_lru, 2, LRU_WIDTH), f32, 0.9, 0.999)
    return {
        'x': nrm((BATCH, SEQ, D_MODEL), 1.0),
        'c': nrm((BATCH, D_MODEL), 1.0),
        'ctx': nrm((BATCH, CTX_LEN, D_MODEL), 1.0),
        'c_ctx': nrm((D_MODEL,), 1.0),
        'ada_w': nrm((DEPTH, D_MODEL, N_MOD * D_MODEL), 0.5 * D_MODEL ** -0.5),
        'ada_b': nrm((DEPTH, N_MOD * D_MODEL), 0.02),
        'norm_mix': 1.0 + nrm((DEPTH, D_MODEL), 0.05),
        'norm_ffn': 1.0 + nrm((DEPTH, D_MODEL), 0.05),
        'ffn_w_up': nrm((DEPTH, D_MODEL, 2 * FFN_DIM), D_MODEL ** -0.5),
        'ffn_conv_w': nrm((DEPTH, FFN_CONV, 2 * FFN_DIM), FFN_CONV ** -0.5),
        'ffn_conv_b': nrm((DEPTH, 2 * FFN_DIM), 0.02),
        'ffn_w_down': nrm((DEPTH, FFN_DIM, D_MODEL), FFN_DIM ** -0.5),
        'ret_w_in': nrm((n_ret, D_MODEL, 2 * RET_HEADS * RET_DK + 2 * RET_HEADS * RET_DV), D_MODEL ** -0.5),
        'ret_logit_decay': ret_logit0 + nrm((n_ret, 2, RET_HEADS), 0.1),
        'ret_gn': 1.0 + nrm((n_ret, RET_HEADS * RET_DV), 0.05),
        'ret_w_out': nrm((n_ret, RET_HEADS * RET_DV, D_MODEL), (RET_HEADS * RET_DV) ** -0.5),
        'lru_w_in': nrm((n_lru, D_MODEL, 2 * LRU_WIDTH), D_MODEL ** -0.5),
        'lru_conv_w': nrm((n_lru, LRU_CONV, LRU_WIDTH), LRU_CONV ** -0.5),
        'lru_conv_b': nrm((n_lru, LRU_WIDTH), 0.02),
        'lru_gate_w': nrm((n_lru, 2, 2, LRU_BLOCKS, LRU_BS, LRU_BS), LRU_BS ** -0.5),
        'lru_gate_b': nrm((n_lru, 2, 2, LRU_WIDTH), 0.02),
        'lru_lambda': jnp.log(a0 / (1.0 - a0)),
        'lru_w_out': nrm((n_lru, LRU_WIDTH, D_MODEL), LRU_WIDTH ** -0.5),
        'na_w_qkv': nrm((n_na, D_MODEL, 3 * D_MODEL), D_MODEL ** -0.5),
        'na_rpb': nrm((n_na, NA_HEADS, 2 * NA_KH - 1, 2 * NA_KW - 1), 0.05),
        'na_w_out': nrm((n_na, D_MODEL, D_MODEL), D_MODEL ** -0.5),
        'final_norm': 1.0 + nrm((D_MODEL,), 0.05),
    }


def reference(x, c, ctx, c_ctx, ada_w, ada_b, norm_mix, norm_ffn, ffn_w_up, ffn_conv_w, ffn_conv_b,
              ffn_w_down, ret_w_in, ret_logit_decay, ret_gn, ret_w_out, lru_w_in, lru_conv_w, lru_conv_b,
              lru_gate_w, lru_gate_b, lru_lambda, lru_w_out, na_w_qkv, na_rpb, na_w_out, final_norm):
    silu_c = jax.nn.silu(c)
    silu_cc = jax.nn.silu(c_ctx)
    for i in range(DEPTH):
        need_ctx = i < DEPTH - 1
        kind, j = i % N_MIXERS, i // N_MIXERS
        mod_l = (silu_c @ ada_w[i] + ada_b[i])[:, None, :]
        mod_c = silu_cc @ ada_w[i] + ada_b[i]
        sh1, sc1, g1, sh2, sc2, g2 = jnp.split(mod_l, N_MOD, axis=-1)
        csh1, csc1, cg1, csh2, csc2, cg2 = jnp.split(mod_c, N_MOD, axis=-1)

        h_l = modulate(rmsnorm(x, norm_mix[i]), sh1, sc1)
        h_c = modulate(rmsnorm(ctx, norm_mix[i]), csh1, csc1)
        if kind == 0:
            out_c, out_l = retention_mixer(h_c, h_l, ret_w_in[j], ret_logit_decay[j], ret_gn[j],
                                           ret_w_out[j], need_ctx)
        elif kind == 1:
            out_c, out_l = lru_mixer(h_c, h_l, lru_w_in[j], lru_conv_w[j], lru_conv_b[j], lru_gate_w[j],
                                     lru_gate_b[j], lru_lambda[j], lru_w_out[j], need_ctx)
        else:
            out_c, out_l = na_mixer(h_c, h_l, na_w_qkv[j], na_rpb[j], na_w_out[j], need_ctx)
        x = x + g1 * out_l
        if need_ctx:
            ctx = ctx + cg1 * out_c

        x = x + g2 * conv_ffn(modulate(rmsnorm(x, norm_ffn[i]), sh2, sc2),
                              ffn_w_up[i], ffn_conv_w[i], ffn_conv_b[i], ffn_w_down[i])
        if need_ctx:
            ctx = ctx + cg2 * conv_ffn(modulate(rmsnorm(ctx, norm_ffn[i]), csh2, csc2),
                                       ffn_w_up[i], ffn_conv_w[i], ffn_conv_b[i], ffn_w_down[i])
    return rmsnorm(x, final_norm)
```

```cpp
#include <hip/hip_runtime.h>
#include <cstdio>
#include <cstdint>

#ifndef DBG
#define DBG 0
#endif
#ifndef ONLY
#define ONLY 0
#endif
#define EN(k) (ONLY == 0 || ONLY == (k))
#ifndef DUP
#define DUP 0
#endif

#define GAS __attribute__((address_space(1)))
#define LAS __attribute__((address_space(3)))
typedef unsigned short bf16;
typedef short bf16x8 __attribute__((ext_vector_type(8)));
typedef float f32x4 __attribute__((ext_vector_type(4)));
typedef float f32x2 __attribute__((ext_vector_type(2)));
typedef unsigned u32x4 __attribute__((ext_vector_type(4)));
typedef unsigned u32x2 __attribute__((ext_vector_type(2)));
typedef GAS unsigned gu32;

__device__ __forceinline__ int lane_id() { unsigned m = ~0u; asm volatile("" : "+s"(m)); return (int)__builtin_amdgcn_mbcnt_hi(m, __builtin_amdgcn_mbcnt_lo(m, 0u)); }
namespace pg8 {
#define PG8_LAS __attribute__((address_space(3)))
typedef unsigned short bf16_t;
constexpr int BM = 256, BK = 64, HALF = 128, HTB = HALF * BK * 2, STAGE_BYTES = 8 * HTB, NXCD = 8, WGM = 8;
__host__ __device__ __forceinline__ int lds_byte(int r, int c) { const int st = (r >> 4) * 2 + (c >> 5), rr = r & 15, cc = c & 31, ob = rr * 64 + cc * 2; return st * 1024 + (ob ^ (((ob >> 9) & 1) << 5)); }
__host__ __device__ __forceinline__ void stage_rc(int b, int& R, int& C) { const int st = b / 1024, sb = b % 1024, swz = sb ^ (((sb >> 9) & 1) << 5); R = (st >> 1) * 16 + swz / 64; C = (st & 1) * 32 + (swz % 64) / 2; }
__host__ __device__ __forceinline__ int perm32(int rho) { const int n = rho >> 4, i = rho & 15; return 8 * (i >> 2) + 4 * n + (i & 3); }
struct Unit { int pm, pn; };
struct Gemm { const bf16_t* A; const bf16_t* Bt; int M, N, K; };
struct StaticOrder {
    int nM, nN, nwg, G, c;
    __host__ __device__ __forceinline__ void init(int M, int N, int G_, int c_, int lat_ = 0) { nM = M / BM; if (lat_) nM = nM / 9 * 8; nN = N / BM; nwg = nM * nN; G = G_; c = c_; if (lat_) nN = -nN; }
    __host__ __device__ __forceinline__ bool next(int i, Unit& u) const {
        const long L = (long)i * G + c; if (L >= nwg) return false;
        const int nn = nN < 0 ? -nN : nN;
        int wgid = (int)L; { const int q = nwg / NXCD, r = nwg % NXCD, xcd = wgid % NXCD, off = wgid / NXCD; wgid = (xcd < r ? xcd * (q + 1) : r * (q + 1) + (xcd - r) * q) + off; }
        const int nig = WGM * nn, gid = wgid / nig, fm = gid * WGM, gsz = (nM - fm) < WGM ? (nM - fm) : WGM;
        u.pm = fm + ((wgid % nig) % gsz); u.pn = (wgid % nig) / gsz; if (nN < 0) u.pm += (u.pm >> 3) + 1; return true;
    }
    __device__ __forceinline__ void a_ready(const Unit&) const {}
    __device__ __forceinline__ void done(const Unit&) const {}
};
__device__ __forceinline__ unsigned cvt_pk_bf16(float lo, float hi) { unsigned r; asm volatile("v_cvt_pk_bf16_f32 %0, %1, %2" : "=v"(r) : "v"(lo), "v"(hi)); return r; }

struct EpiBf16 {
    static constexpr bool PERM = true, AFTER_DRAIN = false;
    bf16_t* O; int ldc;
    __device__ __forceinline__ f32x2 pre(const Unit&, int, int) const { return (f32x2){0.f, 0.f}; }
    __device__ __forceinline__ void operator()(const f32x4 (&acc)[2][2][4][2], const Unit& u, int wr, int wc, int fr_, int fq_, f32x2) const {
        int fr = fr_, fq = fq_; asm volatile("" : "+v"(fr), "+v"(fq));
        const int row0 = u.pm * BM + wr * 64 + fr; const int col0 = u.pn * BM + wc * 32 + 8 * fq;
#pragma unroll
        for (int ai = 0; ai < 2; ++ai)
#pragma unroll
            for (int m = 0; m < 4; ++m) { bf16_t* rowp = O + (size_t)(row0 + ai * HALF + m * 16) * ldc + col0;
#pragma unroll
                for (int bj = 0; bj < 2; ++bj) { const f32x4 v0 = acc[ai][bj][m][0], v1 = acc[ai][bj][m][1];
                    u32x4 w; w.x = cvt_pk_bf16(v0[0], v0[1]); w.y = cvt_pk_bf16(v0[2], v0[3]); w.z = cvt_pk_bf16(v1[0], v1[1]); w.w = cvt_pk_bf16(v1[2], v1[3]);
                    *(u32x4*)(rowp + bj * HALF) = w; } }
    }
};
constexpr int NSLOT_BYTES = 5120;
__device__ __forceinline__ void norm_pre(const float* stat, const float* T, int ldt, int tok_tile, int feat_tile, PG8_LAS unsigned char* nl, int tid_, int slot) {
    int tid = tid_; asm volatile("" : "+v"(tid));
    const int wv = __builtin_amdgcn_readfirstlane(tid >> 6), lane = tid & 63;
    const int mr = (tok_tile % 9 == 0) ? 32 : tok_tile / 9;
    if (wv < 4) __builtin_amdgcn_global_load_lds((const unsigned*)(stat + ((size_t)tok_tile * 256 + wv * 64 + lane) * 4), (PG8_LAS unsigned*)(nl + slot * NSLOT_BYTES + wv * 1024), 16, 0, 0);
    else if (wv == 4) __builtin_amdgcn_global_load_lds((const unsigned*)(T + (size_t)mr * ldt + feat_tile * 256 + lane * 4), (PG8_LAS unsigned*)(nl + slot * NSLOT_BYTES + 4096), 16, 0, 0);
}
__device__ __forceinline__ float norm_rstd(const PG8_LAS float* NL, int tok) { const f32x4 p = *(const PG8_LAS f32x4*)(NL + tok * 4); return __builtin_amdgcn_rsqf(((p.x + p.y) + (p.z + p.w)) * (1.f / 1024.f) + 1e-6f); }
template <bool NORM>
struct EpiRopeQ {
    static constexpr bool PERM = true, AFTER_DRAIN = false;
    bf16_t* O; const float* RT; const float* stat; const float* T; PG8_LAS unsigned char* nl; int tile0;
    __device__ __forceinline__ f32x2 pre(const Unit& u, int tid, int slot) const { if (NORM) norm_pre(stat, T, 4096, tile0 + u.pm, u.pn, nl, tid, slot); return (f32x2){__int_as_float(slot), 0.f}; }
    __device__ __forceinline__ void operator()(const f32x4 (&acc)[2][2][4][2], const Unit& u, int wr, int wc, int fr_, int fq_, f32x2 wpre) const {
        int fr = fr_, fq = fq_; asm volatile("" : "+v"(fr), "+v"(fq));
        const PG8_LAS float* NL = (const PG8_LAS float*)(nl + __builtin_amdgcn_readfirstlane(__float_as_int(wpre.x)) * NSLOT_BYTES);
        f32x4 tc[2][2];
#pragma unroll
        for (int bj = 0; bj < 2; ++bj)
#pragma unroll
            for (int n = 0; n < 2; ++n) tc[bj][n] = NORM ? *(const PG8_LAS f32x4*)(NL + 1024 + bj * HALF + wc * 32 + 8 * fq + 4 * n) : (f32x4){0.f, 0.f, 0.f, 0.f};
#define RQ_VAL(ai, bj, m, n, rs) (NORM ? acc[ai][bj][m][n] * (rs) + tc[bj][n] : acc[ai][bj][m][n])
        if (u.pn >= 8) {
            const int row0 = u.pm * BM + wr * 64 + fr; const int col0 = u.pn * BM + wc * 32 + 8 * fq;
#pragma unroll
            for (int ai = 0; ai < 2; ++ai)
#pragma unroll
                for (int m = 0; m < 4; ++m) { bf16_t* rowp = O + (size_t)(row0 + ai * HALF + m * 16) * 4096 + col0;
                    const float rs = NORM ? norm_rstd(NL, ai * HALF + wr * 64 + m * 16 + fr) : 1.f;
#pragma unroll
                    for (int bj = 0; bj < 2; ++bj) { const f32x4 v0 = RQ_VAL(ai, bj, m, 0, rs), v1 = RQ_VAL(ai, bj, m, 1, rs);
                        u32x4 w; w.x = cvt_pk_bf16(v0[0], v0[1]); w.y = cvt_pk_bf16(v0[2], v0[3]); w.z = cvt_pk_bf16(v1[0], v1[1]); w.w = cvt_pk_bf16(v1[2], v1[3]);
                        *(u32x4*)(rowp + bj * HALF) = w; } }
            return;
        }
        const int pt = u.pm % 9; const bool lat = pt != 0;
        const int hfj = wc >> 1, m0 = (32 * wc + 8 * fq) & 63;
#pragma unroll
        for (int ai = 0; ai < 2; ++ai)
#pragma unroll
            for (int m = 0; m < 4; ++m) { const int rl = ai * HALF + wr * 64 + m * 16 + fr;
                bf16_t* rowp = O + (size_t)(u.pm * BM + rl) * 4096 + u.pn * BM + 128 * hfj + m0;
                const float rs = NORM ? norm_rstd(NL, rl) : 1.f;
                f32x4 a0 = RQ_VAL(ai, 0, m, 0, rs), a1 = RQ_VAL(ai, 0, m, 1, rs), b0 = RQ_VAL(ai, 1, m, 0, rs), b1 = RQ_VAL(ai, 1, m, 1, rs);
                if (lat) { const int t = (pt - 1) * 256 + rl; const int pos = hfj == 0 ? (t >> 6) : (t & 63);
                    const float* cp = RT + 2 * (pos * 64 + m0);
                    const f32x4 c0 = *(const f32x4*)cp, c1 = *(const f32x4*)(cp + 4), c2 = *(const f32x4*)(cp + 8), c3 = *(const f32x4*)(cp + 12);
                    const f32x4 co0 = (f32x4){c0.x, c0.z, c1.x, c1.z}, si0 = (f32x4){c0.y, c0.w, c1.y, c1.w}, co1 = (f32x4){c2.x, c2.z, c3.x, c3.z}, si1 = (f32x4){c2.y, c2.w, c3.y, c3.w};
                    const f32x4 n0 = a0 * co0 - b0 * si0, n1 = a1 * co1 - b1 * si1; b0 = a0 * si0 + b0 * co0; b1 = a1 * si1 + b1 * co1; a0 = n0; a1 = n1; }
                u32x4 w; w.x = cvt_pk_bf16(a0[0], a0[1]); w.y = cvt_pk_bf16(a0[2], a0[3]); w.z = cvt_pk_bf16(a1[0], a1[1]); w.w = cvt_pk_bf16(a1[2], a1[3]);
                *(u32x4*)rowp = w;
                w.x = cvt_pk_bf16(b0[0], b0[1]); w.y = cvt_pk_bf16(b0[2], b0[3]); w.z = cvt_pk_bf16(b1[0], b1[1]); w.w = cvt_pk_bf16(b1[2], b1[3]);
                *(u32x4*)(rowp + 64) = w; }
#undef RQ_VAL
    }
};
template <bool NORM>
struct EpiRopeKT {
    static constexpr bool PERM = true, AFTER_DRAIN = false;
    bf16_t* O; const float* RT; int ldc; const float* stat; const float* T; PG8_LAS unsigned char* nl; int tile0;
    __device__ __forceinline__ f32x2 pre(const Unit& u, int tid, int slot) const { if (NORM) norm_pre(stat, T, 3072, tile0 + u.pn, u.pm, nl, tid, slot); return (f32x2){__int_as_float(slot), 0.f}; }
    __device__ __forceinline__ void operator()(const f32x4 (&acc)[2][2][4][2], const Unit& u, int wr, int wc, int fr_, int fq_, f32x2 wpre) const {
        int fr = fr_, fq = fq_; asm volatile("" : "+v"(fr), "+v"(fq));
        const PG8_LAS float* NL = (const PG8_LAS float*)(nl + __builtin_amdgcn_readfirstlane(__float_as_int(wpre.x)) * NSLOT_BYTES);
        f32x4 rc[2][2];
#pragma unroll
        for (int bj = 0; bj < 2; ++bj)
#pragma unroll
            for (int n = 0; n < 2; ++n) { const int cl = bj * HALF + wc * 32 + 8 * fq + 4 * n;
                rc[bj][n] = NORM ? (f32x4){norm_rstd(NL, cl), norm_rstd(NL, cl + 1), norm_rstd(NL, cl + 2), norm_rstd(NL, cl + 3)} : (f32x4){1.f, 1.f, 1.f, 1.f}; }
#define RK_VAL(ai, bj, m, n) (NORM ? acc[ai][bj][m][n] * rc[bj][n] + NL[1024 + (ai) * HALF + wr * 64 + (m) * 16 + fr] : acc[ai][bj][m][n])
        const int col0 = u.pn * BM + wc * 32 + 8 * fq;
        if (u.pm >= 4) {
            const int row0 = u.pm * BM + wr * 64 + fr;
#pragma unroll
            for (int ai = 0; ai < 2; ++ai)
#pragma unroll
                for (int m = 0; m < 4; ++m) { bf16_t* rowp = O + (size_t)(row0 + ai * HALF + m * 16) * ldc + col0;
#pragma unroll
                    for (int bj = 0; bj < 2; ++bj) { const f32x4 v0 = RK_VAL(ai, bj, m, 0), v1 = RK_VAL(ai, bj, m, 1);
                        u32x4 w; w.x = cvt_pk_bf16(v0[0], v0[1]); w.y = cvt_pk_bf16(v0[2], v0[3]); w.z = cvt_pk_bf16(v1[0], v1[1]); w.w = cvt_pk_bf16(v1[2], v1[3]);
                        *(u32x4*)(rowp + bj * HALF) = w; } }
            return;
        }
        const int pt = u.pn % 9; const bool lat = pt != 0;
#pragma unroll
        for (int m = 0; m < 4; ++m) { const int mi = m * 16 + fr;
            bf16_t* rowp = O + (size_t)(u.pm * BM + 128 * wr + mi) * ldc + col0;
#pragma unroll
            for (int bj = 0; bj < 2; ++bj) {
                f32x4 a0 = RK_VAL(0, bj, m, 0), a1 = RK_VAL(0, bj, m, 1), b0 = RK_VAL(1, bj, m, 0), b1 = RK_VAL(1, bj, m, 1);
                if (lat) { const int tb = (pt - 1) * 256 + bj * HALF + wc * 32 + 8 * fq;
                    f32x4 co0, si0, co1, si1;
                    if (wr == 0) { const f32x2 c = *(const f32x2*)(RT + 2 * ((tb >> 6) * 64 + mi)); co0 = (f32x4){c.x, c.x, c.x, c.x}; si0 = (f32x4){c.y, c.y, c.y, c.y}; co1 = co0; si1 = si0; }
                    else { const float* cp = RT + 2 * ((tb & 63) * 64 + mi);
#pragma unroll
                        for (int e = 0; e < 4; ++e) { const f32x2 c = *(const f32x2*)(cp + 128 * e), d = *(const f32x2*)(cp + 128 * (e + 4)); co0[e] = c.x; si0[e] = c.y; co1[e] = d.x; si1[e] = d.y; } }
                    const f32x4 n0 = a0 * co0 - b0 * si0, n1 = a1 * co1 - b1 * si1; b0 = a0 * si0 + b0 * co0; b1 = a1 * si1 + b1 * co1; a0 = n0; a1 = n1; }
                u32x4 w; w.x = cvt_pk_bf16(a0[0], a0[1]); w.y = cvt_pk_bf16(a0[2], a0[3]); w.z = cvt_pk_bf16(a1[0], a1[1]); w.w = cvt_pk_bf16(a1[2], a1[3]);
                *(u32x4*)(rowp + bj * HALF) = w;
                w.x = cvt_pk_bf16(b0[0], b0[1]); w.y = cvt_pk_bf16(b0[2], b0[3]); w.z = cvt_pk_bf16(b1[0], b1[1]); w.w = cvt_pk_bf16(b1[2], b1[3]);
                *(u32x4*)(rowp + (size_t)64 * ldc + bj * HALF) = w; } }
#undef RK_VAL
    }
};
template <bool SWAP>
struct EpiBf16N {
    static constexpr bool PERM = true, AFTER_DRAIN = false;
    bf16_t* O; int ldc; const float* stat; const float* T; int ldt; PG8_LAS unsigned char* nl; int tile0;
    __device__ __forceinline__ f32x2 pre(const Unit& u, int tid, int slot) const { norm_pre(stat, T, ldt, tile0 + (SWAP ? u.pn : u.pm), SWAP ? u.pm : u.pn, nl, tid, slot); return (f32x2){__int_as_float(slot), 0.f}; }
    __device__ __forceinline__ void operator()(const f32x4 (&acc)[2][2][4][2], const Unit& u, int wr, int wc, int fr_, int fq_, f32x2 wpre) const {
        int fr = fr_, fq = fq_; asm volatile("" : "+v"(fr), "+v"(fq));
        const PG8_LAS float* NL = (const PG8_LAS float*)(nl + __builtin_amdgcn_readfirstlane(__float_as_int(wpre.x)) * NSLOT_BYTES);
        const int row0 = u.pm * BM + wr * 64 + fr; const int col0 = u.pn * BM + wc * 32 + 8 * fq;
        f32x4 cv[2][2];
#pragma unroll
        for (int bj = 0; bj < 2; ++bj)
#pragma unroll
            for (int n = 0; n < 2; ++n) { const int cl = bj * HALF + wc * 32 + 8 * fq + 4 * n;
                if (!SWAP) cv[bj][n] = *(const PG8_LAS f32x4*)(NL + 1024 + cl);
                else cv[bj][n] = (f32x4){norm_rstd(NL, cl), norm_rstd(NL, cl + 1), norm_rstd(NL, cl + 2), norm_rstd(NL, cl + 3)}; }
#pragma unroll
        for (int ai = 0; ai < 2; ++ai)
#pragma unroll
            for (int m = 0; m < 4; ++m) { bf16_t* rowp = O + (size_t)(row0 + ai * HALF + m * 16) * ldc + col0;
                const int rl = ai * HALF + wr * 64 + m * 16 + fr;
                const float rv = SWAP ? NL[1024 + rl] : norm_rstd(NL, rl);
#pragma unroll
                for (int bj = 0; bj < 2; ++bj) { f32x4 v0, v1;
                    if (!SWAP) { v0 = acc[ai][bj][m][0] * rv + cv[bj][0]; v1 = acc[ai][bj][m][1] * rv + cv[bj][1]; }
                    else { v0 = acc[ai][bj][m][0] * cv[bj][0] + rv; v1 = acc[ai][bj][m][1] * cv[bj][1] + rv; }
                    u32x4 w; w.x = cvt_pk_bf16(v0[0], v0[1]); w.y = cvt_pk_bf16(v0[2], v0[3]); w.z = cvt_pk_bf16(v1[0], v1[1]); w.w = cvt_pk_bf16(v1[2], v1[3]);
                    *(u32x4*)(rowp + bj * HALF) = w; } }
    }
};
struct EpiResid {
    static constexpr bool PERM = true, AFTER_DRAIN = false;
    const void* src_x; const void* src_c; bf16_t* dst_x; bf16_t* dst_c; const float* modl; int goff; int b0; int f32src;
    bf16_t* Hn; bf16_t* Hn2; const float* ngain; const float* nmodl; int nscoff; float* stat; PG8_LAS unsigned char* eb;
    __device__ __forceinline__ f32x2 pre(const Unit&, int, int) const { return (f32x2){0.f, 0.f}; }
    __device__ __forceinline__ void operator()(const f32x4 (&acc)[2][2][4][2], const Unit& u, int wr, int wc, int fr_, int fq_, f32x2) const {
        int fr = fr_, fq = fq_; asm volatile("" : "+v"(fr), "+v"(fq));
        const int bl = u.pm / 9, pt = u.pm % 9, b = b0 + bl;
        const float* gate = modl + (size_t)(pt == 0 ? 32 : b) * 6144 + goff;
        const size_t rbase = pt == 0 ? (size_t)b * 256 : (size_t)b * 2048 + (size_t)(pt - 1) * 256;
        const void* s = pt == 0 ? src_c : src_x; bf16_t* d = pt == 0 ? dst_c : dst_x;
        const int r0 = wr * 64 + fr, col0 = u.pn * BM + wc * 32 + 8 * fq;
        f32x4 gv[2][2], cf[2][2];
        const bool dn = Hn != nullptr;
#pragma unroll
        for (int bj = 0; bj < 2; ++bj)
#pragma unroll
            for (int n = 0; n < 2; ++n) { gv[bj][n] = *(const f32x4*)(gate + col0 + bj * HALF + 4 * n);
                if (dn) { const float* nsc = nmodl + (size_t)(pt == 0 ? 32 : b) * 6144 + nscoff; cf[bj][n] = *(const f32x4*)(ngain + col0 + bj * HALF + 4 * n) * (*(const f32x4*)(nsc + col0 + bj * HALF + 4 * n) + 1.f); } }
        float ss[2][4];
#pragma unroll
        for (int ai = 0; ai < 2; ++ai)
#pragma unroll
            for (int m = 0; m < 4; ++m) ss[ai][m] = 0.f;
#pragma unroll
        for (int ai = 0; ai < 2; ++ai)
#pragma unroll
            for (int m = 0; m < 4; ++m) { const size_t off = (rbase + (size_t)(r0 + ai * HALF + m * 16)) * 1024 + col0;
#pragma unroll
                for (int bj = 0; bj < 2; ++bj) { f32x4 x0, x1;
                    if (f32src) { const float* sf = (const float*)s + off + bj * HALF; x0 = *(const f32x4*)sf; x1 = *(const f32x4*)(sf + 4); }
                    else { const u32x4 xv = *(const u32x4*)((const bf16_t*)s + off + bj * HALF);
                        x0 = (f32x4){__builtin_bit_cast(float, xv.x << 16), __builtin_bit_cast(float, xv.x & 0xffff0000u), __builtin_bit_cast(float, xv.y << 16), __builtin_bit_cast(float, xv.y & 0xffff0000u)};
                        x1 = (f32x4){__builtin_bit_cast(float, xv.z << 16), __builtin_bit_cast(float, xv.z & 0xffff0000u), __builtin_bit_cast(float, xv.w << 16), __builtin_bit_cast(float, xv.w & 0xffff0000u)}; }
                    const f32x4 o0 = x0 + gv[bj][0] * acc[ai][bj][m][0], o1 = x1 + gv[bj][1] * acc[ai][bj][m][1];
                    u32x4 w; w.x = cvt_pk_bf16(o0[0], o0[1]); w.y = cvt_pk_bf16(o0[2], o0[3]); w.z = cvt_pk_bf16(o1[0], o1[1]); w.w = cvt_pk_bf16(o1[2], o1[3]);
                    *(u32x4*)(d + off + bj * HALF) = w;
                    if (dn) {
                        const f32x4 y0 = (f32x4){__builtin_bit_cast(float, w.x << 16), __builtin_bit_cast(float, w.x & 0xffff0000u), __builtin_bit_cast(float, w.y << 16), __builtin_bit_cast(float, w.y & 0xffff0000u)};
                        const f32x4 y1 = (f32x4){__builtin_bit_cast(float, w.z << 16), __builtin_bit_cast(float, w.z & 0xffff0000u), __builtin_bit_cast(float, w.w << 16), __builtin_bit_cast(float, w.w & 0xffff0000u)};
                        ss[ai][m] += ((y0[0] * y0[0] + y0[1] * y0[1]) + (y0[2] * y0[2] + y0[3] * y0[3])) + ((y1[0] * y1[0] + y1[1] * y1[1]) + (y1[2] * y1[2] + y1[3] * y1[3]));
                        const f32x4 h0 = y0 * cf[bj][0], h1 = y1 * cf[bj][1];
                        u32x4 hw; hw.x = cvt_pk_bf16(h0[0], h0[1]); hw.y = cvt_pk_bf16(h0[2], h0[3]); hw.z = cvt_pk_bf16(h1[0], h1[1]); hw.w = cvt_pk_bf16(h1[2], h1[3]);
                        *(u32x4*)((u.pm < 144 ? Hn : Hn2) + ((size_t)u.pm * BM + (size_t)(r0 + ai * HALF + m * 16)) * 1024 + col0 + bj * HALF) = hw; }
                } }
        if (dn) {
            PG8_LAS float* ST = (PG8_LAS float*)eb;
            const int ln = fr + 16 * fq;
#pragma unroll
            for (int ai = 0; ai < 2; ++ai)
#pragma unroll
                for (int m = 0; m < 4; ++m) { float v = ss[ai][m];
                    v += __builtin_bit_cast(float, __builtin_amdgcn_ds_bpermute((ln ^ 16) << 2, __builtin_bit_cast(int, v)));
                    v += __builtin_bit_cast(float, __builtin_amdgcn_ds_bpermute((ln ^ 32) << 2, __builtin_bit_cast(int, v)));
                    if (fq == 0) ST[(ai * HALF + r0 + m * 16) * 4 + wc] = v; }
            asm volatile("s_waitcnt lgkmcnt(0)" ::: "memory"); __builtin_amdgcn_s_barrier(); asm volatile("" ::: "memory");
            const int t = (wr * 4 + wc) * 64 + ln;
            if (t < 256) { const f32x4 p = *(const PG8_LAS f32x4*)(ST + t * 4); stat[((size_t)u.pm * BM + t) * 4 + u.pn] = (p.x + p.y) + (p.z + p.w); }
        }
    }
};

__device__ __forceinline__ float dpp_prev(float x) { return __int_as_float(__builtin_amdgcn_update_dpp(__float_as_int(x), __float_as_int(x), 0x121, 0xf, 0xf, false)); }
__device__ __forceinline__ float dpp_next(float x) { return __int_as_float(__builtin_amdgcn_update_dpp(__float_as_int(x), __float_as_int(x), 0x12F, 0xf, 0xf, false)); }
__device__ __forceinline__ f32x4 rot_prev(f32x4 v) { f32x4 r; r.x = dpp_prev(v.x); r.y = dpp_prev(v.y); r.z = dpp_prev(v.z); r.w = dpp_prev(v.w); return r; }
__device__ __forceinline__ f32x4 rot_next(f32x4 v) { f32x4 r; r.x = dpp_next(v.x); r.y = dpp_next(v.y); r.z = dpp_next(v.z); r.w = dpp_next(v.w); return r; }
struct EpiConvGate {
    static constexpr bool PERM = true, AFTER_DRAIN = false;
    bf16_t* ACT; bf16_t* EDGE; const float* cw; const float* cb; PG8_LAS unsigned char* eb; PG8_LAS unsigned char* wl; const float* stat; const float* T; PG8_LAS unsigned char* nl;
    __device__ __forceinline__ f32x2 pre(const Unit& u, int tid, int slot) const { const int wv = __builtin_amdgcn_readfirstlane(tid >> 6), lane = tid & 63;
#pragma unroll
        for (int i = 0; i < 2; ++i) { const int idx = (2 * wv + i) * 64 + lane, k = idx >> 8, j = idx & 255, bj = j >> 7, jj = j & 127;
            const float* p = (k < 3 ? cw + k * 5632 : cb) + bj * 2816 + u.pn * 128 + jj;
            __builtin_amdgcn_global_load_lds((const unsigned*)p, (PG8_LAS unsigned*)(wl + slot * 4096 + (2 * wv + i) * 256), 4, 0, 0); }
        norm_pre(stat, T, 5632, u.pm, u.pn, nl, tid, slot);
        return (f32x2){__int_as_float(slot), 0.f}; }
    __device__ __forceinline__ void operator()(const f32x4 (&acc)[2][2][4][2], const Unit& u, int wr, int wc, int fr_, int fq_, f32x2 wpre) const {
        int fr = fr_, fq = fq_; asm volatile("" : "+v"(fr), "+v"(fq));
        const int slot = __builtin_amdgcn_readfirstlane(__float_as_int(wpre.x));
        PG8_LAS float* E = (PG8_LAS float*)eb; PG8_LAS float* WL = (PG8_LAS float*)(wl + slot * 4096); const PG8_LAS float* NL = (const PG8_LAS float*)(nl + slot * NSLOT_BYTES);
#define EB_IDX(wc_, wr_, ai_, wh_) (((((wc_) * 2 + (wr_)) * 2 + (ai_)) * 2 + (wh_)) * 64 + fq * 16)
        if (fr == 0) {
#pragma unroll
            for (int ai = 0; ai < 2; ++ai) { const float r = norm_rstd(NL, ai * HALF + wr * 64);
#pragma unroll
                for (int bj = 0; bj < 2; ++bj)
#pragma unroll
                    for (int n = 0; n < 2; ++n) *(PG8_LAS f32x4*)(E + EB_IDX(wc, wr, ai, 0) + bj * 8 + n * 4) = acc[ai][bj][0][n] * r; }
        }
        if (fr == 15) {
#pragma unroll
            for (int ai = 0; ai < 2; ++ai) { const float r = norm_rstd(NL, ai * HALF + wr * 64 + 63);
#pragma unroll
                for (int bj = 0; bj < 2; ++bj)
#pragma unroll
                    for (int n = 0; n < 2; ++n) *(PG8_LAS f32x4*)(E + EB_IDX(wc, wr, ai, 1) + bj * 8 + n * 4) = acc[ai][bj][3][n] * r; }
        }
        asm volatile("s_waitcnt lgkmcnt(0)" ::: "memory"); __builtin_amdgcn_s_barrier(); asm volatile("" ::: "memory");
        const f32x4 zero4 = (f32x4){0.f, 0.f, 0.f, 0.f};
        const int c8 = u.pn * 128 + wc * 32 + 8 * fq;
#pragma unroll
        for (int ai = 0; ai < 2; ++ai) {
            float rs[4];
#pragma unroll
            for (int m = 0; m < 4; ++m) rs[m] = norm_rstd(NL, ai * HALF + wr * 64 + m * 16 + fr);
            u32x2 actp[2][4];
#pragma unroll
            for (int n = 0; n < 2; ++n) {
                const int jc = wc * 32 + 8 * fq + 4 * n;
                f32x4 gt[4];
#pragma unroll
                for (int bj = 0; bj < 2; ++bj) {
                    f32x4 w[3];
#pragma unroll
                    for (int k = 0; k < 3; ++k) w[k] = *(const PG8_LAS f32x4*)(WL + k * 256 + bj * 128 + jc);
                    const f32x4 tq = *(const PG8_LAS f32x4*)(NL + 1024 + bj * 128 + jc);
                    const f32x4 bb = *(const PG8_LAS f32x4*)(WL + 3 * 256 + bj * 128 + jc) + tq * ((w[0] + w[1]) + w[2]);
                    f32x4 ep = zero4 - tq, en = zero4 - tq;
                    if (wr == 1) ep = *(const PG8_LAS f32x4*)(E + EB_IDX(wc, 0, ai, 1) + bj * 8 + n * 4);
                    else if (ai == 1) ep = *(const PG8_LAS f32x4*)(E + EB_IDX(wc, 1, 0, 1) + bj * 8 + n * 4);
                    if (wr == 0) en = *(const PG8_LAS f32x4*)(E + EB_IDX(wc, 1, ai, 0) + bj * 8 + n * 4);
                    else if (ai == 0) en = *(const PG8_LAS f32x4*)(E + EB_IDX(wc, 0, 1, 0) + bj * 8 + n * 4);
                    f32x4 a4[4];
#pragma unroll
                    for (int m = 0; m < 4; ++m) a4[m] = acc[ai][bj][m][n] * rs[m];
#pragma unroll
                    for (int m = 0; m < 4; ++m) {
                        f32x4 pv = rot_prev(m == 0 ? a4[0] : (fr == 15 ? a4[m - 1] : a4[m]));
                        f32x4 nv = rot_next(m == 3 ? a4[3] : (fr == 0 ? a4[m + 1] : a4[m]));
                        if (m == 0) pv = fr == 0 ? ep : pv;
                        if (m == 3) nv = fr == 15 ? en : nv;
                        const f32x4 uv = bb + w[0] * pv + w[1] * a4[m] + w[2] * nv;
                        if (bj == 0) {
#pragma unroll
                            for (int e = 0; e < 4; ++e) gt[m][e] = uv[e] * __builtin_amdgcn_rcpf(1.f + __builtin_amdgcn_exp2f(uv[e] * -1.4426950408889634f));
                        } else { const f32x4 o = gt[m] * uv; actp[n][m].x = cvt_pk_bf16(o[0], o[1]); actp[n][m].y = cvt_pk_bf16(o[2], o[3]); }
                    }
                }
            }
#pragma unroll
            for (int m = 0; m < 4; ++m) { const u32x4 pk = (u32x4){actp[0][m].x, actp[0][m].y, actp[1][m].x, actp[1][m].y};
                *(u32x4*)(ACT + (size_t)(u.pm * BM + ai * HALF + wr * 64 + m * 16 + fr) * 2816 + c8) = pk; }
        }
        if (wr == 0 && fr < 2) { const float r = norm_rstd(NL, fr);
#pragma unroll
            for (int bj = 0; bj < 2; ++bj) { const int jc = bj * 128 + wc * 32 + 8 * fq;
                const f32x4 v0 = acc[0][bj][0][0] * r + *(const PG8_LAS f32x4*)(NL + 1024 + jc), v1 = acc[0][bj][0][1] * r + *(const PG8_LAS f32x4*)(NL + 1024 + jc + 4);
                u32x4 pk; pk.x = cvt_pk_bf16(v0[0], v0[1]); pk.y = cvt_pk_bf16(v0[2], v0[3]); pk.z = cvt_pk_bf16(v1[0], v1[1]); pk.w = cvt_pk_bf16(v1[2], v1[3]);
                *(u32x4*)(EDGE + ((size_t)u.pm * 4 + fr) * 5632 + bj * 2816 + c8) = pk; }
        }
        if (wr == 1 && fr >= 14) { const float r = norm_rstd(NL, 240 + fr);
#pragma unroll
            for (int bj = 0; bj < 2; ++bj) { const int jc = bj * 128 + wc * 32 + 8 * fq;
                const f32x4 v0 = acc[1][bj][3][0] * r + *(const PG8_LAS f32x4*)(NL + 1024 + jc), v1 = acc[1][bj][3][1] * r + *(const PG8_LAS f32x4*)(NL + 1024 + jc + 4);
                u32x4 pk; pk.x = cvt_pk_bf16(v0[0], v0[1]); pk.y = cvt_pk_bf16(v0[2], v0[3]); pk.z = cvt_pk_bf16(v1[0], v1[1]); pk.w = cvt_pk_bf16(v1[2], v1[3]);
                *(u32x4*)(EDGE + ((size_t)u.pm * 4 + (fr - 12)) * 5632 + bj * 2816 + c8) = pk; }
        }
#undef EB_IDX
    }
};

template <class Epi, class Sched, bool ALIGN_EPI = false>
__device__ __forceinline__ void gemm_phase(PG8_LAS unsigned char* lds, const Gemm g, const Sched& S, const Epi& E, int wave_id) {
    int tid_ = wave_id * 64 + lane_id(); asm volatile("" : "+v"(tid_)); const int tid = tid_, wid = __builtin_amdgcn_readfirstlane(tid >> 6), lane = tid & 63, wr = wid >> 2, wc = wid & 3, fr = lane & 15, fq = lane >> 4;
    const int K = g.K, nt = K / BK;
    unsigned voffA[2], voffB[2];
#pragma unroll
    for (int i = 0; i < 2; ++i) { int R, C; stage_rc(tid * 16 + i * 8192, R, C); const int Rb = Epi::PERM ? ((R & ~31) + perm32(R & 31)) : R;
        voffA[i] = (unsigned)(R * K + C) * 2u; voffB[i] = (unsigned)(Rb * K + C) * 2u; }
    const size_t kstep = (size_t)(BK * 2);
    const size_t hstep = (size_t)HALF * K * 2;
    const size_t tstep = 2 * hstep;
    const unsigned ldsw = (unsigned)wid * 1024u;
    const int aoff = lds_byte(wr * 64 + fr, fq * 8), boff = lds_byte(wc * 32 + fr, fq * 8);
#define PG8_SA(b, h) (((b) * 2 + (h)) * HTB)
#define PG8_SB(b, h) ((4 + (b) * 2 + (h)) * HTB)
#define PG8_STAGE(bufoff, gbase, voff) do { _Pragma("unroll") for (int _i = 0; _i < 2; ++_i) \
        __builtin_amdgcn_global_load_lds((const unsigned*)((const char*)(gbase) + (voff)[_i]), (PG8_LAS unsigned*)(lds + (bufoff) + ldsw + _i * 8192), 16, 0, 0); } while (0)
#define PG8_LDA(dst, b, h) do { _Pragma("unroll") for (int m = 0; m < 4; ++m) _Pragma("unroll") for (int k = 0; k < 2; ++k) dst[m][k] = *(const PG8_LAS bf16x8*)(lds + PG8_SA(b, h) + aoff + m * 2048 + k * 1024); } while (0)
#define PG8_LDB(dst, b, h) do { _Pragma("unroll") for (int n = 0; n < 2; ++n) _Pragma("unroll") for (int k = 0; k < 2; ++k) dst[n][k] = *(const PG8_LAS bf16x8*)(lds + PG8_SB(b, h) + boff + n * 2048 + k * 1024); } while (0)
#define PG8_MMA(ai, bj, At, Bt) do { __builtin_amdgcn_s_setprio(1); _Pragma("unroll") for (int m = 0; m < 4; ++m) _Pragma("unroll") for (int n = 0; n < 2; ++n) _Pragma("unroll") for (int k = 0; k < 2; ++k) \
        acc[ai][bj][m][n] = __builtin_amdgcn_mfma_f32_16x16x32_bf16(Bt[n][k], At[m][k], acc[ai][bj][m][n], 0, 0, 0); __builtin_amdgcn_s_setprio(0); } while (0)
#define PG8_WAIT_V(n) asm volatile("s_waitcnt vmcnt(" #n ")" ::: "memory")
#define PG8_WAIT_L(n) asm volatile("s_waitcnt lgkmcnt(" #n ")" ::: "memory")
#define PG8_BAR __builtin_amdgcn_s_barrier()
#define PG8_SCHED __builtin_amdgcn_sched_barrier(0)
    Unit cur, nxt; int ui = 0;
    if (!S.next(0, cur)) return;
    f32x4 acc[2][2][4][2];
#pragma unroll
    for (int a = 0; a < 2; ++a)
#pragma unroll
        for (int b = 0; b < 2; ++b)
#pragma unroll
            for (int m = 0; m < 4; ++m)
#pragma unroll
                for (int n = 0; n < 2; ++n) acc[a][b][m][n] = (f32x4){0.f, 0.f, 0.f, 0.f};
    bf16x8 At[4][2], B0[2][2], B1[2][2];
    const char* cA = (const char*)g.A + (size_t)cur.pm * tstep; const char* cB = (const char*)g.Bt + (size_t)cur.pn * tstep;
    S.a_ready(cur);
    (void)E.pre(cur, tid, 0);
    {
        PG8_STAGE(PG8_SB(0, 0), cB, voffB); PG8_STAGE(PG8_SB(0, 1), cB + hstep, voffB); PG8_STAGE(PG8_SA(0, 0), cA, voffA); PG8_STAGE(PG8_SA(0, 1), cA + hstep, voffA);
        if (wr == 1) PG8_BAR;
        PG8_WAIT_V(2); PG8_BAR;
        PG8_STAGE(PG8_SB(1, 0), cB + kstep, voffB); PG8_STAGE(PG8_SA(1, 0), cA + kstep, voffA); PG8_STAGE(PG8_SB(1, 1), cB + hstep + kstep, voffB);
        PG8_WAIT_V(6); PG8_BAR;
    }
    for (;;) {
        const bool has_next = S.next(ui + 1, nxt);
        const char* nA = has_next ? (const char*)g.A + (size_t)nxt.pm * tstep : cA; const char* nB = has_next ? (const char*)g.Bt + (size_t)nxt.pn * tstep : cB;
        for (int t = 0; t < nt; t += 2) {
            const bool last = (t == nt - 2);
            const char* a1 = cA + (size_t)(t + 1) * kstep;
            const char* a2 = last ? nA : cA + (size_t)(t + 2) * kstep; const char* b2 = last ? nB : cB + (size_t)(t + 2) * kstep;
            const char* a3 = a2 + kstep; const char* b3 = b2 + kstep;
            if (last && has_next) S.a_ready(nxt);
            PG8_LDB(B0, 0, 0); PG8_LDB(B1, 0, 1); PG8_SCHED; PG8_LDA(At, 0, 0); PG8_STAGE(PG8_SA(1, 1), a1 + hstep, voffA);
            PG8_WAIT_V(8); PG8_WAIT_L(0); PG8_BAR; PG8_MMA(0, 0, At, B0); PG8_MMA(0, 1, At, B1); PG8_BAR; PG8_SCHED;
            PG8_LDA(At, 0, 1); PG8_STAGE(PG8_SB(0, 0), b2, voffB); PG8_STAGE(PG8_SB(0, 1), b2 + hstep, voffB); PG8_STAGE(PG8_SA(0, 0), a2, voffA);
            PG8_WAIT_V(8); PG8_WAIT_L(0); PG8_BAR; PG8_MMA(1, 0, At, B0); PG8_MMA(1, 1, At, B1); PG8_BAR; PG8_SCHED;
            PG8_LDB(B0, 1, 0); PG8_LDB(B1, 1, 1); PG8_SCHED; PG8_LDA(At, 1, 0); PG8_STAGE(PG8_SA(0, 1), a2 + hstep, voffA);
            PG8_WAIT_V(8); PG8_WAIT_L(0); PG8_BAR; PG8_MMA(0, 0, At, B0); PG8_MMA(0, 1, At, B1); PG8_BAR; PG8_SCHED;
            PG8_LDA(At, 1, 1); PG8_STAGE(PG8_SB(1, 0), b3, voffB); PG8_STAGE(PG8_SB(1, 1), b3 + hstep, voffB); PG8_STAGE(PG8_SA(1, 0), a3, voffA);
            PG8_WAIT_V(8); PG8_WAIT_L(0); PG8_BAR; PG8_MMA(1, 0, At, B0); PG8_MMA(1, 1, At, B1); PG8_BAR; PG8_SCHED;
        }
        if constexpr (ALIGN_EPI) { if (wr == 0) PG8_BAR; }
        { const int l2 = lane_id(); E(acc, cur, wr, wc, l2 & 15, l2 >> 4, (f32x2){__int_as_float(ui & 1), 0.f}); } S.done(cur);
        if (!has_next) break;
        (void)E.pre(nxt, wave_id * 64 + lane_id(), (ui + 1) & 1);
#pragma unroll
        for (int a = 0; a < 2; ++a)
#pragma unroll
            for (int b = 0; b < 2; ++b)
#pragma unroll
                for (int m = 0; m < 4; ++m)
#pragma unroll
                    for (int n = 0; n < 2; ++n) acc[a][b][m][n] = (f32x4){0.f, 0.f, 0.f, 0.f};
        cur = nxt; cA = nA; cB = nB; ++ui;
        if constexpr (ALIGN_EPI) { if (wr == 1) PG8_BAR; }
    }
    PG8_WAIT_V(0);
    if constexpr (!ALIGN_EPI) { if (wr == 0) PG8_BAR; }
    PG8_BAR;
#undef PG8_SA
#undef PG8_SB
#undef PG8_STAGE
#undef PG8_LDA
#undef PG8_LDB
#undef PG8_MMA
#undef PG8_WAIT_V
#undef PG8_WAIT_L
#undef PG8_BAR
#undef PG8_SCHED
}
}

constexpr int D = 1024, NBATCH = 32, SEQ = 2048, CTXL = 256, PT = 2304, NB = 16, NG = 2, TG = NB * PT;
constexpr int FFN = 2816, FFN2 = 5632, LW = 1280, NMOD = 6144;
constexpr float EPS = 1e-6f;
constexpr int NWAVES = 8, NTHR = 512;

constexpr size_t MiB = 1u << 20;
constexpr size_t WS_CTL = 0, CTL_ZERO_BYTES = 1 * MiB;
constexpr size_t WS_MOD = 1 * MiB;
constexpr size_t WS_ROPE = 5 * MiB;
constexpr size_t WS_CTX = 8 * MiB;
constexpr size_t WS_T = 24 * MiB;
constexpr size_t WS_STAT = 30 * MiB;
constexpr int TB_FFN = 0, TB_FFN_SZ = 33 * 5632, TB_LRU = 4 * TB_FFN_SZ, TB_NAQK = TB_LRU + 33 * 2560, TB_NAV = TB_NAQK + 33 * 2048, TB_RETA = TB_NAV + 33 * 1024, TB_RETB = TB_RETA + 33 * 4096;
constexpr size_t WS_W = 40 * MiB;
constexpr size_t WS_ACT = 160 * MiB;
constexpr size_t WS_END = 1024 * MiB;
constexpr size_t W_RET = 0;
constexpr size_t W_FFN = 36 * MiB;
constexpr size_t W_LRU_IN = 102 * MiB, W_LRU_OUT = 107 * MiB, W_LRU_G = 109 * MiB + 512 * 1024;
constexpr size_t W_NA_QK = 112 * MiB, W_NA_V = 116 * MiB, W_NA_O = 118 * MiB;
constexpr size_t A_H = 0;
constexpr size_t A_QKG = 72 * MiB, A_KVT = 360 * MiB, A_Y = 576 * MiB;
constexpr size_t A_ACT = 144 * MiB, A_EDGE = 540 * MiB;
constexpr size_t A_YX = 144 * MiB, A_LA = 324 * MiB, A_U = 504 * MiB, A_A3 = 684 * MiB;
constexpr size_t A_QK = 144 * MiB, A_VT = 288 * MiB, A_O = 360 * MiB;
constexpr int CW_BAR = 4096, CW_DBG = 8192;

constexpr int RING_BYTES = 139264;
constexpr int MISC_OFF = RING_BYTES;
constexpr int NSLOT_OFF = MISC_OFF + 512 + 8192;
constexpr int LDS_BYTES = NSLOT_OFF + 2 * 5120;

#define RLX_AGENT __ATOMIC_RELAXED, __HIP_MEMORY_SCOPE_AGENT
__device__ __forceinline__ unsigned f2bf(float f) { unsigned u = __builtin_bit_cast(unsigned, f); return (u + 0x7fffu + ((u >> 16) & 1u)) >> 16; }
__device__ __forceinline__ unsigned pk2(float lo, float hi) { unsigned r; asm("v_cvt_pk_bf16_f32 %0, %1, %2" : "=v"(r) : "v"(lo), "v"(hi)); return r; }
__device__ __forceinline__ float bf2f(unsigned short h) { return __builtin_bit_cast(float, (unsigned)h << 16); }
__device__ __forceinline__ float bflo(unsigned w) { return __builtin_bit_cast(float, w << 16); }
__device__ __forceinline__ float bfhi(unsigned w) { return __builtin_bit_cast(float, w & 0xffff0000u); }
__device__ __forceinline__ float silu_f(float x) { return x * __builtin_amdgcn_rcpf(1.f + __expf(-x)); }
__device__ __forceinline__ float sigmoid_f(float x) { return __builtin_amdgcn_rcpf(1.f + __expf(-x)); }
__device__ __forceinline__ float lane_get(float v, int src) { return __builtin_bit_cast(float, __builtin_amdgcn_ds_bpermute(src << 2, __builtin_bit_cast(int, v))); }
__device__ __forceinline__ float wave_sum(float v, int lane) {
#pragma unroll
    for (int o = 1; o < 64; o <<= 1) v += lane_get(v, lane ^ o);
    return v;
}

#define XB_TMO      128
#define XB_XCNT(j)  (256  + 64 * (j))
#define XB_XSUB(j)  (1280 + 64 * (j))
#define XB_XGEN(j)  (2304 + 64 * (j))
#define XB_TOP      3328
#define XB_TOPGEN   3392
#define XCD_BAR_WORDS 3456
#define XB_SPIN_CAP (1u << 18)
__device__ __forceinline__ unsigned xb_ld(unsigned* p)              { return __hip_atomic_load(p, __ATOMIC_RELAXED, __HIP_MEMORY_SCOPE_AGENT); }
__device__ __forceinline__ unsigned xb_add(unsigned* p, unsigned v) { return __hip_atomic_fetch_add(p, v, __ATOMIC_RELAXED, __HIP_MEMORY_SCOPE_AGENT); }
__device__ __forceinline__ unsigned xb_xcc_id() { return (unsigned)__builtin_amdgcn_s_getreg((3 << 11) | 20) & 0xFu; }
#define XB_SPIN(cond, bar) do { unsigned _sp = 0; while (cond) { __builtin_amdgcn_s_sleep(1); \
    if ((++_sp & 255u) == 0u) { if (xb_ld(&(bar)[XB_TMO])) break; if (_sp > XB_SPIN_CAP) { atomicAdd(&(bar)[XB_TMO], 1u); break; } } } } while (0)
struct XcdBarrier { unsigned* bar; unsigned x; volatile LAS unsigned* st; bool t0; };
__device__ __forceinline__ XcdBarrier xcd_barrier_post(unsigned* bar, volatile LAS unsigned* st) {
    XcdBarrier b; b.bar = bar; b.x = xb_xcc_id(); b.st = st; b.t0 = threadIdx.x == 0;
    if (threadIdx.x == 0) (void)xb_add(&bar[XB_XCNT(b.x)], 1u);
    return b;
}
__device__ __forceinline__ void xcd_barrier_complete(unsigned* bar, unsigned x, unsigned& nloc, unsigned& nx) {
    const unsigned G = gridDim.x * gridDim.y * gridDim.z;
    unsigned sum, cnt, mine, sp = 0u;
    for (;;) {
        sum = 0u; cnt = 0u; mine = 0u;
#pragma unroll
        for (unsigned j = 0; j < 16; ++j) { const unsigned c = xb_ld(&bar[XB_XCNT(j)]); sum += c; cnt += (c > 0u) ? 1u : 0u; mine = (j == x) ? c : mine; }
        if (sum == G) break;
        __builtin_amdgcn_s_sleep(1);
        if ((++sp & 255u) == 0u) { if (xb_ld(&bar[XB_TMO])) break; if (sp > XB_SPIN_CAP) { atomicAdd(&bar[XB_TMO], 1u); break; } }
    }
    nloc = mine > 0u ? mine : 1u; nx = cnt > 0u ? cnt : 1u;
}
__device__ __forceinline__ void xcd_barrier(const XcdBarrier& b) {
    asm volatile("s_waitcnt vmcnt(0)" ::: "memory");
    __syncthreads();
    if (b.t0) {
        unsigned* bar = b.bar;
        __builtin_amdgcn_s_waitcnt(0);
        unsigned nloc = b.st[0], nx = b.st[1];
        if (nloc == 0u) { xcd_barrier_complete(bar, b.x, nloc, nx); b.st[0] = nloc; b.st[1] = nx; }
        const unsigned old = xb_add(&bar[XB_XSUB(b.x)], 1u);
        const unsigned gen = old / nloc;
        if (old + 1u == (gen + 1u) * nloc) {
            __builtin_amdgcn_fence(__ATOMIC_RELEASE, "agent");
            asm volatile("s_waitcnt vmcnt(0)" ::: "memory");
            const unsigned og = xb_add(&bar[XB_TOP], 1u);
            const unsigned tg = og / nx;
            if (og + 1u == (tg + 1u) * nx) xb_add(&bar[XB_TOPGEN], 1u);
            else XB_SPIN(xb_ld(&bar[XB_TOPGEN]) == tg, bar);
            __builtin_amdgcn_fence(__ATOMIC_ACQUIRE, "agent");
            xb_add(&bar[XB_XGEN(b.x)], 1u);
            asm volatile("s_waitcnt vmcnt(0)" ::: "memory");
        } else {
            XB_SPIN(xb_ld(&bar[XB_XGEN(b.x)]) == gen, bar);
            __builtin_amdgcn_fence(__ATOMIC_ACQUIRE, "agent");
            asm volatile("s_waitcnt vmcnt(0)" ::: "memory");
        }
    }
    __syncthreads();
}

struct Args { const float* in[27]; float* out; unsigned char* ws; };
enum { I_X = 0, I_C, I_CTX, I_CCTX, I_ADAW, I_ADAB, I_NMIX, I_NFFN, I_UP, I_FCW, I_FCB, I_DOWN, I_RWIN, I_RDEC, I_RGN, I_RWOUT,
       I_LWIN, I_LCW, I_LCB, I_LGW, I_LGB, I_LLAM, I_LWOUT, I_NQKV, I_NRPB, I_NWOUT, I_FNORM };

typedef const __attribute__((address_space(4))) Args* CArgsP;
__device__ __forceinline__ CArgsP fresh_args() { CArgsP p = (CArgsP)__builtin_amdgcn_kernarg_segment_ptr(); asm volatile("" : "+s"(p)); return p; }
#define AIN(i) (fresh_args()->in[(i)])
#define AOUT (fresh_args()->out)
#define AWS (fresh_args()->ws)
struct Frame {
    LAS unsigned char* lds;
    int tid, lane, wave, vcu, G, gw, NGW;
    unsigned char* ws;
};

__device__ __forceinline__ Frame refresh(const Frame& F0) {
    Frame F = F0; int t = F0.wave * 64 + lane_id(); asm volatile("" : "+v"(t));
    F.tid = t; F.lane = t & 63; F.gw = F.vcu * NWAVES + F.wave;
    return F;
}
__device__ __forceinline__ void transpose_item(const float* W, int K, int ldn, int c0, int ncols, bf16* WT, int row_off, float scale, LAS float* scr, int item, int lane) {
    const int nblk = ncols / 32, kb = item / nblk, nb = item % nblk, k0 = 64 * kb, n0 = 32 * nb;
    if (row_off <= -1000000) { const int dim = n0 & 255; row_off = (-1000000 - row_off) + (n0 & ~255) + 128 * ((dim & 127) >> 6) + 64 * (dim >> 7) + (dim & 63) - n0; }
    else if (row_off < 0) { const int cc = c0 + n0; row_off = (cc < 2816 ? 256 * (cc / 128) + (cc % 128) : 256 * ((cc - 2816) / 128) + 128 + ((cc - 2816) % 128)) - n0; }
    {
        f32x4 v[8];
#pragma unroll
        for (int i = 0; i < 8; ++i) v[i] = *(const f32x4*)(W + (size_t)(k0 + 8 * i + (lane >> 3)) * ldn + c0 + n0 + 4 * (lane & 7));
#pragma unroll
        for (int i = 0; i < 8; ++i) { LAS float* d = scr + (8 * i + (lane >> 3)) * 33 + 4 * (lane & 7); d[0] = v[i].x * scale; d[1] = v[i].y * scale; d[2] = v[i].z * scale; d[3] = v[i].w * scale; }
    }
    asm volatile("s_waitcnt lgkmcnt(0)" ::: "memory");
    const int c = lane & 7;
#pragma unroll
    for (int j = 0; j < 4; ++j) { const int n = (lane >> 3) + 8 * j; const LAS float* s = scr + (8 * c) * 33 + n;
        u32x4 o; o.x = pk2(s[0 * 33], s[1 * 33]); o.y = pk2(s[2 * 33], s[3 * 33]); o.z = pk2(s[4 * 33], s[5 * 33]); o.w = pk2(s[6 * 33], s[7 * 33]);
        *(u32x4*)(WT + (size_t)(row_off + n0 + n) * K + k0 + 8 * c) = o; }
    asm volatile("s_waitcnt lgkmcnt(0)" ::: "memory");
}

__device__ __forceinline__ void prologue(const Frame& F0) {
    const Frame F = refresh(F0);
    bf16* Wb = (bf16*)(F.ws + WS_W);
    if (F.vcu < 192) {
        const int l = F.vcu / 48, n0 = (F.vcu % 48) * 128;
        LAS float* s = (LAS float*)F.lds;
        for (int idx = F.tid; idx < 33 * 1024; idx += NTHR) { const int bb = idx >> 10, k = idx & 1023; const float v = bb < 32 ? AIN(I_C)[bb * 1024 + k] : AIN(I_CCTX)[k]; s[idx] = silu_f(v); }
        __syncthreads();
        const int cc = F.tid & 127, kq = F.tid >> 7;
        float acc[33];
#pragma unroll
        for (int bb = 0; bb < 33; ++bb) acc[bb] = 0.f;
        const float* wp = AIN(I_ADAW) + ((size_t)l * 1024 + kq * 256) * NMOD + n0 + cc;
        for (int k = 0; k < 256; k += 4) {
            const float w0 = wp[(size_t)(k + 0) * NMOD], w1 = wp[(size_t)(k + 1) * NMOD], w2 = wp[(size_t)(k + 2) * NMOD], w3 = wp[(size_t)(k + 3) * NMOD];
#pragma unroll
            for (int bb = 0; bb < 33; ++bb) { const f32x4 sv = *(const LAS f32x4*)(s + bb * 1024 + kq * 256 + k); acc[bb] += (sv.x * w0 + sv.y * w1) + (sv.z * w2 + sv.w * w3); }
        }
        __syncthreads();
        LAS float* red = (LAS float*)F.lds;
#pragma unroll
        for (int bb = 0; bb < 33; ++bb) red[(kq * 33 + bb) * 128 + cc] = acc[bb];
        __syncthreads();
        float* MOD = (float*)(F.ws + WS_MOD);
        for (int idx = F.tid; idx < 33 * 128; idx += NTHR) { const int bb = idx >> 7, c2 = idx & 127;
            const float v = (red[(0 * 33 + bb) * 128 + c2] + red[(1 * 33 + bb) * 128 + c2]) + (red[(2 * 33 + bb) * 128 + c2] + red[(3 * 33 + bb) * 128 + c2]);
            MOD[((size_t)l * 33 + bb) * NMOD + n0 + c2] = v + AIN(I_ADAB)[l * NMOD + n0 + c2]; }
        __syncthreads();
    }
    if (F.vcu == 192 + 8) {
        float* RT = (float*)(F.ws + WS_ROPE);
        for (int idx = F.tid; idx < 64 * 64; idx += NTHR) { const int pos = idx >> 6, m = idx & 63; const float fr = powf(10000.0f, -(float)(2 * m) / 128.0f); const float ang = (float)pos * fr;
            RT[2 * idx] = cosf(ang); RT[2 * idx + 1] = sinf(ang); }
    }
    {
        bf16* GW = (bf16*)(F.ws + WS_W + W_LRU_G); const float* gwsrc = AIN(I_LGW);
        for (int idx = F.vcu * NTHR + F.tid; idx < 8 * 640 * 160; idx += F.G * NTHR) { const int c = idx % 160, n = (idx / 160) % 640, blk = idx / (160 * 640); const int dg = n / 160, d = n % 160;
            GW[idx] = (bf16)f2bf(gwsrc[(((size_t)dg * 8 + blk) * 160 + c) * 160 + d]); }
    }
    {
        LAS float* scr = (LAS float*)(F.lds + F.wave * 16384);
        constexpr int TOTAL = 2 * (512 + 512 + 1024 + 512 + 1024 + 1024) + 4 * (2816 + 1408) + 1280 + 640 + 512 + 512 + 512 + 512;
        for (int it = F.gw; it < TOTAL; it += F.NGW) {
            int r = it;
#define JOB(Wp, K_, ldn_, c0_, nc_, dst_, ro_, sc_) { constexpr int items_ = ((K_) / 64) * ((nc_) / 32); if (r < items_) { transpose_item((Wp), (K_), (ldn_), (c0_), (nc_), (dst_), (ro_), (sc_), scr, r, F.lane); continue; } r -= items_; }
#define RETJOBS(j) { const float* win = AIN(I_RWIN) + (size_t)(j) * 1024 * 6144; bf16* Wa = Wb + (W_RET + (size_t)(j) * 18 * MiB) / 2; bf16* Wbb = Wa + (8 * MiB) / 2; bf16* Wo = Wa + (14 * MiB) / 2; \
            JOB(win, 1024, 6144, 0, 1024, Wa, -1000000, 1.f) JOB(win, 1024, 6144, 1024, 1024, Wa, -1000000 - 1024, 0.0625f) JOB(win, 1024, 6144, 4096, 2048, Wa, 2048, 1.f) \
            JOB(win, 1024, 6144, 1024, 1024, Wbb, -1000000, 0.0625f) JOB(win, 1024, 6144, 2048, 2048, Wbb, 1024, 1.f) \
            JOB(AIN(I_RWOUT) + (size_t)(j) * 2048 * 1024, 2048, 1024, 0, 1024, Wo, 0, 1.f) }
#define FFNJOBS(l) { bf16* Wup = Wb + (W_FFN + (size_t)(l) * (16 * MiB + 512 * 1024)) / 2; bf16* Wdn = Wup + (11 * MiB) / 2; \
            JOB(AIN(I_UP) + (size_t)(l) * 1024 * 5632, 1024, 5632, 0, 5632, Wup, -1, 1.f) JOB(AIN(I_DOWN) + (size_t)(l) * 2816 * 1024, 2816, 1024, 0, 1024, Wdn, 0, 1.f) }
            RETJOBS(0) RETJOBS(1) FFNJOBS(0) FFNJOBS(1) FFNJOBS(2) FFNJOBS(3)
            JOB(AIN(I_LWIN), 1024, 2560, 0, 2560, Wb + W_LRU_IN / 2, 0, 1.f) JOB(AIN(I_LWOUT), 1280, 1024, 0, 1024, Wb + W_LRU_OUT / 2, 0, 1.f)
            JOB(AIN(I_NQKV), 1024, 3072, 0, 1024, Wb + W_NA_QK / 2, 0, 0.125f) JOB(AIN(I_NQKV), 1024, 3072, 1024, 1024, Wb + W_NA_QK / 2, 1024, 1.f)
            JOB(AIN(I_NQKV), 1024, 3072, 2048, 1024, Wb + W_NA_V / 2, 0, 1.f) JOB(AIN(I_NWOUT), 1024, 1024, 0, 1024, Wb + W_NA_O / 2, 0, 1.f)
#undef JOB
#undef RETJOBS
#undef FFNJOBS
        }
    }
}

__device__ __forceinline__ void norm_phase(const Frame& F0, int b0, int nrows, const void* xs, const void* cs, int f32src, const float* gain, const float* modl, int shoff, int scoff) {
    const Frame F = refresh(F0);
    bf16* H = (bf16*)(F.ws + WS_ACT + A_H);
    for (int row = F.gw; row < nrows; row += F.NGW) {
        const int bl = row / PT, p = row % PT, b = b0 + bl;
        const size_t soff = p < CTXL ? ((size_t)b * CTXL + p) * D : ((size_t)b * SEQ + (p - CTXL)) * D; const void* sbase = p < CTXL ? cs : xs;
        const float* mod = modl + (size_t)(p < CTXL ? 32 : b) * NMOD;
        f32x4 v[4]; float ss = 0.f;
#pragma unroll
        for (int j = 0; j < 4; ++j) {
            if (f32src) v[j] = *(const f32x4*)((const float*)sbase + soff + 4 * F.lane + 256 * j);
            else { const u32x2 w = *(const u32x2*)((const bf16*)sbase + soff + 4 * F.lane + 256 * j); v[j] = (f32x4){bflo(w.x), bfhi(w.x), bflo(w.y), bfhi(w.y)}; }
            ss += (v[j].x * v[j].x + v[j].y * v[j].y) + (v[j].z * v[j].z + v[j].w * v[j].w); }
        const float rstd = 1.f / sqrtf(wave_sum(ss, F.lane) * (1.f / D) + EPS);
#pragma unroll
        for (int j = 0; j < 4; ++j) { const int c = 4 * F.lane + 256 * j;
            const f32x4 gn = *(const f32x4*)(gain + c), sh = *(const f32x4*)(mod + shoff + c), sc = *(const f32x4*)(mod + scoff + c);
            const f32x4 h = (v[j] * rstd) * gn; const f32x4 o = h * (sc + 1.f) + sh;
            u32x2 w; w.x = pk2(o.x, o.y); w.y = pk2(o.z, o.w);
            *(u32x2*)(H + (size_t)row * D + c) = w; }
    }
}

__device__ __forceinline__ void ffn_fix_phase(const Frame& F0, const float* cw, const float* cb) {
    const Frame F = refresh(F0);
    const bf16* EDGE = (const bf16*)(F.ws + WS_ACT + A_EDGE); bf16* ACT = (bf16*)(F.ws + WS_ACT + A_ACT);
    const int NOCT = FFN / 8;
    for (int it = F.vcu * NTHR + F.tid; it < NBATCH * 7 * 2 * NOCT; it += F.G * NTHR) {
        const int oc = it % NOCT, r2 = it / NOCT, side = r2 & 1, bd = (r2 >> 1) % 7, b = (r2 >> 1) / 7; const int c = oc * 8;
        const int pml = 9 * b + 1 + bd, pmh = pml + 1;
        const bf16* pp = side == 0 ? EDGE + ((size_t)pml * 4 + 2) * FFN2 : EDGE + ((size_t)pml * 4 + 3) * FFN2;
        const bf16* pc = side == 0 ? EDGE + ((size_t)pml * 4 + 3) * FFN2 : EDGE + ((size_t)pmh * 4 + 0) * FFN2;
        const bf16* pn = side == 0 ? EDGE + ((size_t)pmh * 4 + 0) * FFN2 : EDGE + ((size_t)pmh * 4 + 1) * FFN2;
        const size_t trow = side == 0 ? (size_t)pml * 256 + 255 : (size_t)pmh * 256;
        float ug[8], uv[8];
#pragma unroll
        for (int half = 0; half < 2; ++half) {
            const int col = half * FFN + c;
            const u32x4 prv = *(const u32x4*)(pp + col), cur = *(const u32x4*)(pc + col), nxt = *(const u32x4*)(pn + col);
            float* dst = half == 0 ? ug : uv;
#pragma unroll
            for (int q = 0; q < 4; ++q) {
                const f32x2 w0 = *(const f32x2*)(cw + 0 * FFN2 + col + 2 * q), w1 = *(const f32x2*)(cw + 1 * FFN2 + col + 2 * q), w2 = *(const f32x2*)(cw + 2 * FFN2 + col + 2 * q), bb = *(const f32x2*)(cb + col + 2 * q);
                dst[2 * q] = bb.x + w0.x * bflo(prv[q]) + w1.x * bflo(cur[q]) + w2.x * bflo(nxt[q]);
                dst[2 * q + 1] = bb.y + w0.y * bfhi(prv[q]) + w1.y * bfhi(cur[q]) + w2.y * bfhi(nxt[q]);
            }
        }
        float o[8];
#pragma unroll
        for (int e = 0; e < 8; ++e) o[e] = silu_f(ug[e]) * uv[e];
        u32x4 w; w.x = pk2(o[0], o[1]); w.y = pk2(o[2], o[3]); w.z = pk2(o[4], o[5]); w.w = pk2(o[6], o[7]);
        *(u32x4*)(ACT + trow * FFN + c) = w;
    }
}

__device__ __forceinline__ void rope_phase(const Frame& F0) {
    const Frame F = refresh(F0);
    bf16* QKG = (bf16*)(F.ws + WS_ACT + A_QKG); bf16* KVT = (bf16*)(F.ws + WS_ACT + A_KVT); const float* RT = (const float*)(F.ws + WS_ROPE);
    const size_t n1 = (size_t)NB * SEQ * 128;
    for (size_t it = (size_t)F.vcu * NTHR + F.tid; it < n1; it += (size_t)F.G * NTHR) {
        const int sub = (int)(it & 127); const size_t lr = it >> 7; const int bl = (int)(lr / SEQ), t = (int)(lr % SEQ);
        const int oct = sub & 7, hf = (sub >> 3) & 1, h = (sub >> 4) & 3, tens = sub >> 6;
        const int pos = hf == 0 ? (t >> 6) : (t & 63);
        bf16* p1 = QKG + ((size_t)bl * PT + CTXL + t) * 4096 + tens * 1024 + h * 256 + hf * 128 + oct * 8; bf16* p2 = p1 + 64;
        const u32x4 a = *(const u32x4*)p1, b = *(const u32x4*)p2; u32x4 oa, ob;
#pragma unroll
        for (int q = 0; q < 4; ++q) {
            const f32x4 cs = *(const f32x4*)(RT + 2 * (pos * 64 + oct * 8 + 2 * q));
            const float x1l = bflo(a[q]), x1h = bfhi(a[q]), x2l = bflo(b[q]), x2h = bfhi(b[q]);
            oa[q] = pk2(x1l * cs.x - x2l * cs.y, x1h * cs.z - x2h * cs.w);
            ob[q] = pk2(x1l * cs.y + x2l * cs.x, x1h * cs.w + x2h * cs.z);
        }
        *(u32x4*)p1 = oa; *(u32x4*)p2 = ob;
    }
    const size_t n2 = (size_t)4 * 2 * 64 * NB * (SEQ / 8);
    for (size_t it = (size_t)F.vcu * NTHR + F.tid; it < n2; it += (size_t)F.G * NTHR) {
        const int to = (int)(it % (SEQ / 8)); size_t r = it / (SEQ / 8); const int bl = (int)(r % NB); r /= NB; const int d = (int)(r & 63), hf = (int)((r >> 6) & 1), h = (int)(r >> 7);
        const int t0 = to * 8;
        bf16* p1 = KVT + (size_t)(h * 256 + hf * 128 + d) * TG + (size_t)bl * PT + CTXL + t0; bf16* p2 = p1 + (size_t)64 * TG;
        const u32x4 a = *(const u32x4*)p1, b = *(const u32x4*)p2; u32x4 oa, ob;
#pragma unroll
        for (int q = 0; q < 4; ++q) {
            const int pos0 = hf == 0 ? (t0 >> 6) : ((t0 & 63) + 2 * q), pos1 = hf == 0 ? pos0 : pos0 + 1;
            const f32x2 c0 = *(const f32x2*)(RT + 2 * (pos0 * 64 + d)), c1 = *(const f32x2*)(RT + 2 * (pos1 * 64 + d));
            const float x1l = bflo(a[q]), x1h = bfhi(a[q]), x2l = bflo(b[q]), x2h = bfhi(b[q]);
            oa[q] = pk2(x1l * c0.x - x2l * c0.y, x1h * c1.x - x2h * c1.y);
            ob[q] = pk2(x1l * c0.y + x2l * c0.x, x1h * c1.y + x2h * c1.x);
        }
        *(u32x4*)p1 = oa; *(u32x4*)p2 = ob;
    }
}

#define MFMA16(a, b, c) __builtin_amdgcn_mfma_f32_16x16x32_bf16((a), (b), (c), 0, 0, 0)
constexpr int QS_STRIDE = 528, PS_STRIDE = 272;
constexpr int LDS_RA = 0, LDS_RB = 65536;
__device__ __forceinline__ float ex2(float x) { return __builtin_amdgcn_exp2f(x); }
__device__ __forceinline__ int st_off(int r, int cb, int ncg) { return ((r >> 4) * ncg + (cb >> 6)) * 1024 + ((((r & 15) << 6) + (cb & 63)) ^ (((r >> 3) & 1) << 5)); }
template <int DIR>
__device__ __forceinline__ void ret_scan_pass(const Frame& F, const bf16* QKG, const bf16* KVT, bf16* Y, int bl, int h, int vs, float lgf, float lgb) {
    LAS unsigned char* RA = F.lds + LDS_RA; LAS unsigned char* RB = F.lds + LDS_RB;
    const int v0 = vs * 128 + F.wave * 16;
    const float lg2 = DIR == 0 ? lgf : lgb;
    const float gch = ex2(lg2 * 128.f);
    f32x4 S[16];
#pragma unroll
    for (int i = 0; i < 16; ++i) S[i] = (f32x4){0.f, 0.f, 0.f, 0.f};
    u32x4 qv[8], kv[8];
#define RET_PF_Q(cc) do { const size_t Rn = (size_t)bl * PT + (size_t)(cc) * 128; int tp = F.tid; asm volatile("" : "+v"(tp)); \
        _Pragma("unroll") for (int e = 0; e < 8; ++e) { const int q = tp + NTHR * e; qv[e] = *(const u32x4*)(QKG + (Rn + (q >> 5)) * 4096 + h * 256 + (q & 31) * 8); } } while (0)
#define RET_PF_K(cc) do { const size_t Rn = (size_t)bl * PT + (size_t)(cc) * 128; int tp = F.tid; asm volatile("" : "+v"(tp)); \
        _Pragma("unroll") for (int e = 0; e < 8; ++e) { const int q = tp + NTHR * e; \
            if (DIR == 0) kv[e] = *(const u32x4*)(QKG + (Rn + (q >> 5)) * 4096 + 1024 + h * 256 + (q & 31) * 8); \
            else kv[e] = *(const u32x4*)(KVT + (size_t)(h * 256 + (q >> 4)) * TG + Rn + (q & 15) * 8); } } while (0)
    RET_PF_Q(DIR == 0 ? 0 : 1); RET_PF_K(DIR == 0 ? 0 : 1);
    for (int step = 0; step < 18; ++step) {
        const int c = DIR == 0 ? step : (step < 2 ? 1 - step : 19 - step);
        const int cn = step == 17 ? c : (DIR == 0 ? step + 1 : (step + 1 < 2 ? 1 - (step + 1) : 19 - (step + 1)));
        const size_t R0 = (size_t)bl * PT + (size_t)c * 128;
        int tl = F.tid; asm volatile("" : "+v"(tl));
        const int l15 = tl & 15, g4 = (tl >> 4) & 3;
#pragma unroll
        for (int e = 0; e < 8; ++e) { const int q = tl + NTHR * e; const int m8 = q & 31, mm = m8 & 3;
            const int o0 = st_off(q >> 5, 64 * (m8 >> 2) + 32 * (mm & 1) + 8 * (mm >> 1), 8), o1 = st_off(q >> 5, 64 * (m8 >> 2) + 32 * (mm & 1) + 8 * (mm >> 1) + 16, 8);
            *(LAS u32x2*)(RA + o0) = (u32x2){qv[e].x, qv[e].y}; *(LAS u32x2*)(RA + o1) = (u32x2){qv[e].z, qv[e].w};
            if (DIR == 0) { *(LAS u32x2*)(RB + o0) = (u32x2){kv[e].x, kv[e].y}; *(LAS u32x2*)(RB + o1) = (u32x2){kv[e].z, kv[e].w}; }
            else *(LAS u32x4*)(RB + st_off(q >> 4, 16 * (q & 15), 4)) = kv[e]; }
        const int loff = ((l15 << 6) + 16 * g4) ^ (((l15 >> 3) & 1) << 5);
        bf16x8 vf[4];
#pragma unroll
        for (int ks = 0; ks < 4; ++ks) vf[ks] = *(const bf16x8*)(KVT + (size_t)(1024 + h * 512 + v0 + l15) * TG + R0 + 32 * ks + 8 * g4);
        __syncthreads();
        if (DIR == 1) RET_PF_Q(cn);
        f32x4 ya[8];
#pragma unroll
        for (int it = 0; it < 8; ++it) ya[it] = (f32x4){0.f, 0.f, 0.f, 0.f};
        if (DIR == 0) {
            f32x4 pt[8];
#pragma unroll
            for (int it = 0; it < 8; ++it) pt[it] = (f32x4){0.f, 0.f, 0.f, 0.f};
#pragma unroll
            for (int ks = 0; ks < 8; ++ks) {
                __builtin_amdgcn_sched_barrier(0);
                const bf16x8 af = *(const LAS bf16x8*)(RB + (F.wave * 8 + ks) * 1024 + loff);
#pragma unroll
                for (int ih = 0; ih < 2; ++ih) {
                    bf16x8 bq[4];
#pragma unroll
                    for (int it = 0; it < 4; ++it) bq[it] = *(const LAS bf16x8*)(RA + ((4 * ih + it) * 8 + ks) * 1024 + loff);
                    __builtin_amdgcn_sched_barrier(0);
#pragma unroll
                    for (int it = 0; it < 4; ++it) pt[4 * ih + it] = MFMA16(af, bq[it], pt[4 * ih + it]);
                    __builtin_amdgcn_sched_barrier(0);
                }
            }
            __syncthreads();
#pragma unroll
            for (int it = 0; it < 8; ++it) {
                const int i = 16 * it + l15; float pv[4];
                const float ixi = ex2(-lgf * (float)(i + 1));
#pragma unroll
                for (int r = 0; r < 4; ++r) { const int j = 16 * F.wave + 4 * g4 + r; const int dd = i - j;
                    const float f = dd > 0 ? ex2(-lgf * (float)(j + 1)) : (dd < 0 ? ex2(lgb * (float)(-dd)) * ixi : 2.f * ixi); pv[r] = pt[it][r] * f; }
                u32x2 w; w.x = pk2(pv[0], pv[1]); w.y = pk2(pv[2], pv[3]);
                *(LAS u32x2*)(RB + st_off(i, 32 * F.wave + 8 * g4, 4)) = w;
            }
            __syncthreads();
#pragma unroll
            for (int ks = 0; ks < 4; ++ks) {
                __builtin_amdgcn_sched_barrier(0);
                bf16x8 ap[8];
#pragma unroll
                for (int it = 0; it < 8; ++it) ap[it] = *(const LAS bf16x8*)(RB + (it * 4 + ks) * 1024 + loff);
                __builtin_amdgcn_sched_barrier(0);
#pragma unroll
                for (int it = 0; it < 8; ++it) ya[it] = MFMA16(ap[it], vf[ks], ya[it]);
            }
        }
        u32x4 kt2[8];
        if (DIR == 0) {
#pragma unroll
            for (int e = 0; e < 8; ++e) { const int q = tl + NTHR * e; kt2[e] = *(const u32x4*)(KVT + (size_t)(h * 256 + (q >> 4)) * TG + R0 + (q & 15) * 8); }
        }
        bf16x8 vfs[4];
        {
            float z[8]; const float z32 = ex2(lg2 * (DIR == 0 ? -32.f : 32.f));
#pragma unroll
            for (int e = 0; e < 8; ++e) z[e] = ex2(lg2 * (float)(DIR == 0 ? 127 - (8 * g4 + e) : 8 * g4 + e));
#pragma unroll
            for (int ks = 0; ks < 4; ++ks) {
                const u32x4 vv = __builtin_bit_cast(u32x4, vf[ks]); u32x4 o;
#pragma unroll
                for (int w = 0; w < 4; ++w) o[w] = pk2(bflo(vv[w]) * z[2 * w], bfhi(vv[w]) * z[2 * w + 1]);
                vfs[ks] = __builtin_bit_cast(bf16x8, o);
#pragma unroll
                for (int e = 0; e < 8; ++e) z[e] *= z32;
            }
        }
#pragma unroll
        for (int s = 0; s < 8; ++s) {
            __builtin_amdgcn_sched_barrier(0);
            u32x4 sb; sb.x = pk2(S[2 * s][0], S[2 * s][1]); sb.y = pk2(S[2 * s][2], S[2 * s][3]); sb.z = pk2(S[2 * s + 1][0], S[2 * s + 1][1]); sb.w = pk2(S[2 * s + 1][2], S[2 * s + 1][3]);
            const bf16x8 bfr = __builtin_bit_cast(bf16x8, sb);
            bf16x8 aq[8];
#pragma unroll
            for (int it = 0; it < 8; ++it) aq[it] = *(const LAS bf16x8*)(RA + (it * 8 + s) * 1024 + loff);
            __builtin_amdgcn_sched_barrier(0);
#pragma unroll
            for (int it = 0; it < 8; ++it) ya[it] = MFMA16(aq[it], bfr, ya[it]);
        }
        __builtin_amdgcn_sched_barrier(0);
        {
            float x0[4]; const float x16 = ex2(lg2 * (DIR == 0 ? 16.f : -16.f));
#pragma unroll
            for (int r = 0; r < 4; ++r) x0[r] = ex2(lg2 * (float)(DIR == 0 ? 4 * g4 + r + 1 : 128 - (4 * g4 + r)));
            if (DIR == 0) __syncthreads();
            LAS unsigned char* wscr = F.lds + 139776 + F.wave * 2048;
#pragma unroll
            for (int it = 0; it < 8; ++it) {
#pragma unroll
                for (int r = 0; r < 4; ++r) {
                    const unsigned short o = (unsigned short)f2bf(x0[r] * ya[it][r]);
                    if (DIR == 0) *(LAS bf16*)(RB + st_off(16 * it + 4 * g4 + r, 32 * F.wave + 2 * l15, 4)) = o;
                    else *(LAS bf16*)(wscr + (16 * (it & 3) + 4 * g4 + r) * 32 + l15 * 2) = o;
                    x0[r] *= x16;
                }
                if (DIR == 1 && (it & 3) == 3) {
                    asm volatile("s_waitcnt lgkmcnt(0)" ::: "memory");
                    const int ln = tl & 63;
#pragma unroll
                    for (int cch = 0; cch < 2; ++cch) { const int cq = ln + 64 * cch; const u32x4 yv = *(const LAS u32x4*)(wscr + cq * 16);
                        *(u32x4*)(Y + (R0 + 64 * (it >> 2) + (cq >> 1)) * 2048 + h * 512 + v0 + 8 * (cq & 1)) = yv; }
                    asm volatile("s_waitcnt lgkmcnt(0)" ::: "memory");
                }
            }
        }
#pragma unroll
        for (int i = 0; i < 16; ++i) S[i] = S[i] * gch;
        if (DIR == 0) {
#pragma unroll
            for (int e = 0; e < 8; ++e) { const int q = tl + NTHR * e; *(LAS u32x4*)(RA + st_off(q >> 4, 16 * (q & 15), 4)) = kt2[e]; }
            __syncthreads();
            u32x4 yold[4];
#pragma unroll
            for (int e = 0; e < 4; ++e) { const int q = tl + NTHR * e; yold[e] = *(const u32x4*)(Y + (R0 + (q >> 4)) * 2048 + h * 512 + vs * 128 + (q & 15) * 8); }
            RET_PF_Q(cn); RET_PF_K(cn);
#pragma unroll
            for (int e = 0; e < 4; ++e) {
                const int q = tl + NTHR * e, row = q >> 4, ch = q & 15;
                bf16* yp = Y + (R0 + row) * 2048 + h * 512 + vs * 128 + ch * 8;
                const u32x4 yv = *(const LAS u32x4*)(RB + st_off(row, 16 * ch, 4)); u32x4 o;
#pragma unroll
                for (int w = 0; w < 4; ++w) o[w] = pk2(bflo(yv[w]) + bflo(yold[e][w]), bfhi(yv[w]) + bfhi(yold[e][w]));
                *(u32x4*)yp = o;
            }
        } else {
            RET_PF_K(cn);
        }
        {
            LAS unsigned char* KT = DIR == 0 ? RA : RB;
#pragma unroll
            for (int ks = 0; ks < 4; ++ks)
#pragma unroll
                for (int dh = 0; dh < 2; ++dh) {
                    __builtin_amdgcn_sched_barrier(0);
                    bf16x8 ak[8];
#pragma unroll
                    for (int d8 = 0; d8 < 8; ++d8) ak[d8] = *(const LAS bf16x8*)(KT + ((8 * dh + d8) * 4 + ks) * 1024 + loff);
                    __builtin_amdgcn_sched_barrier(0);
#pragma unroll
                    for (int d8 = 0; d8 < 8; ++d8) S[8 * dh + d8] = MFMA16(ak[d8], vfs[ks], S[8 * dh + d8]);
                }
        }
        __syncthreads();
    }
#undef RET_PF_Q
#undef RET_PF_K
}
__device__ __forceinline__ void ret_scan_phase(const Frame& F0, const float* logit  , size_t yoff) {
    const Frame F = refresh(F0);
    const bf16* QKG = (const bf16*)(F.ws + WS_ACT + A_QKG); const bf16* KVT = (const bf16*)(F.ws + WS_ACT + A_KVT); bf16* Y = (bf16*)(F.ws + WS_ACT + A_Y + yoff);
    for (int u = F.vcu; u < NB * 16; u += F.G) {
        const int bl = u >> 4, h = (u >> 2) & 3, vs = u & 3;
        const float lgf = -log1pf(expf(-logit[h])) * 1.4426950408889634f, lgb = -log1pf(expf(-logit[4 + h])) * 1.4426950408889634f;
        ret_scan_pass<1>(F, QKG, KVT, Y, bl, h, vs, lgf, lgb);
        ret_scan_pass<0>(F, QKG, KVT, Y, bl, h, vs, lgf, lgb);
    }
}

__device__ __forceinline__ void t_phase(const Frame& F0) {
    const Frame F = refresh(F0);
    for (int it = F.gw; it < 2208; it += F.NGW) {
    const bf16* W; int N, n0; const float* sh; float* T;
    const float* MODp = (const float*)(F.ws + WS_MOD); float* TB = (float*)(F.ws + WS_T);
    if (it < 1408) { const int l = it / 352; W = (const bf16*)(F.ws + WS_W + W_FFN + (size_t)l * (16 * MiB + 512 * 1024)); N = 5632; n0 = (it % 352) * 16; sh = MODp + (size_t)l * 33 * NMOD + 3 * D; T = TB + TB_FFN + (size_t)l * TB_FFN_SZ; }
    else if (it < 1568) { W = (const bf16*)(F.ws + WS_W + W_LRU_IN); N = 2560; n0 = (it - 1408) * 16; sh = MODp + (size_t)1 * 33 * NMOD; T = TB + TB_LRU; }
    else if (it < 1696) { W = (const bf16*)(F.ws + WS_W + W_NA_QK); N = 2048; n0 = (it - 1568) * 16; sh = MODp + (size_t)2 * 33 * NMOD; T = TB + TB_NAQK; }
    else if (it < 1760) { W = (const bf16*)(F.ws + WS_W + W_NA_V); N = 1024; n0 = (it - 1696) * 16; sh = MODp + (size_t)2 * 33 * NMOD; T = TB + TB_NAV; }
    else if (it < 2016) { W = (const bf16*)(F.ws + WS_W + W_RET + 18 * MiB); N = 4096; n0 = (it - 1760) * 16; sh = MODp + (size_t)3 * 33 * NMOD; T = TB + TB_RETA; }
    else { W = (const bf16*)(F.ws + WS_W + W_RET + 18 * MiB + 8 * MiB); N = 3072; n0 = (it - 2016) * 16; sh = MODp + (size_t)3 * 33 * NMOD; T = TB + TB_RETB; }
    const int l15 = F.lane & 15, g4 = F.lane >> 4;
    f32x4 acc[3];
#pragma unroll
    for (int ct = 0; ct < 3; ++ct) acc[ct] = (f32x4){0.f, 0.f, 0.f, 0.f};
    const bf16* wp = W + (size_t)(n0 + l15) * 1024 + 8 * g4;
    for (int ks = 0; ks < 32; ++ks) {
        const bf16x8 a = *(const bf16x8*)(wp + 32 * ks);
#pragma unroll
        for (int ct = 0; ct < 3; ++ct) { const int mr = 16 * ct + l15 < 32 ? 16 * ct + l15 : 32;
            const float* sp = sh + (size_t)mr * NMOD + 32 * ks + 8 * g4; const f32x4 s0 = *(const f32x4*)sp, s1 = *(const f32x4*)(sp + 4);
            u32x4 bw; bw.x = pk2(s0.x, s0.y); bw.y = pk2(s0.z, s0.w); bw.z = pk2(s1.x, s1.y); bw.w = pk2(s1.z, s1.w);
            acc[ct] = MFMA16(a, __builtin_bit_cast(bf16x8, bw), acc[ct]); }
    }
#pragma unroll
    for (int ct = 0; ct < 3; ++ct) { const int mr = 16 * ct + l15;
        if (mr < 33) {
#pragma unroll
            for (int r = 0; r < 4; ++r) T[(size_t)mr * N + n0 + 4 * g4 + r] = acc[ct][r]; } }
    }
}

__device__ __forceinline__ void ret_gn_phase(const Frame& F0, const float* gn, size_t yoff) {
    const Frame F = refresh(F0);
    const bf16* Y = (const bf16*)(F.ws + WS_ACT + A_Y + yoff); const bf16* QKG = (const bf16*)(F.ws + WS_ACT + A_QKG); bf16* A2 = (bf16*)(F.ws + WS_ACT + A_Y + yoff);
    for (int row = F.gw; row < TG; row += F.NGW) {
#pragma unroll
        for (int h = 0; h < 4; ++h) {
            const int c = h * 512 + 8 * F.lane;
            const u32x4 yv = *(const u32x4*)(Y + (size_t)row * 2048 + c), gv = *(const u32x4*)(QKG + (size_t)row * 4096 + 2048 + c);
            float y[8]; float s = 0.f;
#pragma unroll
            for (int q = 0; q < 4; ++q) { y[2 * q] = bflo(yv[q]); y[2 * q + 1] = bfhi(yv[q]); s += y[2 * q] + y[2 * q + 1]; }
            const float mu = wave_sum(s, F.lane) * (1.f / 512.f); float s2 = 0.f;
#pragma unroll
            for (int e = 0; e < 8; ++e) { y[e] -= mu; s2 += y[e] * y[e]; }
            const float rstd = 1.f / sqrtf(wave_sum(s2, F.lane) * (1.f / 512.f) + EPS);
            float o[8];
#pragma unroll
            for (int q = 0; q < 4; ++q) { const f32x2 gg = *(const f32x2*)(gn + c + 2 * q);
                o[2 * q] = silu_f(bflo(gv[q])) * (y[2 * q] * rstd * gg.x); o[2 * q + 1] = silu_f(bfhi(gv[q])) * (y[2 * q + 1] * rstd * gg.y); }
            u32x4 w; w.x = pk2(o[0], o[1]); w.y = pk2(o[2], o[3]); w.z = pk2(o[4], o[5]); w.w = pk2(o[6], o[7]);
            *(u32x4*)(A2 + (size_t)row * 2048 + c) = w;
        }
    }
}

__device__ __forceinline__ float gelu_tanh(float x) { const float z = 0.7978845608028654f * (x + 0.044715f * x * x * x); const float e = __expf(2.f * z); const float th = 1.f - 2.f * __builtin_amdgcn_rcpf(e + 1.f); return 0.5f * x * (1.f + th); }
constexpr int XC_STRIDE = 336;
__device__ __forceinline__ void lru_gate_phase(const Frame& F0, const float* cw, const float* cb, const float* gb  , const float* lam  ) {
    const Frame F = refresh(F0);
    const bf16* YX = (const bf16*)(F.ws + WS_ACT + A_YX); const bf16* GW = (const bf16*)(F.ws + WS_W + W_LRU_G);
    bf16* LA = (bf16*)(F.ws + WS_ACT + A_LA); bf16* U = (bf16*)(F.ws + WS_ACT + A_U);
    const int l15 = F.lane & 15, g4 = F.lane >> 4;
    const int oc = F.tid % 20, rg = F.tid / 20; const bool act = rg < 22;
    float cwv[4][8], cbv[8];
#define LRU_LOAD_CW(kb_) do { const int cch = (kb_) * 160 + oc * 8; _Pragma("unroll") for (int w = 0; w < 4; ++w) { const f32x2 bb = *(const f32x2*)(cb + cch + 2 * w); cbv[2 * w] = bb.x; cbv[2 * w + 1] = bb.y; \
        _Pragma("unroll") for (int k = 0; k < 4; ++k) { const f32x2 ww = *(const f32x2*)(cw + k * LW + cch + 2 * w); cwv[k][2 * w] = ww.x; cwv[k][2 * w + 1] = ww.y; } } } while (0)
    const bool kbfix = (F.G & 7) == 0;
    LRU_LOAD_CW(F.vcu & 7);
    u32x4 xin[9];
#define LRU_LOAD_X(it_) do { const int rw_ = ((it_) >> 3) * 128, kb_ = (it_) & 7; const int sk_ = (rw_ / PT) * 2 + ((rw_ % PT) >= CTXL ? 1 : 0); \
        _Pragma("unroll") for (int q = 0; q < 9; ++q) { const int gr = rw_ + rg * 6 - 2 + q; const bool ok = act && gr >= 0 && gr < TG && ((gr / PT) * 2 + ((gr % PT) >= CTXL ? 1 : 0)) == sk_; \
            xin[q] = ok ? *(const u32x4*)(YX + (size_t)gr * 2560 + LW + kb_ * 160 + oc * 8) : (u32x4){0u, 0u, 0u, 0u}; } } while (0)
    LRU_LOAD_X(F.vcu);
    for (int it = F.vcu; it < (TG / 128) * 8; it += F.G) {
        const int rb = it >> 3, kb = it & 7; const int row0 = rb * 128;
        if (!kbfix) LRU_LOAD_CW(kb);
        if (act) {
#pragma unroll
            for (int jr = 0; jr < 6; ++jr) {
                const int r = rg * 6 + jr;
                if (r < 128) {
                    float o[8];
#pragma unroll
                    for (int e = 0; e < 8; ++e) o[e] = cbv[e];
#pragma unroll
                    for (int k = 0; k < 4; ++k)
#pragma unroll
                        for (int w = 0; w < 4; ++w) { o[2 * w] += cwv[k][2 * w] * bflo(xin[jr + k][w]); o[2 * w + 1] += cwv[k][2 * w + 1] * bfhi(xin[jr + k][w]); }
                    u32x4 w4; w4.x = pk2(o[0], o[1]); w4.y = pk2(o[2], o[3]); w4.z = pk2(o[4], o[5]); w4.w = pk2(o[6], o[7]);
                    *(LAS u32x4*)(F.lds + r * XC_STRIDE + oc * 16) = w4;
                }
            }
        }
        __syncthreads();
        { const int itn = it + F.G < (TG / 128) * 8 ? it + F.G : it; LRU_LOAD_X(itn); }
        const int dir = F.wave & 1;
        bf16x8 wr[5], wi[5], wrn[5], win[5];
#define LRU_LOAD_W(dr, di, nt_) do { const bf16* wp_ = GW + ((size_t)kb * 640 + (dir * 2 + 0) * 160 + 16 * (nt_) + l15) * 160 + 8 * g4; \
        _Pragma("unroll") for (int ks = 0; ks < 5; ++ks) { dr[ks] = *(const bf16x8*)(wp_ + 32 * ks); di[ks] = *(const bf16x8*)(wp_ + 160 * 160 + 32 * ks); } } while (0)
        LRU_LOAD_W(wrn, win, F.wave >> 1);
        for (int nt = F.wave >> 1; nt < 10; nt += 4) {
#pragma unroll
            for (int ks = 0; ks < 5; ++ks) { wr[ks] = wrn[ks]; wi[ks] = win[ks]; }
            { const int ntn = nt + 4 < 10 ? nt + 4 : nt; LRU_LOAD_W(wrn, win, ntn); }
            const int c0 = kb * 160 + 16 * nt + 4 * g4;
            const f32x4 br = *(const f32x4*)(gb + (dir * 2 + 0) * LW + c0), bi = *(const f32x4*)(gb + (dir * 2 + 1) * LW + c0), lm = *(const f32x4*)(lam + dir * LW + c0);
            f32x4 sp;
#pragma unroll
            for (int r = 0; r < 4; ++r) sp[r] = -8.f * log1pf(__expf(-lm[r]));
            for (int rt = 0; rt < 8; ++rt) {
                f32x4 ar = (f32x4){0.f, 0.f, 0.f, 0.f}, ai = ar;
                const LAS unsigned char* xrow = F.lds + (16 * rt + l15) * XC_STRIDE;
#pragma unroll
                for (int ks = 0; ks < 5; ++ks) { const bf16x8 xb = *(const LAS bf16x8*)(xrow + (32 * ks + 8 * g4) * 2); ar = MFMA16(wr[ks], xb, ar); ai = MFMA16(wi[ks], xb, ai); }
                const u32x2 xv = *(const LAS u32x2*)(xrow + (16 * nt + 4 * g4) * 2);
                const float x4[4] = {bflo(xv.x), bfhi(xv.x), bflo(xv.y), bfhi(xv.y)};
                float la[4], uu[4];
#pragma unroll
                for (int r = 0; r < 4; ++r) {
                    const float rg = sigmoid_f(ar[r] + br[r]), ig = sigmoid_f(ai[r] + bi[r]);
                    la[r] = rg * sp[r]; const float a2 = __expf(2.f * la[r]);
                    uu[r] = sqrtf(fmaxf(1.f - a2, 0.f)) * (ig * x4[r]);
                }
                const size_t o = ((size_t)dir * TG + (size_t)(row0 + 16 * rt + l15)) * LW + c0;
                u32x2 w1, w2; w1.x = pk2(la[0], la[1]); w1.y = pk2(la[2], la[3]); w2.x = pk2(uu[0], uu[1]); w2.y = pk2(uu[2], uu[3]);
                *(u32x2*)(LA + o) = w1; *(u32x2*)(U + o) = w2;
            }
        }
        __syncthreads();
    }
#undef LRU_LOAD_X
#undef LRU_LOAD_W
}

__device__ __forceinline__ void lru_scan_phase(const Frame& F0, size_t aoff) {
    const Frame F = refresh(F0);
    const bf16* LA = (const bf16*)(F.ws + WS_ACT + A_LA); const bf16* U = (const bf16*)(F.ws + WS_ACT + A_U); const bf16* YX = (const bf16*)(F.ws + WS_ACT + A_YX);
    bf16* A3 = (bf16*)(F.ws + WS_ACT + A_A3 + aoff);
    LAS f32x4* cbuf = (LAS f32x4*)F.lds;
    const int cp = F.tid % 40, k = F.tid / 40; const bool act = F.tid < 360;
    for (int it = F.vcu; it < NB * 16; it += F.G) {
        const int bl = it >> 4, cg = it & 15; const int c0 = cg * 80 + 2 * cp;
        for (int dir = 0; dir < 2; ++dir) {
            const size_t base = ((size_t)dir * TG + (size_t)bl * PT) * LW + c0;
            const int pstart = dir == 0 ? 256 * k : 256 * k + 255, pstep = dir == 0 ? 1 : -1;
            if (act) {
                float hx = 0.f, hy = 0.f, sx = 0.f, sy = 0.f;
                for (int s0 = 0; s0 < 256; s0 += 32) {
                    unsigned lv[32], uv[32];
#pragma unroll
                    for (int e = 0; e < 32; ++e) { const size_t o = base + (size_t)(pstart + pstep * (s0 + e)) * LW; lv[e] = *(const unsigned*)(LA + o); uv[e] = *(const unsigned*)(U + o); }
#pragma unroll
                    for (int e = 0; e < 32; ++e) { const float lx = bflo(lv[e]), ly = bfhi(lv[e]); hx = __expf(lx) * hx + bflo(uv[e]); hy = __expf(ly) * hy + bfhi(uv[e]); sx += lx; sy += ly; }
                }
                cbuf[k * 40 + cp] = (f32x4){__expf(sx), hx, __expf(sy), hy};
            }
            __syncthreads();
            if (act) {
                const int ok = dir == 0 ? k : (k == 0 ? 0 : 9 - k);
                float hx = 0.f, hy = 0.f;
                for (int o = 0; o < ok; ++o) { const int kk = dir == 0 ? o : (o == 0 ? 0 : 9 - o); const f32x4 cv = cbuf[kk * 40 + cp]; hx = cv.x * hx + cv.y; hy = cv.z * hy + cv.w; }
                for (int s0 = 0; s0 < 256; s0 += 16) {
                    unsigned lv[16], uv[16], fv[16], yv[16];
#pragma unroll
                    for (int e = 0; e < 16; ++e) { const int p = pstart + pstep * (s0 + e); const size_t o = base + (size_t)p * LW; lv[e] = *(const unsigned*)(LA + o); uv[e] = *(const unsigned*)(U + o);
                        if (dir == 1) { const size_t r = (size_t)bl * PT + p; fv[e] = *(const unsigned*)(A3 + r * LW + c0); yv[e] = *(const unsigned*)(YX + r * 2560 + c0); } }
#pragma unroll
                    for (int e = 0; e < 16; ++e) { const int p = pstart + pstep * (s0 + e); const size_t r = (size_t)bl * PT + p;
                        hx = __expf(bflo(lv[e])) * hx + bflo(uv[e]); hy = __expf(bfhi(lv[e])) * hy + bfhi(uv[e]);
                        unsigned w;
                        if (dir == 0) w = pk2(hx, hy);
                        else w = pk2((hx + bflo(fv[e])) * gelu_tanh(bflo(yv[e])), (hy + bfhi(fv[e])) * gelu_tanh(bfhi(yv[e])));
                        *(unsigned*)(A3 + r * LW + c0) = w; }
                }
            }
            __syncthreads();
        }
    }
}

constexpr int CK_STRIDE = 144, CV_STRIDE = 528, NA_CK = 0, NA_CV = 36864, NA_RP = 36864 + 33792;
__device__ __forceinline__ void na_attn_phase(const Frame& F0, const float* rpb  , size_t ooff) {
    const Frame F = refresh(F0);
    const bf16* QK = (const bf16*)(F.ws + WS_ACT + A_QK); const bf16* VT = (const bf16*)(F.ws + WS_ACT + A_VT); bf16* O = (bf16*)(F.ws + WS_ACT + A_O + ooff);
    const float L2E = 1.4426950408889634f;
    LAS unsigned char* CK = F.lds + NA_CK; LAS unsigned char* CV = F.lds + NA_CV; LAS float* RP = (LAS float*)(F.lds + NA_RP);
    for (int item = F.vcu; item < NB * 16; item += F.G) {
        const int bl = item >> 4, h = item & 15; const size_t cbase = (size_t)bl * PT;
        {
            int ts = F.tid; asm volatile("" : "+v"(ts));
#pragma unroll
            for (int e = 0; e < 4; ++e) { const int q = ts + NTHR * e;
                *(LAS u32x4*)(CK + (q >> 3) * CK_STRIDE + (q & 7) * 16) = *(const u32x4*)(QK + (cbase + (q >> 3)) * 2048 + 1024 + h * 64 + (q & 7) * 8);
                *(LAS u32x4*)(CV + (q >> 5) * CV_STRIDE + (q & 31) * 16) = *(const u32x4*)(VT + (size_t)(h * 64 + (q >> 5)) * TG + cbase + (q & 31) * 8); }
            if (ts < 465) RP[ts] = rpb[h * 465 + ts];
        }
        __syncthreads();
        int tl_ = F.tid; asm volatile("" : "+v"(tl_));
        const int l15 = tl_ & 15, g4 = (tl_ >> 4) & 3;
        bf16x8 qf[2], qn[2], kfa[4][2], kfb[4][2]; u32x2 vfa[2][4][2];
#define NA_CC0(qb_) ((qb_) == 0 ? 0 : ((qb_) == 1 ? 8 : ((qb_) == 2 ? 24 : 32)))
#define NA_START(r_) ((r_) - 4 < 0 ? 0 : ((r_) - 4 > 24 ? 24 : (r_) - 4))
        const unsigned qko = (unsigned)(l15 * 2048 + 8 * g4) * 2u, vto = (unsigned)(l15 * TG + 4 * g4) * 2u;
        const char* qkb = (const char*)(QK + cbase * 2048 + h * 64); const char* vtb = (const char*)(VT + (size_t)(h * 64) * TG + cbase);
#define NA_TK(st_, cc_, BLK, t) (CTXL + ((st_) + 2 * (BLK) + ((t) >> 1)) * 64 + (cc_) + 16 * ((t) & 1))
#define NA_LOADQ(dst, tq_) do { _Pragma("unroll") for (int s_ = 0; s_ < 2; ++s_) dst[s_] = *(const bf16x8*)(qkb + (size_t)(tq_) * 4096 + 64 * s_ + qko); } while (0)
#define NA_LOADK(kf, st_, cc_, BLK) do { _Pragma("unroll") for (int t = 0; t < 4; ++t) { const char* kp = qkb + (size_t)NA_TK(st_, cc_, BLK, t) * 4096 + 2048; \
            kf[t][0] = *(const bf16x8*)(kp + qko); kf[t][1] = *(const bf16x8*)(kp + 64 + qko); } } while (0)
#define NA_LOADV(vf, st_, cc_, BLK) do { _Pragma("unroll") for (int pr = 0; pr < 2; ++pr) _Pragma("unroll") for (int dt = 0; dt < 4; ++dt) { const char* vrow = vtb + (size_t)(16 * dt) * TG * 2; \
            vf[pr][dt][0] = *(const u32x2*)(vrow + (size_t)NA_TK(st_, cc_, BLK, 2 * pr) * 2 + vto); vf[pr][dt][1] = *(const u32x2*)(vrow + (size_t)NA_TK(st_, cc_, BLK, 2 * pr + 1) * 2 + vto); } } while (0)
#define NA_SOFTMAX() \
            float bm = -1e30f; \
            _Pragma("unroll") for (int t = 0; t < 4; ++t) bm = fmaxf(fmaxf(fmaxf(st[t][0], st[t][1]), fmaxf(st[t][2], st[t][3])), bm); \
            bm = fmaxf(bm, lane_get(bm, (tl_ & 63) ^ 16)); bm = fmaxf(bm, lane_get(bm, (tl_ & 63) ^ 32)); \
            const float mnew = fmaxf(mrun, bm); const float alpha = ex2((mrun - mnew) * L2E); mrun = mnew; \
            float ps = 0.f; u32x4 pa[2]; \
            _Pragma("unroll") for (int t = 0; t < 4; ++t) { float pv[4]; \
                _Pragma("unroll") for (int e = 0; e < 4; ++e) { pv[e] = ex2((st[t][e] - mnew) * L2E); ps += pv[e]; } \
                pa[t >> 1][2 * (t & 1)] = pk2(pv[0], pv[1]); pa[t >> 1][2 * (t & 1) + 1] = pk2(pv[2], pv[3]); } \
            lrun = lrun * alpha + ps; \
            { float ar[4]; _Pragma("unroll") for (int e = 0; e < 4; ++e) ar[e] = lane_get(alpha, 4 * g4 + e); \
              _Pragma("unroll") for (int dt = 0; dt < 4; ++dt) _Pragma("unroll") for (int e = 0; e < 4; ++e) o[dt][e] *= ar[e]; }
#define NA_BLOCK_WIN(kf, vf, BLK) do { f32x4 st[4]; \
            _Pragma("unroll") for (int t = 0; t < 4; ++t) { const int rr = start + 2 * (BLK) + (t >> 1), kc0 = cc0 + 16 * (t & 1); \
                f32x4 a = (f32x4){0.f, 0.f, 0.f, 0.f}; a = MFMA16(kf[t][0], qf[0], a); a = MFMA16(kf[t][1], qf[1], a); \
                const LAS float* bp = RP + (rr - r + 7) * 31 + (kc0 + 4 * g4 - qc + 15); \
                _Pragma("unroll") for (int e = 0; e < 4; ++e) { const int kc = kc0 + 4 * g4 + e; const bool ok = kc >= cs && kc < cs + 16; a[e] = ok ? a[e] + bp[ok ? e : 0] : -1e30f; } \
                st[t] = a; } \
            NA_SOFTMAX() \
            _Pragma("unroll") for (int pr = 0; pr < 2; ++pr) _Pragma("unroll") for (int dt = 0; dt < 4; ++dt) { \
                const u32x4 vb = (u32x4){vf[pr][dt][0].x, vf[pr][dt][0].y, vf[pr][dt][1].x, vf[pr][dt][1].y}; \
                o[dt] = MFMA16(__builtin_bit_cast(bf16x8, pa[pr]), __builtin_bit_cast(bf16x8, vb), o[dt]); } } while (0)
#define NA_BLOCK_CTX(BLK) do { f32x4 st[4]; \
            _Pragma("unroll") for (int t = 0; t < 4; ++t) { const LAS unsigned char* kp = CK + (64 * (BLK) + 16 * t) * CK_STRIDE + cko; \
                f32x4 a = (f32x4){0.f, 0.f, 0.f, 0.f}; a = MFMA16(*(const LAS bf16x8*)kp, qf[0], a); a = MFMA16(*(const LAS bf16x8*)(kp + 64), qf[1], a); st[t] = a; } \
            NA_SOFTMAX() \
            _Pragma("unroll") for (int pr = 0; pr < 2; ++pr) _Pragma("unroll") for (int dt = 0; dt < 4; ++dt) { const LAS unsigned char* vrow = CV + (16 * dt) * CV_STRIDE + (64 * (BLK) + 32 * pr) * 2 + cvo; \
                const u32x2 lo = *(const LAS u32x2*)vrow, hi = *(const LAS u32x2*)(vrow + 32); const u32x4 vb = (u32x4){lo.x, lo.y, hi.x, hi.y}; \
                o[dt] = MFMA16(__builtin_bit_cast(bf16x8, pa[pr]), __builtin_bit_cast(bf16x8, vb), o[dt]); } } while (0)
#define NA_FINISH(tq_) do { lrun += lane_get(lrun, (tl_ & 63) ^ 16); lrun += lane_get(lrun, (tl_ & 63) ^ 32); \
            _Pragma("unroll") for (int e = 0; e < 4; ++e) { const float inv = 1.f / lane_get(lrun, 4 * g4 + e); \
                _Pragma("unroll") for (int dt = 0; dt < 4; ++dt) O[(cbase + (tq_) + 4 * g4 + e) * 1024 + h * 64 + 16 * dt + l15] = (bf16)f2bf(o[dt][e] * inv); } } while (0)
        {
            const int r0_ = F.wave >> 2, qb0_ = F.wave & 3;
            NA_LOADQ(qn, CTXL + r0_ * 64 + 16 * qb0_); NA_LOADK(kfa, NA_START(r0_), NA_CC0(qb0_), 0); NA_LOADV(vfa, NA_START(r0_), NA_CC0(qb0_), 0);
        }
#pragma unroll 1
        for (int i = 0; i < 16; ++i) {
            const int uu = F.wave + 8 * i; const int r = uu >> 2, qb = uu & 3; const int Rq = CTXL + r * 64 + 16 * qb;
            const int start = NA_START(r), cc0 = NA_CC0(qb);
            const int qc = 16 * qb + l15; const int cs = qc - 8 < 0 ? 0 : (qc - 8 > 48 ? 48 : qc - 8);
            qf[0] = qn[0]; qf[1] = qn[1];
            int cko = l15 * CK_STRIDE + 16 * g4, cvo = l15 * CV_STRIDE + 8 * g4; asm volatile("" : "+v"(cko), "+v"(cvo));
            float mrun = -1e30f, lrun = 0.f;
            f32x4 o[4];
#pragma unroll
            for (int dt = 0; dt < 4; ++dt) o[dt] = (f32x4){0.f, 0.f, 0.f, 0.f};
            NA_LOADK(kfb, start, cc0, 1); __builtin_amdgcn_sched_barrier(0);
            NA_BLOCK_WIN(kfa, vfa, 0); __builtin_amdgcn_sched_barrier(0);
            NA_LOADV(vfa, start, cc0, 1); NA_LOADK(kfa, start, cc0, 2); __builtin_amdgcn_sched_barrier(0);
            NA_BLOCK_WIN(kfb, vfa, 1); __builtin_amdgcn_sched_barrier(0);
            NA_LOADV(vfa, start, cc0, 2); NA_LOADK(kfb, start, cc0, 3); __builtin_amdgcn_sched_barrier(0);
            NA_BLOCK_WIN(kfa, vfa, 2); __builtin_amdgcn_sched_barrier(0);
            NA_LOADV(vfa, start, cc0, 3); __builtin_amdgcn_sched_barrier(0);
            {
                const int un = uu + 8; const int rn = un >> 2, qbn = un & 3;
                if (i < 15) { NA_LOADQ(qn, CTXL + rn * 64 + 16 * qbn); NA_LOADK(kfa, NA_START(rn), NA_CC0(qbn), 0); }
                else NA_LOADQ(qn, 16 * (un - 128));
            }
            __builtin_amdgcn_sched_barrier(0);
            NA_BLOCK_WIN(kfb, vfa, 3); __builtin_amdgcn_sched_barrier(0);
            if (i < 15) { const int un = uu + 8; NA_LOADV(vfa, NA_START(un >> 2), NA_CC0(un & 3), 0); }
            __builtin_amdgcn_sched_barrier(0);
            NA_BLOCK_CTX(0); __builtin_amdgcn_sched_barrier(0); NA_BLOCK_CTX(1); __builtin_amdgcn_sched_barrier(0); NA_BLOCK_CTX(2); __builtin_amdgcn_sched_barrier(0); NA_BLOCK_CTX(3); __builtin_amdgcn_sched_barrier(0);
            NA_FINISH(Rq);
        }
#pragma unroll 1
        for (int i = 16; i < 18; ++i) {
            const int uu = F.wave + 8 * i; const int Rq = 16 * (uu - 128);
            qf[0] = qn[0]; qf[1] = qn[1];
            if (i == 16) NA_LOADQ(qn, 16 * (uu + 8 - 128));
            int cko = l15 * CK_STRIDE + 16 * g4, cvo = l15 * CV_STRIDE + 8 * g4; asm volatile("" : "+v"(cko), "+v"(cvo));
            float mrun = -1e30f, lrun = 0.f;
            f32x4 o[4];
#pragma unroll
            for (int dt = 0; dt < 4; ++dt) o[dt] = (f32x4){0.f, 0.f, 0.f, 0.f};
            NA_BLOCK_CTX(0); __builtin_amdgcn_sched_barrier(0); NA_BLOCK_CTX(1); __builtin_amdgcn_sched_barrier(0); NA_BLOCK_CTX(2); __builtin_amdgcn_sched_barrier(0); NA_BLOCK_CTX(3); __builtin_amdgcn_sched_barrier(0);
            NA_FINISH(Rq);
        }
#undef NA_CC0
#undef NA_START
#undef NA_TK
#undef NA_LOADQ
#undef NA_LOADK
#undef NA_LOADV
#undef NA_SOFTMAX
#undef NA_BLOCK_WIN
#undef NA_BLOCK_CTX
#undef NA_FINISH
        __syncthreads();
    }
}

__device__ __forceinline__ void final_norm_phase(const Frame& F0, const bf16* xfin, float* out, const float* gain) {
    const Frame F = refresh(F0);
    for (int row = F.gw; row < NBATCH * SEQ; row += F.NGW) {
        const bf16* src = xfin + (size_t)row * D; float* dst = out + (size_t)row * D;
        f32x4 v[4]; float ss = 0.f;
#pragma unroll
        for (int j = 0; j < 4; ++j) { const u32x2 w = *(const u32x2*)(src + 4 * F.lane + 256 * j); v[j] = (f32x4){bflo(w.x), bfhi(w.x), bflo(w.y), bfhi(w.y)};
            ss += (v[j].x * v[j].x + v[j].y * v[j].y) + (v[j].z * v[j].z + v[j].w * v[j].w); }
        const float rstd = 1.f / sqrtf(wave_sum(ss, F.lane) * (1.f / D) + EPS);
#pragma unroll
        for (int j = 0; j < 4; ++j) { const int c = 4 * F.lane + 256 * j; const f32x4 gn = *(const f32x4*)(gain + c); *(f32x4*)(dst + c) = (v[j] * rstd) * gn; }
    }
}

__device__ __forceinline__ void dbg_check_ffn(const Frame& F0, const float* up, const float* cw, const float* cb) {
    const Frame F = refresh(F0);
    if (F.vcu != 0 || F.tid >= 1) return;
    const bf16* Hh = (const bf16*)(F.ws + WS_ACT + A_H); const bf16* ACT = (const bf16*)(F.ws + WS_ACT + A_ACT);
    const int row = 276, c = 5;
    float u[2][5];
    for (int half = 0; half < 2; ++half) for (int k = 0; k < 5; ++k) {
        const int rr = row + (k == 0 ? -16 : (k == 4 ? 16 : k - 2)); const int col = half * FFN + c;
        float d = 0.f; for (int q = 0; q < 1024; ++q) d += bf2f(Hh[(size_t)rr * 1024 + q]) * up[(size_t)q * FFN2 + col]; u[half][k] = d; }
    const float got = bf2f(ACT[(size_t)row * FFN + c]);
    unsigned code = 9;
    for (int hyp = 8; hyp >= 1; --hyp) {
        float uv2[2];
        for (int half = 0; half < 2; ++half) { const int col = half * FFN + c; const float w0 = cw[col], w1 = cw[FFN2 + col], w2 = cw[2 * FFN2 + col], b = cb[col];
            float pv = u[half][1], cv = u[half][2], nv = u[half][3];
            if (hyp == 2) { pv = u[half][3]; nv = u[half][1]; }
            if (hyp == 3) { pv = 0.f; nv = 0.f; }
            if (hyp == 4) { pv = u[half][0]; nv = u[half][4]; }
            if (hyp == 5) { pv = u[half][4]; nv = u[half][0]; }
            if (hyp == 6) { pv = 0.f; }
            if (hyp == 7) { nv = 0.f; }
            if (hyp == 8) { pv = cv; nv = cv; }
            uv2[half] = b + w0 * pv + w1 * cv + w2 * nv; }
        const float ref = silu_f(uv2[0]) * uv2[1];
        if (fabsf(ref - got) <= 0.03f + 0.03f * fabsf(ref)) code = hyp;
    }
    atomicMin((unsigned*)(F.ws + WS_CTL) + CW_DBG, code);
}

__global__ void __launch_bounds__(NTHR, 2) mega_fwd(Args a) {
    extern __shared__ __attribute__((aligned(16))) unsigned char lds_raw[];
    Frame F;
    F.lds = (LAS unsigned char*)lds_raw;
    F.tid = threadIdx.x; F.lane = F.tid & 63; F.wave = __builtin_amdgcn_readfirstlane(F.tid >> 6);
    F.G = gridDim.x; { const int bx = blockIdx.x; F.vcu = (F.G % 8 == 0) ? (bx % 8) * (F.G / 8) + bx / 8 : bx; }
    F.gw = F.vcu * NWAVES + F.wave; F.NGW = F.G * NWAVES; F.ws = AWS;
    volatile LAS unsigned* MISC = (volatile LAS unsigned*)(F.lds + MISC_OFF);
    for (int u = F.tid; u < (LDS_BYTES - MISC_OFF) / 4; u += NTHR) ((LAS unsigned*)(F.lds + MISC_OFF))[u] = 0u;
    __syncthreads();
    unsigned* ctl = (unsigned*)(AWS + WS_CTL);
    XcdBarrier bar = xcd_barrier_post(ctl + CW_BAR, MISC + 8);
    (void)bar;
#define GRID_BAR() do { XcdBarrier b_; b_.bar = (unsigned*)(AWS + WS_CTL) + CW_BAR; unsigned x_ = xb_xcc_id(); asm volatile("" : "+s"(x_)); b_.x = x_; \
        b_.st = (volatile LAS unsigned*)(F.lds + MISC_OFF) + 8; b_.t0 = (F.wave == 0) && (lane_id() == 0); xcd_barrier(b_); } while (0)
#define MOD ((const float*)(AWS + WS_MOD))
#define XS ((bf16*)AOUT)
#define CS ((bf16*)(AWS + WS_CTX))
#define XFIN ((bf16*)(AWS + WS_ACT + A_H))
#define Wb ((bf16*)(AWS + WS_W))
#define H ((bf16*)(AWS + WS_ACT + A_H))
    const int bx = (int)blockIdx.x;

    if (DBG && blockIdx.x == 0 && threadIdx.x == 0) __hip_atomic_store((unsigned*)(AWS + WS_CTL) + CW_DBG, 0xffffffffu, RLX_AGENT);
    if (EN(1)) prologue(F); if (DUP & (1 << 1)) { GRID_BAR(); prologue(F); }
    GRID_BAR();

#define GEMM_BF16(Aptr, Btptr, M_, N_, K_, Optr, ldc_) do { pg8::Gemm gg{(const bf16*)(Aptr), (const bf16*)(Btptr), (M_), (N_), (K_)}; pg8::StaticOrder So; So.init((M_), (N_), F.G, bx); \
        pg8::EpiBf16 Ee{(bf16*)(Optr), (ldc_)}; pg8::gemm_phase<pg8::EpiBf16, pg8::StaticOrder, true>(F.lds, gg, So, Ee, F.wave); } while (0)
#define STATP ((float*)(AWS + WS_STAT))
#define TBP ((const float*)(AWS + WS_T))
#define GEMM_BF16N(SW, Aptr, Btptr, M_, N_, K_, Optr, ldc_, tile0_, Toff_, ldt_) do { pg8::Gemm gg{(const bf16*)(Aptr), (const bf16*)(Btptr), (M_), (N_), (K_)}; pg8::StaticOrder So; So.init((M_), (N_), F.G, bx); \
        pg8::EpiBf16N<SW> Ee{(bf16*)(Optr), (ldc_), STATP, TBP + (Toff_), (ldt_), F.lds + NSLOT_OFF, (tile0_)}; pg8::gemm_phase<pg8::EpiBf16N<SW>, pg8::StaticOrder, true>(F.lds, gg, So, Ee, F.wave); } while (0)
#define GEMM_RESID(Aptr, Btptr, M_, K_, sx, sc, f32s_, dx_, layer, goff_, b0_, NL_, NF_) do { pg8::Gemm gg{(const bf16*)(Aptr), (const bf16*)(Btptr), (M_), D, (K_)}; pg8::StaticOrder So; So.init((M_), D, F.G, bx, (layer) == 3 ? 1 : 0); \
        pg8::EpiResid Ee{(sx), (sc), (dx_), CS, MOD + (size_t)(layer) * 33 * NMOD, (goff_), (b0_), (f32s_), \
            (NF_) < 0 ? (bf16*)nullptr : H, ((NF_) == 0 && (NL_) == 3) ? HALT - (size_t)TG * D : H, ((NF_) > 0 ? AIN(I_NFFN) : AIN(I_NMIX)) + (NL_) * D, MOD + (size_t)(NL_) * 33 * NMOD, (NF_) > 0 ? 4 * D : D, STATP, F.lds + 131072}; \
        pg8::gemm_phase<pg8::EpiResid, pg8::StaticOrder, true>(F.lds, gg, So, Ee, F.wave); } while (0)
#define FFN_BLOCK(layer) do { \
        { bf16* Wup = Wb + (W_FFN + (size_t)(layer) * (16 * MiB + 512 * 1024)) / 2; bf16* Wdn = Wup + (11 * MiB) / 2; \
          for (int rep_ = 0; rep_ < ((DUP & (1 << 15)) ? 2 : 1); ++rep_) { if (rep_) GRID_BAR(); if (EN(3)) { pg8::Gemm gg{H, Wup, NBATCH * PT, FFN2, D}; pg8::StaticOrder So; So.init(NBATCH * PT, FFN2, F.G, bx, (layer) == 3 ? 1 : 0); \
              pg8::EpiConvGate Ee{(bf16*)(AWS + WS_ACT + A_ACT), (bf16*)(AWS + WS_ACT + A_EDGE), AIN(I_FCW) + (size_t)(layer) * 3 * FFN2, AIN(I_FCB) + (size_t)(layer) * FFN2, F.lds + 131072, F.lds + MISC_OFF + 512, STATP, TBP + TB_FFN + (size_t)(layer) * TB_FFN_SZ, F.lds + NSLOT_OFF}; \
              pg8::gemm_phase<pg8::EpiConvGate, pg8::StaticOrder, true>(F.lds, gg, So, Ee, F.wave); } } GRID_BAR(); \
          if (EN(4)) ffn_fix_phase(F, AIN(I_FCW) + (size_t)(layer) * 3 * FFN2, AIN(I_FCB) + (size_t)(layer) * FFN2); GRID_BAR(); \
          if (DBG && (layer) == 0) { dbg_check_ffn(F, AIN(I_UP), AIN(I_FCW), AIN(I_FCB)); GRID_BAR(); } \
          if (EN(5)) GEMM_RESID(AWS + WS_ACT + A_ACT, Wdn, NBATCH * PT, FFN, XS, CS, 0, (layer) == 3 ? XFIN : XS, (layer), 5 * D, 0, (layer) + 1, (layer) < 3 ? 0 : -1); GRID_BAR(); } } while (0)
#define HALT (XS + (size_t)NBATCH * SEQ * D)
#define RET_MIXER(layer, j, sx, sc, f32s_, DN_) do { \
        if (!(DN_)) { if (EN(2)) norm_phase(F, g * NB, TG, (sx), (sc), (f32s_), AIN(I_NMIX) + (layer) * D, MOD + (size_t)(layer) * 33 * NMOD, 0, D); GRID_BAR(); } \
        { bf16* Wa = Wb + (W_RET + (size_t)(j) * 18 * MiB) / 2; bf16* Wbb = Wa + (8 * MiB) / 2; const bf16* Hg = ((DN_) && g == 1) ? HALT : H; \
          if (EN(3)) { pg8::Gemm gg{Hg, Wa, TG, 4096, D}; pg8::StaticOrder So; So.init(TG, 4096, F.G, bx); pg8::EpiRopeQ<DN_> Ee{(bf16*)(AWS + WS_ACT + A_QKG), (const float*)(AWS + WS_ROPE), STATP, TBP + TB_RETA, F.lds + NSLOT_OFF, g * 144}; \
              pg8::gemm_phase<pg8::EpiRopeQ<DN_>, pg8::StaticOrder, true>(F.lds, gg, So, Ee, F.wave); } \
          if (EN(3)) { pg8::Gemm gg{Wbb, Hg, 3072, TG, D}; pg8::StaticOrder So; So.init(3072, TG, F.G, bx); pg8::EpiRopeKT<DN_> Ee{(bf16*)(AWS + WS_ACT + A_KVT), (const float*)(AWS + WS_ROPE), TG, STATP, TBP + TB_RETB, F.lds + NSLOT_OFF, g * 144}; \
              pg8::gemm_phase<pg8::EpiRopeKT<DN_>, pg8::StaticOrder, true>(F.lds, gg, So, Ee, F.wave); } GRID_BAR(); \
          if (EN(7)) ret_scan_phase(F, AIN(I_RDEC) + (j) * 8, (size_t)g * 144 * MiB); GRID_BAR(); \
          if (EN(8)) ret_gn_phase(F, AIN(I_RGN) + (j) * 2048, (size_t)g * 144 * MiB); GRID_BAR(); } } while (0)
#define RET_OUT(layer, j, sx, sc, f32s_) do { bf16* Wo = Wb + (W_RET + (size_t)(j) * 18 * MiB + 14 * MiB) / 2; \
        if (EN(5)) GEMM_RESID(AWS + WS_ACT + A_Y, Wo, NBATCH * PT, 2048, (sx), (sc), (f32s_), XS, (layer), 2 * D, 0, (layer), 1); GRID_BAR(); } while (0)

    if (EN(2)) t_phase(F);
    for (int g = 0; g < NG; ++g) RET_MIXER(0, 0, AIN(I_X), AIN(I_CTX), 1, false);
    RET_OUT(0, 0, AIN(I_X), AIN(I_CTX), 1);
    FFN_BLOCK(0);
    for (int g = 0; g < NG; ++g) {
        if (EN(3)) GEMM_BF16N(false, H + (size_t)g * TG * D, Wb + W_LRU_IN / 2, TG, 2560, D, AWS + WS_ACT + A_YX, 2560, g * 144, TB_LRU, 2560); GRID_BAR();
        if (EN(10)) lru_gate_phase(F, AIN(I_LCW), AIN(I_LCB), AIN(I_LGB), AIN(I_LLAM)); GRID_BAR();
        if (EN(11)) lru_scan_phase(F, (size_t)g * 90 * MiB); GRID_BAR();
    }
    if (EN(5)) GEMM_RESID(AWS + WS_ACT + A_A3, Wb + W_LRU_OUT / 2, NBATCH * PT, LW, XS, CS, 0, XS, 1, 2 * D, 0, 1, 1); GRID_BAR();
    FFN_BLOCK(1);
    for (int g = 0; g < NG; ++g) {
        if (EN(3)) GEMM_BF16N(false, H + (size_t)g * TG * D, Wb + W_NA_QK / 2, TG, 2048, D, AWS + WS_ACT + A_QK, 2048, g * 144, TB_NAQK, 2048);
        if (EN(3)) GEMM_BF16N(true, Wb + W_NA_V / 2, H + (size_t)g * TG * D, 1024, TG, D, AWS + WS_ACT + A_VT, TG, g * 144, TB_NAV, 1024); GRID_BAR();
        if (EN(13)) na_attn_phase(F, AIN(I_NRPB), (size_t)g * 72 * MiB); GRID_BAR();
    }
    if (EN(5)) GEMM_RESID(AWS + WS_ACT + A_O, Wb + W_NA_O / 2, NBATCH * PT, D, XS, CS, 0, XS, 2, 2 * D, 0, 2, 1); GRID_BAR();
    FFN_BLOCK(2);
    for (int g = 0; g < NG; ++g) RET_MIXER(3, 1, XS, CS, 0, true);
    RET_OUT(3, 1, XS, CS, 0);
    FFN_BLOCK(3);
    if (EN(14)) final_norm_phase(F, XFIN, AOUT, AIN(I_FNORM));
    if (DBG) { GRID_BAR(); const unsigned code = __hip_atomic_load((unsigned*)(AWS + WS_CTL) + CW_DBG, RLX_AGENT);
        if (code != 0xffffffffu) { float* o = AOUT; for (size_t i = (size_t)blockIdx.x * NTHR + threadIdx.x; i < (size_t)NBATCH * SEQ * D; i += (size_t)gridDim.x * NTHR) o[i] = 1000.f * (float)code; } }
}

extern "C" void kernel_launch(void* const* d_in, const int* in_sizes, int n_in, void* d_out, int out_size, void* d_ws, size_t ws_size, hipStream_t stream) {
    static int grid = 0;
    if (grid == 0) {
        if (n_in != 27 || ws_size < WS_END) { fprintf(stderr, "kernel_launch: need 27 inputs and >= %zu bytes of workspace; got %d, %zu\n", (size_t)WS_END, n_in, ws_size); grid = -1; return; }
        int dev = 0, cus = 0, per_cu = 0;
        if (hipGetDevice(&dev) != hipSuccess || hipDeviceGetAttribute(&cus, hipDeviceAttributeMultiprocessorCount, dev) != hipSuccess) { grid = -1; return; }
        if (hipFuncSetAttribute((const void*)mega_fwd, hipFuncAttributeMaxDynamicSharedMemorySize, LDS_BYTES) != hipSuccess) { fprintf(stderr, "kernel_launch: hipFuncSetAttribute failed\n"); grid = -1; return; }
        if (hipOccupancyMaxActiveBlocksPerMultiprocessor(&per_cu, (const void*)mega_fwd, NTHR, LDS_BYTES) != hipSuccess || per_cu < 1) { fprintf(stderr, "kernel_launch: occupancy query says %d\n", per_cu); }
        (void)hipGetLastError();
        grid = cus;
    }
    if (grid < 0) return;
    (void)hipMemsetAsync((char*)d_ws + WS_CTL, 0, CTL_ZERO_BYTES, stream);
    Args a{};
    for (int i = 0; i < 27; ++i) a.in[i] = (const float*)d_in[i];
    a.out = (float*)d_out; a.ws = (unsigned char*)d_ws;
    hipLaunchKernelGGL(mega_fwd, dim3(grid), dim3(NTHR), LDS_BYTES, stream, a);
}
```

```cpp
#include <hip/hip_runtime.h>
#include <cstdio>
#include <cstdint>

#ifndef DBG
#define DBG 0
#endif
#ifndef ONLY
#define ONLY 0
#endif
#define EN(k) (ONLY == 0 || ONLY == (k))
#ifndef DUP
#define DUP 0
#endif

#define GAS __attribute__((address_space(1)))
#define LAS __attribute__((address_space(3)))
typedef unsigned short bf16;
typedef short bf16x8 __attribute__((ext_vector_type(8)));
typedef float f32x4 __attribute__((ext_vector_type(4)));
typedef float f32x2 __attribute__((ext_vector_type(2)));
typedef unsigned u32x4 __attribute__((ext_vector_type(4)));
typedef unsigned u32x2 __attribute__((ext_vector_type(2)));
typedef GAS unsigned gu32;

__device__ __forceinline__ int lane_id() { unsigned m = ~0u; asm volatile("" : "+s"(m)); return (int)__builtin_amdgcn_mbcnt_hi(m, __builtin_amdgcn_mbcnt_lo(m, 0u)); }
namespace pg8 {
#define PG8_LAS __attribute__((address_space(3)))
typedef unsigned short bf16_t;
constexpr int BM = 256, BK = 64, HALF = 128, HTB = HALF * BK * 2, STAGE_BYTES = 8 * HTB, NXCD = 8, WGM = 8;
__host__ __device__ __forceinline__ int lds_byte(int r, int c) { const int st = (r >> 4) * 2 + (c >> 5), rr = r & 15, cc = c & 31, ob = rr * 64 + cc * 2; return st * 1024 + (ob ^ (((ob >> 9) & 1) << 5)); }
__host__ __device__ __forceinline__ void stage_rc(int b, int& R, int& C) { const int st = b / 1024, sb = b % 1024, swz = sb ^ (((sb >> 9) & 1) << 5); R = (st >> 1) * 16 + swz / 64; C = (st & 1) * 32 + (swz % 64) / 2; }
__host__ __device__ __forceinline__ int perm32(int rho) { const int n = rho >> 4, i = rho & 15; return 8 * (i >> 2) + 4 * n + (i & 3); }
struct Unit { int pm, pn; };
struct Gemm { const bf16_t* A; const bf16_t* Bt; int M, N, K; };
struct StaticOrder {
    int nM, nN, nwg, G, c;
    __host__ __device__ __forceinline__ void init(int M, int N, int G_, int c_, int lat_ = 0) { nM = M / BM; if (lat_) nM = nM / 9 * 8; nN = N / BM; nwg = nM * nN; G = G_; c = c_; if (lat_) nN = -nN; }
    __host__ __device__ __forceinline__ bool next(int i, Unit& u) const {
        const long L = (long)i * G + c; if (L >= nwg) return false;
        const int nn = nN < 0 ? -nN : nN;
        int wgid = (int)L; { const int q = nwg / NXCD, r = nwg % NXCD, xcd = wgid % NXCD, off = wgid / NXCD; wgid = (xcd < r ? xcd * (q + 1) : r * (q + 1) + (xcd - r) * q) + off; }
        const int nig = WGM * nn, gid = wgid / nig, fm = gid * WGM, gsz = (nM - fm) < WGM ? (nM - fm) : WGM;
        u.pm = fm + ((wgid % nig) % gsz); u.pn = (wgid % nig) / gsz; if (nN < 0) u.pm += (u.pm >> 3) + 1; return true;
    }
    __device__ __forceinline__ void a_ready(const Unit&) const {}
    __device__ __forceinline__ void done(const Unit&) const {}
};
__device__ __forceinline__ unsigned cvt_pk_bf16(float lo, float hi) { unsigned r; asm volatile("v_cvt_pk_bf16_f32 %0, %1, %2" : "=v"(r) : "v"(lo), "v"(hi)); return r; }

struct EpiBf16 {
    static constexpr bool PERM = true, AFTER_DRAIN = false, PERMA = false;
    bf16_t* O; int ldc;
    __device__ __forceinline__ f32x2 pre(const Unit&, int, int) const { return (f32x2){0.f, 0.f}; }
    __device__ __forceinline__ void operator()(const f32x4 (&acc)[2][2][4][2], const Unit& u, int wr, int wc, int fr_, int fq_, f32x2) const {
        int fr = fr_, fq = fq_; asm volatile("" : "+v"(fr), "+v"(fq));
        const int row0 = u.pm * BM + wr * 64 + fr; const int col0 = u.pn * BM + wc * 32 + 8 * fq;
#pragma unroll
        for (int ai = 0; ai < 2; ++ai)
#pragma unroll
            for (int m = 0; m < 4; ++m) { bf16_t* rowp = O + (size_t)(row0 + ai * HALF + m * 16) * ldc + col0;
#pragma unroll
                for (int bj = 0; bj < 2; ++bj) { const f32x4 v0 = acc[ai][bj][m][0], v1 = acc[ai][bj][m][1];
                    u32x4 w; w.x = cvt_pk_bf16(v0[0], v0[1]); w.y = cvt_pk_bf16(v0[2], v0[3]); w.z = cvt_pk_bf16(v1[0], v1[1]); w.w = cvt_pk_bf16(v1[2], v1[3]);
                    *(u32x4*)(rowp + bj * HALF) = w; } }
    }
};
constexpr int NSLOT_BYTES = 5120;
__device__ __forceinline__ void norm_pre(const float* stat, const float* T, int ldt, int tok_tile, int feat_tile, PG8_LAS unsigned char* nl, int tid_, int slot) {
    int tid = tid_; asm volatile("" : "+v"(tid));
    const int wv = __builtin_amdgcn_readfirstlane(tid >> 6), lane = tid & 63;
    const int mr = (tok_tile % 9 == 0) ? 32 : tok_tile / 9;
    if (wv < 4) __builtin_amdgcn_global_load_lds((const unsigned*)(stat + ((size_t)tok_tile * 256 + wv * 64 + lane) * 4), (PG8_LAS unsigned*)(nl + slot * NSLOT_BYTES + wv * 1024), 16, 0, 0);
    else if (wv == 4) __builtin_amdgcn_global_load_lds((const unsigned*)(T + (size_t)mr * ldt + feat_tile * 256 + lane * 4), (PG8_LAS unsigned*)(nl + slot * NSLOT_BYTES + 4096), 16, 0, 0);
}
__device__ __forceinline__ float norm_rstd(const PG8_LAS float* NL, int tok) { const f32x4 p = *(const PG8_LAS f32x4*)(NL + tok * 4); return __builtin_amdgcn_rsqf(((p.x + p.y) + (p.z + p.w)) * (1.f / 1024.f) + 1e-6f); }
template <bool NORM>
struct EpiRopeQ {
    static constexpr bool PERM = true, AFTER_DRAIN = false, PERMA = false;
    bf16_t* O; const float* RT; const float* stat; const float* T; PG8_LAS unsigned char* nl; int tile0;
    __device__ __forceinline__ f32x2 pre(const Unit& u, int tid, int slot) const { if (NORM) norm_pre(stat, T, 4096, tile0 + u.pm, u.pn, nl, tid, slot); return (f32x2){__int_as_float(slot), 0.f}; }
    __device__ __forceinline__ void operator()(const f32x4 (&acc)[2][2][4][2], const Unit& u, int wr, int wc, int fr_, int fq_, f32x2 wpre) const {
        int fr = fr_, fq = fq_; asm volatile("" : "+v"(fr), "+v"(fq));
        const PG8_LAS float* NL = (const PG8_LAS float*)(nl + __builtin_amdgcn_readfirstlane(__float_as_int(wpre.x)) * NSLOT_BYTES);
        f32x4 tc[2][2];
#pragma unroll
        for (int bj = 0; bj < 2; ++bj)
#pragma unroll
            for (int n = 0; n < 2; ++n) tc[bj][n] = NORM ? *(const PG8_LAS f32x4*)(NL + 1024 + bj * HALF + wc * 32 + 8 * fq + 4 * n) : (f32x4){0.f, 0.f, 0.f, 0.f};
#define RQ_VAL(ai, bj, m, n, rs) (NORM ? acc[ai][bj][m][n] * (rs) + tc[bj][n] : acc[ai][bj][m][n])
        if (u.pn >= 8) {
            const int row0 = u.pm * BM + wr * 64 + fr; const int col0 = u.pn * BM + wc * 32 + 8 * fq;
#pragma unroll
            for (int ai = 0; ai < 2; ++ai)
#pragma unroll
                for (int m = 0; m < 4; ++m) { bf16_t* rowp = O + (size_t)(row0 + ai * HALF + m * 16) * 4096 + col0;
                    const float rs = NORM ? norm_rstd(NL, ai * HALF + wr * 64 + m * 16 + fr) : 1.f;
#pragma unroll
                    for (int bj = 0; bj < 2; ++bj) { const f32x4 v0 = RQ_VAL(ai, bj, m, 0, rs), v1 = RQ_VAL(ai, bj, m, 1, rs);
                        u32x4 w; w.x = cvt_pk_bf16(v0[0], v0[1]); w.y = cvt_pk_bf16(v0[2], v0[3]); w.z = cvt_pk_bf16(v1[0], v1[1]); w.w = cvt_pk_bf16(v1[2], v1[3]);
                        *(u32x4*)(rowp + bj * HALF) = w; } }
            return;
        }
        const int pt = u.pm % 9; const bool lat = pt != 0;
        const int hfj = wc >> 1, m0 = (32 * wc + 8 * fq) & 63;
#pragma unroll
        for (int ai = 0; ai < 2; ++ai)
#pragma unroll
            for (int m = 0; m < 4; ++m) { const int rl = ai * HALF + wr * 64 + m * 16 + fr;
                bf16_t* rowp = O + (size_t)(u.pm * BM + rl) * 4096 + u.pn * BM + 128 * hfj + m0;
                const float rs = NORM ? norm_rstd(NL, rl) : 1.f;
                f32x4 a0 = RQ_VAL(ai, 0, m, 0, rs), a1 = RQ_VAL(ai, 0, m, 1, rs), b0 = RQ_VAL(ai, 1, m, 0, rs), b1 = RQ_VAL(ai, 1, m, 1, rs);
                if (lat) { const int t = (pt - 1) * 256 + rl; const int pos = hfj == 0 ? (t >> 6) : (t & 63);
                    const float* cp = RT + 2 * (pos * 64 + m0);
                    const f32x4 c0 = *(const f32x4*)cp, c1 = *(const f32x4*)(cp + 4), c2 = *(const f32x4*)(cp + 8), c3 = *(const f32x4*)(cp + 12);
                    const f32x4 co0 = (f32x4){c0.x, c0.z, c1.x, c1.z}, si0 = (f32x4){c0.y, c0.w, c1.y, c1.w}, co1 = (f32x4){c2.x, c2.z, c3.x, c3.z}, si1 = (f32x4){c2.y, c2.w, c3.y, c3.w};
                    const f32x4 n0 = a0 * co0 - b0 * si0, n1 = a1 * co1 - b1 * si1; b0 = a0 * si0 + b0 * co0; b1 = a1 * si1 + b1 * co1; a0 = n0; a1 = n1; }
                u32x4 w; w.x = cvt_pk_bf16(a0[0], a0[1]); w.y = cvt_pk_bf16(a0[2], a0[3]); w.z = cvt_pk_bf16(a1[0], a1[1]); w.w = cvt_pk_bf16(a1[2], a1[3]);
                *(u32x4*)rowp = w;
                w.x = cvt_pk_bf16(b0[0], b0[1]); w.y = cvt_pk_bf16(b0[2], b0[3]); w.z = cvt_pk_bf16(b1[0], b1[1]); w.w = cvt_pk_bf16(b1[2], b1[3]);
                *(u32x4*)(rowp + 64) = w; }
#undef RQ_VAL
    }
};
template <bool NORM>
struct EpiRopeKT {
    static constexpr bool PERM = true, AFTER_DRAIN = false, PERMA = false;
    bf16_t* O; const float* RT; int ldc; const float* stat; const float* T; PG8_LAS unsigned char* nl; int tile0;
    __device__ __forceinline__ f32x2 pre(const Unit& u, int tid, int slot) const { if (NORM) norm_pre(stat, T, 3072, tile0 + u.pn, u.pm, nl, tid, slot); return (f32x2){__int_as_float(slot), 0.f}; }
    __device__ __forceinline__ void operator()(const f32x4 (&acc)[2][2][4][2], const Unit& u, int wr, int wc, int fr_, int fq_, f32x2 wpre) const {
        int fr = fr_, fq = fq_; asm volatile("" : "+v"(fr), "+v"(fq));
        const PG8_LAS float* NL = (const PG8_LAS float*)(nl + __builtin_amdgcn_readfirstlane(__float_as_int(wpre.x)) * NSLOT_BYTES);
        f32x4 rc[2][2];
#pragma unroll
        for (int bj = 0; bj < 2; ++bj)
#pragma unroll
            for (int n = 0; n < 2; ++n) { const int cl = bj * HALF + wc * 32 + 8 * fq + 4 * n;
                rc[bj][n] = NORM ? (f32x4){norm_rstd(NL, cl), norm_rstd(NL, cl + 1), norm_rstd(NL, cl + 2), norm_rstd(NL, cl + 3)} : (f32x4){1.f, 1.f, 1.f, 1.f}; }
#define RK_VAL(ai, bj, m, n) (NORM ? acc[ai][bj][m][n] * rc[bj][n] + NL[1024 + (ai) * HALF + wr * 64 + (m) * 16 + fr] : acc[ai][bj][m][n])
        const int col0 = u.pn * BM + wc * 32 + 8 * fq;
        if (u.pm >= 4) {
            const int row0 = u.pm * BM + wr * 64 + fr;
#pragma unroll
            for (int ai = 0; ai < 2; ++ai)
#pragma unroll
                for (int m = 0; m < 4; ++m) { bf16_t* rowp = O + (size_t)(row0 + ai * HALF + m * 16) * ldc + col0;
#pragma unroll
                    for (int bj = 0; bj < 2; ++bj) { const f32x4 v0 = RK_VAL(ai, bj, m, 0), v1 = RK_VAL(ai, bj, m, 1);
                        u32x4 w; w.x = cvt_pk_bf16(v0[0], v0[1]); w.y = cvt_pk_bf16(v0[2], v0[3]); w.z = cvt_pk_bf16(v1[0], v1[1]); w.w = cvt_pk_bf16(v1[2], v1[3]);
                        *(u32x4*)(rowp + bj * HALF) = w; } }
            return;
        }
        const int pt = u.pn % 9; const bool lat = pt != 0;
#pragma unroll
        for (int m = 0; m < 4; ++m) { const int mi = m * 16 + fr;
            bf16_t* rowp = O + (size_t)(u.pm * BM + 128 * wr + mi) * ldc + col0;
#pragma unroll
            for (int bj = 0; bj < 2; ++bj) {
                f32x4 a0 = RK_VAL(0, bj, m, 0), a1 = RK_VAL(0, bj, m, 1), b0 = RK_VAL(1, bj, m, 0), b1 = RK_VAL(1, bj, m, 1);
                if (lat) { const int tb = (pt - 1) * 256 + bj * HALF + wc * 32 + 8 * fq;
                    f32x4 co0, si0, co1, si1;
                    if (wr == 0) { const f32x2 c = *(const f32x2*)(RT + 2 * ((tb >> 6) * 64 + mi)); co0 = (f32x4){c.x, c.x, c.x, c.x}; si0 = (f32x4){c.y, c.y, c.y, c.y}; co1 = co0; si1 = si0; }
                    else { const float* cp = RT + 2 * ((tb & 63) * 64 + mi);
#pragma unroll
                        for (int e = 0; e < 4; ++e) { const f32x2 c = *(const f32x2*)(cp + 128 * e), d = *(const f32x2*)(cp + 128 * (e + 4)); co0[e] = c.x; si0[e] = c.y; co1[e] = d.x; si1[e] = d.y; } }
                    const f32x4 n0 = a0 * co0 - b0 * si0, n1 = a1 * co1 - b1 * si1; b0 = a0 * si0 + b0 * co0; b1 = a1 * si1 + b1 * co1; a0 = n0; a1 = n1; }
                u32x4 w; w.x = cvt_pk_bf16(a0[0], a0[1]); w.y = cvt_pk_bf16(a0[2], a0[3]); w.z = cvt_pk_bf16(a1[0], a1[1]); w.w = cvt_pk_bf16(a1[2], a1[3]);
                *(u32x4*)(rowp + bj * HALF) = w;
                w.x = cvt_pk_bf16(b0[0], b0[1]); w.y = cvt_pk_bf16(b0[2], b0[3]); w.z = cvt_pk_bf16(b1[0], b1[1]); w.w = cvt_pk_bf16(b1[2], b1[3]);
                *(u32x4*)(rowp + (size_t)64 * ldc + bj * HALF) = w; } }
#undef RK_VAL
    }
};
template <bool SWAP>
struct EpiBf16N {
    static constexpr bool PERM = true, AFTER_DRAIN = false, PERMA = false;
    bf16_t* O; int ldc; const float* stat; const float* T; int ldt; PG8_LAS unsigned char* nl; int tile0;
    __device__ __forceinline__ f32x2 pre(const Unit& u, int tid, int slot) const { norm_pre(stat, T, ldt, tile0 + (SWAP ? u.pn : u.pm), SWAP ? u.pm : u.pn, nl, tid, slot); return (f32x2){__int_as_float(slot), 0.f}; }
    __device__ __forceinline__ void operator()(const f32x4 (&acc)[2][2][4][2], const Unit& u, int wr, int wc, int fr_, int fq_, f32x2 wpre) const {
        int fr = fr_, fq = fq_; asm volatile("" : "+v"(fr), "+v"(fq));
        const PG8_LAS float* NL = (const PG8_LAS float*)(nl + __builtin_amdgcn_readfirstlane(__float_as_int(wpre.x)) * NSLOT_BYTES);
        const int row0 = u.pm * BM + wr * 64 + fr; const int col0 = u.pn * BM + wc * 32 + 8 * fq;
        f32x4 cv[2][2];
#pragma unroll
        for (int bj = 0; bj < 2; ++bj)
#pragma unroll
            for (int n = 0; n < 2; ++n) { const int cl = bj * HALF + wc * 32 + 8 * fq + 4 * n;
                if (!SWAP) cv[bj][n] = *(const PG8_LAS f32x4*)(NL + 1024 + cl);
                else cv[bj][n] = (f32x4){norm_rstd(NL, cl), norm_rstd(NL, cl + 1), norm_rstd(NL, cl + 2), norm_rstd(NL, cl + 3)}; }
#pragma unroll
        for (int ai = 0; ai < 2; ++ai)
#pragma unroll
            for (int m = 0; m < 4; ++m) { bf16_t* rowp = O + (size_t)(row0 + ai * HALF + m * 16) * ldc + col0;
                const int rl = ai * HALF + wr * 64 + m * 16 + fr;
                const float rv = SWAP ? NL[1024 + rl] : norm_rstd(NL, rl);
#pragma unroll
                for (int bj = 0; bj < 2; ++bj) { f32x4 v0, v1;
                    if (!SWAP) { v0 = acc[ai][bj][m][0] * rv + cv[bj][0]; v1 = acc[ai][bj][m][1] * rv + cv[bj][1]; }
                    else { v0 = acc[ai][bj][m][0] * cv[bj][0] + rv; v1 = acc[ai][bj][m][1] * cv[bj][1] + rv; }
                    u32x4 w; w.x = cvt_pk_bf16(v0[0], v0[1]); w.y = cvt_pk_bf16(v0[2], v0[3]); w.z = cvt_pk_bf16(v1[0], v1[1]); w.w = cvt_pk_bf16(v1[2], v1[3]);
                    *(u32x4*)(rowp + bj * HALF) = w; } }
    }
};
struct EpiResid {
    static constexpr bool PERM = true, AFTER_DRAIN = false, PERMA = false;
    const void* src_x; const void* src_c; bf16_t* dst_x; bf16_t* dst_c; const float* modl; int goff; int b0; int f32src;
    bf16_t* Hn; bf16_t* Hn2; const float* ngain; const float* nmodl; int nscoff; float* stat; PG8_LAS unsigned char* eb;
    __device__ __forceinline__ f32x2 pre(const Unit&, int, int) const { return (f32x2){0.f, 0.f}; }
    __device__ __forceinline__ void operator()(const f32x4 (&acc)[2][2][4][2], const Unit& u, int wr, int wc, int fr_, int fq_, f32x2) const {
        int fr = fr_, fq = fq_; asm volatile("" : "+v"(fr), "+v"(fq));
        const int bl = u.pm / 9, pt = u.pm % 9, b = b0 + bl;
        const float* gate = modl + (size_t)(pt == 0 ? 32 : b) * 6144 + goff;
        const size_t rbase = pt == 0 ? (size_t)b * 256 : (size_t)b * 2048 + (size_t)(pt - 1) * 256;
        const void* s = pt == 0 ? src_c : src_x; bf16_t* d = pt == 0 ? dst_c : dst_x;
        const int r0 = wr * 64 + fr, col0 = u.pn * BM + wc * 32 + 8 * fq;
        f32x4 gv[2][2], cf[2][2];
        const bool dn = Hn != nullptr;
#pragma unroll
        for (int bj = 0; bj < 2; ++bj)
#pragma unroll
            for (int n = 0; n < 2; ++n) { gv[bj][n] = *(const f32x4*)(gate + col0 + bj * HALF + 4 * n);
                if (dn) { const float* nsc = nmodl + (size_t)(pt == 0 ? 32 : b) * 6144 + nscoff; cf[bj][n] = *(const f32x4*)(ngain + col0 + bj * HALF + 4 * n) * (*(const f32x4*)(nsc + col0 + bj * HALF + 4 * n) + 1.f); } }
        float ss[2][4];
#pragma unroll
        for (int ai = 0; ai < 2; ++ai)
#pragma unroll
            for (int m = 0; m < 4; ++m) ss[ai][m] = 0.f;
#pragma unroll
        for (int ai = 0; ai < 2; ++ai)
#pragma unroll
            for (int m = 0; m < 4; ++m) { const size_t off = (rbase + (size_t)(r0 + ai * HALF + m * 16)) * 1024 + col0;
#pragma unroll
                for (int bj = 0; bj < 2; ++bj) { f32x4 x0, x1;
                    if (f32src) { const float* sf = (const float*)s + off + bj * HALF; x0 = *(const f32x4*)sf; x1 = *(const f32x4*)(sf + 4); }
                    else { const u32x4 xv = *(const u32x4*)((const bf16_t*)s + off + bj * HALF);
                        x0 = (f32x4){__builtin_bit_cast(float, xv.x << 16), __builtin_bit_cast(float, xv.x & 0xffff0000u), __builtin_bit_cast(float, xv.y << 16), __builtin_bit_cast(float, xv.y & 0xffff0000u)};
                        x1 = (f32x4){__builtin_bit_cast(float, xv.z << 16), __builtin_bit_cast(float, xv.z & 0xffff0000u), __builtin_bit_cast(float, xv.w << 16), __builtin_bit_cast(float, xv.w & 0xffff0000u)}; }
                    const f32x4 o0 = x0 + gv[bj][0] * acc[ai][bj][m][0], o1 = x1 + gv[bj][1] * acc[ai][bj][m][1];
                    u32x4 w; w.x = cvt_pk_bf16(o0[0], o0[1]); w.y = cvt_pk_bf16(o0[2], o0[3]); w.z = cvt_pk_bf16(o1[0], o1[1]); w.w = cvt_pk_bf16(o1[2], o1[3]);
                    *(u32x4*)(d + off + bj * HALF) = w;
                    if (dn) {
                        const f32x4 y0 = (f32x4){__builtin_bit_cast(float, w.x << 16), __builtin_bit_cast(float, w.x & 0xffff0000u), __builtin_bit_cast(float, w.y << 16), __builtin_bit_cast(float, w.y & 0xffff0000u)};
                        const f32x4 y1 = (f32x4){__builtin_bit_cast(float, w.z << 16), __builtin_bit_cast(float, w.z & 0xffff0000u), __builtin_bit_cast(float, w.w << 16), __builtin_bit_cast(float, w.w & 0xffff0000u)};
                        ss[ai][m] += ((y0[0] * y0[0] + y0[1] * y0[1]) + (y0[2] * y0[2] + y0[3] * y0[3])) + ((y1[0] * y1[0] + y1[1] * y1[1]) + (y1[2] * y1[2] + y1[3] * y1[3]));
                        const f32x4 h0 = y0 * cf[bj][0], h1 = y1 * cf[bj][1];
                        u32x4 hw; hw.x = cvt_pk_bf16(h0[0], h0[1]); hw.y = cvt_pk_bf16(h0[2], h0[3]); hw.z = cvt_pk_bf16(h1[0], h1[1]); hw.w = cvt_pk_bf16(h1[2], h1[3]);
                        *(u32x4*)((u.pm < 144 ? Hn : Hn2) + ((size_t)u.pm * BM + (size_t)(r0 + ai * HALF + m * 16)) * 1024 + col0 + bj * HALF) = hw; }
                } }
        if (dn) {
            PG8_LAS float* ST = (PG8_LAS float*)eb;
            const int ln = fr + 16 * fq;
#pragma unroll
            for (int ai = 0; ai < 2; ++ai)
#pragma unroll
                for (int m = 0; m < 4; ++m) { float v = ss[ai][m];
                    v += __builtin_bit_cast(float, __builtin_amdgcn_ds_bpermute((ln ^ 16) << 2, __builtin_bit_cast(int, v)));
                    v += __builtin_bit_cast(float, __builtin_amdgcn_ds_bpermute((ln ^ 32) << 2, __builtin_bit_cast(int, v)));
                    if (fq == 0) ST[(ai * HALF + r0 + m * 16) * 4 + wc] = v; }
            asm volatile("s_waitcnt lgkmcnt(0)" ::: "memory"); __builtin_amdgcn_s_barrier(); asm volatile("" ::: "memory");
            const int t = (wr * 4 + wc) * 64 + ln;
            if (t < 256) { const f32x4 p = *(const PG8_LAS f32x4*)(ST + t * 4); stat[((size_t)u.pm * BM + t) * 4 + u.pn] = (p.x + p.y) + (p.z + p.w); }
        }
    }
};

__device__ __forceinline__ float dpp_prev(float x) { return __int_as_float(__builtin_amdgcn_update_dpp(__float_as_int(x), __float_as_int(x), 0x121, 0xf, 0xf, false)); }
__device__ __forceinline__ float dpp_next(float x) { return __int_as_float(__builtin_amdgcn_update_dpp(__float_as_int(x), __float_as_int(x), 0x12F, 0xf, 0xf, false)); }
__device__ __forceinline__ f32x4 rot_prev(f32x4 v) { f32x4 r; r.x = dpp_prev(v.x); r.y = dpp_prev(v.y); r.z = dpp_prev(v.z); r.w = dpp_prev(v.w); return r; }
__device__ __forceinline__ f32x4 rot_next(f32x4 v) { f32x4 r; r.x = dpp_next(v.x); r.y = dpp_next(v.y); r.z = dpp_next(v.z); r.w = dpp_next(v.w); return r; }
struct EpiConvGate {
    static constexpr bool PERM = true, AFTER_DRAIN = false, PERMA = true;
    bf16_t* ACT; bf16_t* EDGE; const float* cw; const float* cb; PG8_LAS unsigned char* eb; PG8_LAS unsigned char* wl; const float* stat; const float* T; PG8_LAS unsigned char* nl;
    __device__ __forceinline__ f32x2 pre(const Unit& u, int tid, int slot) const { const int wv = __builtin_amdgcn_readfirstlane(tid >> 6), lane = tid & 63;
#pragma unroll
        for (int i = 0; i < 2; ++i) { const int idx = (2 * wv + i) * 64 + lane, k = idx >> 8, j = idx & 255, bj = j >> 7, jj = j & 127;
            const float* p = (k < 3 ? cw + k * 5632 : cb) + bj * 2816 + u.pn * 128 + jj;
            __builtin_amdgcn_global_load_lds((const unsigned*)p, (PG8_LAS unsigned*)(wl + slot * 4096 + (2 * wv + i) * 256), 4, 0, 0); }
        norm_pre(stat, T, 5632, u.pm, u.pn, nl, tid, slot);
        return (f32x2){__int_as_float(slot), 0.f}; }
    __device__ __forceinline__ void operator()(const f32x4 (&acc)[2][2][4][2], const Unit& u, int wr, int wc, int fr_, int fq_, f32x2 wpre) const {
        int fr = fr_, fq = fq_; asm volatile("" : "+v"(fr), "+v"(fq));
        const int slot = __builtin_amdgcn_readfirstlane(__float_as_int(wpre.x));
        PG8_LAS float* E = (PG8_LAS float*)eb; PG8_LAS float* WL = (PG8_LAS float*)(wl + slot * 4096); const PG8_LAS float* NL = (const PG8_LAS float*)(nl + slot * NSLOT_BYTES);
#define EB_IDX(wc_, wr_, ai_, wh_) (((((wc_) * 2 + (wr_)) * 2 + (ai_)) * 2 + (wh_)) * 64 + fq * 16)
        if (fr == 0) {
#pragma unroll
            for (int ai = 0; ai < 2; ++ai) { const float r = norm_rstd(NL, ai * HALF + wr * 64);
#pragma unroll
                for (int bj = 0; bj < 2; ++bj)
#pragma unroll
                    for (int n = 0; n < 2; ++n) *(PG8_LAS f32x4*)(E + EB_IDX(wc, wr, ai, 0) + bj * 8 + n * 4) = acc[ai][bj][0][n] * r; }
        }
        if (fr == 15) {
#pragma unroll
            for (int ai = 0; ai < 2; ++ai) { const float r = norm_rstd(NL, ai * HALF + wr * 64 + 63);
#pragma unroll
                for (int bj = 0; bj < 2; ++bj)
#pragma unroll
                    for (int n = 0; n < 2; ++n) *(PG8_LAS f32x4*)(E + EB_IDX(wc, wr, ai, 1) + bj * 8 + n * 4) = acc[ai][bj][3][n] * r; }
        }
        asm volatile("s_waitcnt lgkmcnt(0)" ::: "memory"); __builtin_amdgcn_s_barrier(); asm volatile("" ::: "memory");
        const f32x4 zero4 = (f32x4){0.f, 0.f, 0.f, 0.f};
        const int c8 = u.pn * 128 + wc * 32 + 8 * fq;
#pragma unroll
        for (int ai = 0; ai < 2; ++ai) {
            float rs[4];
#pragma unroll
            for (int m = 0; m < 4; ++m) rs[m] = norm_rstd(NL, ai * HALF + wr * 64 + 4 * fr + m);
            u32x2 actp[2][4];
#pragma unroll
            for (int n = 0; n < 2; ++n) {
                const int jc = wc * 32 + 8 * fq + 4 * n;
                f32x4 gt[4];
#pragma unroll
                for (int bj = 0; bj < 2; ++bj) {
                    f32x4 w[3];
#pragma unroll
                    for (int k = 0; k < 3; ++k) w[k] = *(const PG8_LAS f32x4*)(WL + k * 256 + bj * 128 + jc);
                    const f32x4 tq = *(const PG8_LAS f32x4*)(NL + 1024 + bj * 128 + jc);
                    const f32x4 bb = *(const PG8_LAS f32x4*)(WL + 3 * 256 + bj * 128 + jc) + tq * ((w[0] + w[1]) + w[2]);
                    f32x4 ep = zero4 - tq, en = zero4 - tq;
                    if (wr == 1) ep = *(const PG8_LAS f32x4*)(E + EB_IDX(wc, 0, ai, 1) + bj * 8 + n * 4);
                    else if (ai == 1) ep = *(const PG8_LAS f32x4*)(E + EB_IDX(wc, 1, 0, 1) + bj * 8 + n * 4);
                    if (wr == 0) en = *(const PG8_LAS f32x4*)(E + EB_IDX(wc, 1, ai, 0) + bj * 8 + n * 4);
                    else if (ai == 0) en = *(const PG8_LAS f32x4*)(E + EB_IDX(wc, 0, 1, 0) + bj * 8 + n * 4);
                    f32x4 a4[4];
#pragma unroll
                    for (int m = 0; m < 4; ++m) a4[m] = acc[ai][bj][m][n] * rs[m];
                    f32x4 pv0 = rot_prev(a4[3]), nv3 = rot_next(a4[0]);
                    pv0 = fr == 0 ? ep : pv0; nv3 = fr == 15 ? en : nv3;
#pragma unroll
                    for (int m = 0; m < 4; ++m) {
                        const f32x4 pv = m == 0 ? pv0 : a4[m == 0 ? 0 : m - 1];
                        const f32x4 nv = m == 3 ? nv3 : a4[m == 3 ? 3 : m + 1];
                        const f32x4 uv = bb + w[0] * pv + w[1] * a4[m] + w[2] * nv;
                        if (bj == 0) {
#pragma unroll
                            for (int e = 0; e < 4; ++e) gt[m][e] = uv[e] * __builtin_amdgcn_rcpf(1.f + __builtin_amdgcn_exp2f(uv[e] * -1.4426950408889634f));
                        } else { const f32x4 o = gt[m] * uv; actp[n][m].x = cvt_pk_bf16(o[0], o[1]); actp[n][m].y = cvt_pk_bf16(o[2], o[3]); }
                    }
                }
            }
#pragma unroll
            for (int m = 0; m < 4; ++m) { const u32x4 pk = (u32x4){actp[0][m].x, actp[0][m].y, actp[1][m].x, actp[1][m].y};
                *(u32x4*)(ACT + (size_t)(u.pm * BM + ai * HALF + wr * 64 + 4 * fr + m) * 2816 + c8) = pk; }
        }
        if ((wr == 0 && fr == 0) || (wr == 1 && fr == 15)) {
#pragma unroll
            for (int k = 0; k < 2; ++k) {
                const int rl = wr == 0 ? k : 254 + k; const float r = norm_rstd(NL, rl);
#pragma unroll
                for (int bj = 0; bj < 2; ++bj) { const int jc = bj * 128 + wc * 32 + 8 * fq;
                    const f32x4 q0 = wr == 0 ? acc[0][bj][k][0] : acc[1][bj][2 + k][0], q1 = wr == 0 ? acc[0][bj][k][1] : acc[1][bj][2 + k][1];
                    const f32x4 v0 = q0 * r + *(const PG8_LAS f32x4*)(NL + 1024 + jc), v1 = q1 * r + *(const PG8_LAS f32x4*)(NL + 1024 + jc + 4);
                    u32x4 pk; pk.x = cvt_pk_bf16(v0[0], v0[1]); pk.y = cvt_pk_bf16(v0[2], v0[3]); pk.z = cvt_pk_bf16(v1[0], v1[1]); pk.w = cvt_pk_bf16(v1[2], v1[3]);
                    *(u32x4*)(EDGE + ((size_t)u.pm * 4 + (wr == 0 ? k : 2 + k)) * 5632 + bj * 2816 + c8) = pk; }
            }
        }
#undef EB_IDX
    }
};

template <class Epi, class Sched, bool ALIGN_EPI = false>
__device__ __forceinline__ void gemm_phase(PG8_LAS unsigned char* lds, const Gemm g, const Sched& S, const Epi& E, int wave_id) {
    int tid_ = wave_id * 64 + lane_id(); asm volatile("" : "+v"(tid_)); const int tid = tid_, wid = __builtin_amdgcn_readfirstlane(tid >> 6), lane = tid & 63, wr = wid >> 2, wc = wid & 3, fr = lane & 15, fq = lane >> 4;
    const int K = g.K, nt = K / BK;
    unsigned voffA[2], voffB[2];
#pragma unroll
    for (int i = 0; i < 2; ++i) { int R, C; stage_rc(tid * 16 + i * 8192, R, C); const int Rb = Epi::PERM ? ((R & ~31) + perm32(R & 31)) : R;
        const int Ra = Epi::PERMA ? ((R & ~63) + 4 * (R & 15) + ((R >> 4) & 3)) : R;
        voffA[i] = (unsigned)(Ra * K + C) * 2u; voffB[i] = (unsigned)(Rb * K + C) * 2u; }
    const size_t kstep = (size_t)(BK * 2);
    const size_t hstep = (size_t)HALF * K * 2;
    const size_t tstep = 2 * hstep;
    const unsigned ldsw = (unsigned)wid * 1024u;
    const int aoff = lds_byte(wr * 64 + fr, fq * 8), boff = lds_byte(wc * 32 + fr, fq * 8);
#define PG8_SA(b, h) (((b) * 2 + (h)) * HTB)
#define PG8_SB(b, h) ((4 + (b) * 2 + (h)) * HTB)
#define PG8_STAGE(bufoff, gbase, voff) do { _Pragma("unroll") for (int _i = 0; _i < 2; ++_i) \
        __builtin_amdgcn_global_load_lds((const unsigned*)((const char*)(gbase) + (voff)[_i]), (PG8_LAS unsigned*)(lds + (bufoff) + ldsw + _i * 8192), 16, 0, 0); } while (0)
#define PG8_LDA(dst, b, h) do { _Pragma("unroll") for (int m = 0; m < 4; ++m) _Pragma("unroll") for (int k = 0; k < 2; ++k) dst[m][k] = *(const PG8_LAS bf16x8*)(lds + PG8_SA(b, h) + aoff + m * 2048 + k * 1024); } while (0)
#define PG8_LDB(dst, b, h) do { _Pragma("unroll") for (int n = 0; n < 2; ++n) _Pragma("unroll") for (int k = 0; k < 2; ++k) dst[n][k] = *(const PG8_LAS bf16x8*)(lds + PG8_SB(b, h) + boff + n * 2048 + k * 1024); } while (0)
#define PG8_MMA(ai, bj, At, Bt) do { __builtin_amdgcn_s_setprio(1); _Pragma("unroll") for (int m = 0; m < 4; ++m) _Pragma("unroll") for (int n = 0; n < 2; ++n) _Pragma("unroll") for (int k = 0; k < 2; ++k) \
        acc[ai][bj][m][n] = __builtin_amdgcn_mfma_f32_16x16x32_bf16(Bt[n][k], At[m][k], acc[ai][bj][m][n], 0, 0, 0); __builtin_amdgcn_s_setprio(0); } while (0)
#define PG8_WAIT_V(n) asm volatile("s_waitcnt vmcnt(" #n ")" ::: "memory")
#define PG8_WAIT_L(n) asm volatile("s_waitcnt lgkmcnt(" #n ")" ::: "memory")
#define PG8_BAR __builtin_amdgcn_s_barrier()
#define PG8_SCHED __builtin_amdgcn_sched_barrier(0)
    Unit cur, nxt; int ui = 0;
    if (!S.next(0, cur)) return;
    f32x4 acc[2][2][4][2];
#pragma unroll
    for (int a = 0; a < 2; ++a)
#pragma unroll
        for (int b = 0; b < 2; ++b)
#pragma unroll
            for (int m = 0; m < 4; ++m)
#pragma unroll
                for (int n = 0; n < 2; ++n) acc[a][b][m][n] = (f32x4){0.f, 0.f, 0.f, 0.f};
    bf16x8 At[4][2], B0[2][2], B1[2][2];
    const char* cA = (const char*)g.A + (size_t)cur.pm * tstep; const char* cB = (const char*)g.Bt + (size_t)cur.pn * tstep;
    S.a_ready(cur);
    (void)E.pre(cur, tid, 0);
    {
        PG8_STAGE(PG8_SB(0, 0), cB, voffB); PG8_STAGE(PG8_SB(0, 1), cB + hstep, voffB); PG8_STAGE(PG8_SA(0, 0), cA, voffA); PG8_STAGE(PG8_SA(0, 1), cA + hstep, voffA);
        if (wr == 1) PG8_BAR;
        PG8_WAIT_V(2); PG8_BAR;
        PG8_STAGE(PG8_SB(1, 0), cB + kstep, voffB); PG8_STAGE(PG8_SA(1, 0), cA + kstep, voffA); PG8_STAGE(PG8_SB(1, 1), cB + hstep + kstep, voffB);
        PG8_WAIT_V(6); PG8_BAR;
    }
    for (;;) {
        const bool has_next = S.next(ui + 1, nxt);
        const char* nA = has_next ? (const char*)g.A + (size_t)nxt.pm * tstep : cA; const char* nB = has_next ? (const char*)g.Bt + (size_t)nxt.pn * tstep : cB;
        for (int t = 0; t < nt; t += 2) {
            const bool last = (t == nt - 2);
            const char* a1 = cA + (size_t)(t + 1) * kstep;
            const char* a2 = last ? nA : cA + (size_t)(t + 2) * kstep; const char* b2 = last ? nB : cB + (size_t)(t + 2) * kstep;
            const char* a3 = a2 + kstep; const char* b3 = b2 + kstep;
            if (last && has_next) S.a_ready(nxt);
            PG8_LDB(B0, 0, 0); PG8_LDB(B1, 0, 1); PG8_SCHED; PG8_LDA(At, 0, 0); PG8_STAGE(PG8_SA(1, 1), a1 + hstep, voffA);
            PG8_WAIT_V(8); PG8_WAIT_L(0); PG8_BAR; PG8_MMA(0, 0, At, B0); PG8_MMA(0, 1, At, B1); PG8_BAR; PG8_SCHED;
            PG8_LDA(At, 0, 1); PG8_STAGE(PG8_SB(0, 0), b2, voffB); PG8_STAGE(PG8_SB(0, 1), b2 + hstep, voffB); PG8_STAGE(PG8_SA(0, 0), a2, voffA);
            PG8_WAIT_V(8); PG8_WAIT_L(0); PG8_BAR; PG8_MMA(1, 0, At, B0); PG8_MMA(1, 1, At, B1); PG8_BAR; PG8_SCHED;
            PG8_LDB(B0, 1, 0); PG8_LDB(B1, 1, 1); PG8_SCHED; PG8_LDA(At, 1, 0); PG8_STAGE(PG8_SA(0, 1), a2 + hstep, voffA);
            PG8_WAIT_V(8); PG8_WAIT_L(0); PG8_BAR; PG8_MMA(0, 0, At, B0); PG8_MMA(0, 1, At, B1); PG8_BAR; PG8_SCHED;
            PG8_LDA(At, 1, 1); PG8_STAGE(PG8_SB(1, 0), b3, voffB); PG8_STAGE(PG8_SB(1, 1), b3 + hstep, voffB); PG8_STAGE(PG8_SA(1, 0), a3, voffA);
            PG8_WAIT_V(8); PG8_WAIT_L(0); PG8_BAR; PG8_MMA(1, 0, At, B0); PG8_MMA(1, 1, At, B1); PG8_BAR; PG8_SCHED;
        }
        if constexpr (ALIGN_EPI) { if (wr == 0) PG8_BAR; }
        { const int l2 = lane_id(); E(acc, cur, wr, wc, l2 & 15, l2 >> 4, (f32x2){__int_as_float(ui & 1), 0.f}); } S.done(cur);
        if (!has_next) break;
        (void)E.pre(nxt, wave_id * 64 + lane_id(), (ui + 1) & 1);
#pragma unroll
        for (int a = 0; a < 2; ++a)
#pragma unroll
            for (int b = 0; b < 2; ++b)
#pragma unroll
                for (int m = 0; m < 4; ++m)
#pragma unroll
                    for (int n = 0; n < 2; ++n) acc[a][b][m][n] = (f32x4){0.f, 0.f, 0.f, 0.f};
        cur = nxt; cA = nA; cB = nB; ++ui;
        if constexpr (ALIGN_EPI) { if (wr == 1) PG8_BAR; }
    }
    PG8_WAIT_V(0);
    if constexpr (!ALIGN_EPI) { if (wr == 0) PG8_BAR; }
    PG8_BAR;
#undef PG8_SA
#undef PG8_SB
#undef PG8_STAGE
#undef PG8_LDA
#undef PG8_LDB
#undef PG8_MMA
#undef PG8_WAIT_V
#undef PG8_WAIT_L
#undef PG8_BAR
#undef PG8_SCHED
}
}

constexpr int D = 1024, NBATCH = 32, SEQ = 2048, CTXL = 256, PT = 2304, NB = 16, NG = 2, TG = NB * PT;
constexpr int FFN = 2816, FFN2 = 5632, LW = 1280, NMOD = 6144;
constexpr float EPS = 1e-6f;
constexpr int NWAVES = 8, NTHR = 512;

constexpr size_t MiB = 1u << 20;
constexpr size_t WS_CTL = 0, CTL_ZERO_BYTES = 1 * MiB;
constexpr size_t WS_MOD = 1 * MiB;
constexpr size_t WS_ROPE = 5 * MiB;
constexpr size_t WS_CTX = 8 * MiB;
constexpr size_t WS_T = 24 * MiB;
constexpr size_t WS_STAT = 30 * MiB;
constexpr int TB_FFN = 0, TB_FFN_SZ = 33 * 5632, TB_LRU = 4 * TB_FFN_SZ, TB_NAQK = TB_LRU + 33 * 2560, TB_NAV = TB_NAQK + 33 * 2048, TB_RETA = TB_NAV + 33 * 1024, TB_RETB = TB_RETA + 33 * 4096;
constexpr size_t WS_W = 40 * MiB;
constexpr size_t WS_ACT = 160 * MiB;
constexpr size_t WS_END = 1024 * MiB;
constexpr size_t W_RET = 0;
constexpr size_t W_FFN = 36 * MiB;
constexpr size_t W_LRU_IN = 102 * MiB, W_LRU_OUT = 107 * MiB, W_LRU_G = 109 * MiB + 512 * 1024;
constexpr size_t W_NA_QK = 112 * MiB, W_NA_V = 116 * MiB, W_NA_O = 118 * MiB;
constexpr size_t A_H = 0;
constexpr size_t A_QKG = 72 * MiB, A_KVT = 360 * MiB, A_Y = 576 * MiB;
constexpr size_t A_ACT = 144 * MiB, A_EDGE = 540 * MiB;
constexpr size_t A_YX = 144 * MiB, A_LA = 324 * MiB, A_U = 504 * MiB, A_A3 = 684 * MiB;
constexpr size_t A_QK = 144 * MiB, A_VT = 288 * MiB, A_O = 360 * MiB;
constexpr int CW_BAR = 4096, CW_DBG = 8192;

constexpr int RING_BYTES = 139264;
constexpr int MISC_OFF = RING_BYTES;
constexpr int NSLOT_OFF = MISC_OFF + 512 + 8192;
constexpr int LDS_BYTES = NSLOT_OFF + 2 * 5120;

#define RLX_AGENT __ATOMIC_RELAXED, __HIP_MEMORY_SCOPE_AGENT
__device__ __forceinline__ unsigned f2bf(float f) { unsigned u = __builtin_bit_cast(unsigned, f); return (u + 0x7fffu + ((u >> 16) & 1u)) >> 16; }
__device__ __forceinline__ unsigned pk2(float lo, float hi) { unsigned r; asm("v_cvt_pk_bf16_f32 %0, %1, %2" : "=v"(r) : "v"(lo), "v"(hi)); return r; }
__device__ __forceinline__ float bf2f(unsigned short h) { return __builtin_bit_cast(float, (unsigned)h << 16); }
__device__ __forceinline__ float bflo(unsigned w) { return __builtin_bit_cast(float, w << 16); }
__device__ __forceinline__ float bfhi(unsigned w) { return __builtin_bit_cast(float, w & 0xffff0000u); }
__device__ __forceinline__ float silu_f(float x) { return x * __builtin_amdgcn_rcpf(1.f + __expf(-x)); }
__device__ __forceinline__ float sigmoid_f(float x) { return __builtin_amdgcn_rcpf(1.f + __expf(-x)); }
__device__ __forceinline__ float lane_get(float v, int src) { return __builtin_bit_cast(float, __builtin_amdgcn_ds_bpermute(src << 2, __builtin_bit_cast(int, v))); }
__device__ __forceinline__ float wave_sum(float v, int lane) {
#pragma unroll
    for (int o = 1; o < 64; o <<= 1) v += lane_get(v, lane ^ o);
    return v;
}

#define XB_TMO      128
#define XB_XCNT(j)  (256  + 64 * (j))
#define XB_XSUB(j)  (1280 + 64 * (j))
#define XB_XGEN(j)  (2304 + 64 * (j))
#define XB_TOP      3328
#define XB_TOPGEN   3392
#define XCD_BAR_WORDS 3456
#define XB_SPIN_CAP (1u << 18)
__device__ __forceinline__ unsigned xb_ld(unsigned* p)              { return __hip_atomic_load(p, __ATOMIC_RELAXED, __HIP_MEMORY_SCOPE_AGENT); }
__device__ __forceinline__ unsigned xb_add(unsigned* p, unsigned v) { return __hip_atomic_fetch_add(p, v, __ATOMIC_RELAXED, __HIP_MEMORY_SCOPE_AGENT); }
__device__ __forceinline__ unsigned xb_xcc_id() { return (unsigned)__builtin_amdgcn_s_getreg((3 << 11) | 20) & 0xFu; }
#define XB_SPIN(cond, bar) do { unsigned _sp = 0; while (cond) { __builtin_amdgcn_s_sleep(1); \
    if ((++_sp & 255u) == 0u) { if (xb_ld(&(bar)[XB_TMO])) break; if (_sp > XB_SPIN_CAP) { atomicAdd(&(bar)[XB_TMO], 1u); break; } } } } while (0)
struct XcdBarrier { unsigned* bar; unsigned x; volatile LAS unsigned* st; bool t0; };
__device__ __forceinline__ XcdBarrier xcd_barrier_post(unsigned* bar, volatile LAS unsigned* st) {
    XcdBarrier b; b.bar = bar; b.x = xb_xcc_id(); b.st = st; b.t0 = threadIdx.x == 0;
    if (threadIdx.x == 0) (void)xb_add(&bar[XB_XCNT(b.x)], 1u);
    return b;
}
__device__ __forceinline__ void xcd_barrier_complete(unsigned* bar, unsigned x, unsigned& nloc, unsigned& nx) {
    const unsigned G = gridDim.x * gridDim.y * gridDim.z;
    unsigned sum, cnt, mine, sp = 0u;
    for (;;) {
        sum = 0u; cnt = 0u; mine = 0u;
#pragma unroll
        for (unsigned j = 0; j < 16; ++j) { const unsigned c = xb_ld(&bar[XB_XCNT(j)]); sum += c; cnt += (c > 0u) ? 1u : 0u; mine = (j == x) ? c : mine; }
        if (sum == G) break;
        __builtin_amdgcn_s_sleep(1);
        if ((++sp & 255u) == 0u) { if (xb_ld(&bar[XB_TMO])) break; if (sp > XB_SPIN_CAP) { atomicAdd(&bar[XB_TMO], 1u); break; } }
    }
    nloc = mine > 0u ? mine : 1u; nx = cnt > 0u ? cnt : 1u;
}
__device__ __forceinline__ void xcd_barrier(const XcdBarrier& b) {
    asm volatile("s_waitcnt vmcnt(0)" ::: "memory");
    __syncthreads();
    if (b.t0) {
        unsigned* bar = b.bar;
        __builtin_amdgcn_s_waitcnt(0);
        unsigned nloc = b.st[0], nx = b.st[1];
        if (nloc == 0u) { xcd_barrier_complete(bar, b.x, nloc, nx); b.st[0] = nloc; b.st[1] = nx; }
        const unsigned old = xb_add(&bar[XB_XSUB(b.x)], 1u);
        const unsigned gen = old / nloc;
        if (old + 1u == (gen + 1u) * nloc) {
            __builtin_amdgcn_fence(__ATOMIC_RELEASE, "agent");
            asm volatile("s_waitcnt vmcnt(0)" ::: "memory");
            const unsigned og = xb_add(&bar[XB_TOP], 1u);
            const unsigned tg = og / nx;
            if (og + 1u == (tg + 1u) * nx) xb_add(&bar[XB_TOPGEN], 1u);
            else XB_SPIN(xb_ld(&bar[XB_TOPGEN]) == tg, bar);
            __builtin_amdgcn_fence(__ATOMIC_ACQUIRE, "agent");
            xb_add(&bar[XB_XGEN(b.x)], 1u);
            asm volatile("s_waitcnt vmcnt(0)" ::: "memory");
        } else {
            XB_SPIN(xb_ld(&bar[XB_XGEN(b.x)]) == gen, bar);
            __builtin_amdgcn_fence(__ATOMIC_ACQUIRE, "agent");
            asm volatile("s_waitcnt vmcnt(0)" ::: "memory");
        }
    }
    __syncthreads();
}

struct Args { const float* in[27]; float* out; unsigned char* ws; };
enum { I_X = 0, I_C, I_CTX, I_CCTX, I_ADAW, I_ADAB, I_NMIX, I_NFFN, I_UP, I_FCW, I_FCB, I_DOWN, I_RWIN, I_RDEC, I_RGN, I_RWOUT,
       I_LWIN, I_LCW, I_LCB, I_LGW, I_LGB, I_LLAM, I_LWOUT, I_NQKV, I_NRPB, I_NWOUT, I_FNORM };

typedef const __attribute__((address_space(4))) Args* CArgsP;
__device__ __forceinline__ CArgsP fresh_args() { CArgsP p = (CArgsP)__builtin_amdgcn_kernarg_segment_ptr(); asm volatile("" : "+s"(p)); return p; }
#define AIN(i) (fresh_args()->in[(i)])
#define AOUT (fresh_args()->out)
#define AWS (fresh_args()->ws)
struct Frame {
    LAS unsigned char* lds;
    int tid, lane, wave, vcu, G, gw, NGW;
    unsigned char* ws;
};

__device__ __forceinline__ Frame refresh(const Frame& F0) {
    Frame F = F0; int t = F0.wave * 64 + lane_id(); asm volatile("" : "+v"(t));
    F.tid = t; F.lane = t & 63; F.gw = F.vcu * NWAVES + F.wave;
    return F;
}
__device__ __forceinline__ void transpose_item(const float* W, int K, int ldn, int c0, int ncols, bf16* WT, int row_off, float scale, LAS float* scr, int item, int lane) {
    const int nblk = ncols / 32, kb = item / nblk, nb = item % nblk, k0 = 64 * kb, n0 = 32 * nb;
    if (row_off <= -1000000) { const int dim = n0 & 255; row_off = (-1000000 - row_off) + (n0 & ~255) + 128 * ((dim & 127) >> 6) + 64 * (dim >> 7) + (dim & 63) - n0; }
    else if (row_off < 0) { const int cc = c0 + n0; row_off = (cc < 2816 ? 256 * (cc / 128) + (cc % 128) : 256 * ((cc - 2816) / 128) + 128 + ((cc - 2816) % 128)) - n0; }
    {
        f32x4 v[8];
#pragma unroll
        for (int i = 0; i < 8; ++i) v[i] = *(const f32x4*)(W + (size_t)(k0 + 8 * i + (lane >> 3)) * ldn + c0 + n0 + 4 * (lane & 7));
#pragma unroll
        for (int i = 0; i < 8; ++i) { LAS float* d = scr + (8 * i + (lane >> 3)) * 33 + 4 * (lane & 7); d[0] = v[i].x * scale; d[1] = v[i].y * scale; d[2] = v[i].z * scale; d[3] = v[i].w * scale; }
    }
    asm volatile("s_waitcnt lgkmcnt(0)" ::: "memory");
    const int c = lane & 7;
#pragma unroll
    for (int j = 0; j < 4; ++j) { const int n = (lane >> 3) + 8 * j; const LAS float* s = scr + (8 * c) * 33 + n;
        u32x4 o; o.x = pk2(s[0 * 33], s[1 * 33]); o.y = pk2(s[2 * 33], s[3 * 33]); o.z = pk2(s[4 * 33], s[5 * 33]); o.w = pk2(s[6 * 33], s[7 * 33]);
        *(u32x4*)(WT + (size_t)(row_off + n0 + n) * K + k0 + 8 * c) = o; }
    asm volatile("s_waitcnt lgkmcnt(0)" ::: "memory");
}

__device__ __forceinline__ void prologue(const Frame& F0) {
    const Frame F = refresh(F0);
    bf16* Wb = (bf16*)(F.ws + WS_W);
    if (F.vcu < 192) {
        const int l = F.vcu / 48, n0 = (F.vcu % 48) * 128;
        LAS float* s = (LAS float*)F.lds;
        for (int idx = F.tid; idx < 33 * 1024; idx += NTHR) { const int bb = idx >> 10, k = idx & 1023; const float v = bb < 32 ? AIN(I_C)[bb * 1024 + k] : AIN(I_CCTX)[k]; s[idx] = silu_f(v); }
        __syncthreads();
        const int cc = F.tid & 127, kq = F.tid >> 7;
        float acc[33];
#pragma unroll
        for (int bb = 0; bb < 33; ++bb) acc[bb] = 0.f;
        const float* wp = AIN(I_ADAW) + ((size_t)l * 1024 + kq * 256) * NMOD + n0 + cc;
        for (int k = 0; k < 256; k += 4) {
            const float w0 = wp[(size_t)(k + 0) * NMOD], w1 = wp[(size_t)(k + 1) * NMOD], w2 = wp[(size_t)(k + 2) * NMOD], w3 = wp[(size_t)(k + 3) * NMOD];
#pragma unroll
            for (int bb = 0; bb < 33; ++bb) { const f32x4 sv = *(const LAS f32x4*)(s + bb * 1024 + kq * 256 + k); acc[bb] += (sv.x * w0 + sv.y * w1) + (sv.z * w2 + sv.w * w3); }
        }
        __syncthreads();
        LAS float* red = (LAS float*)F.lds;
#pragma unroll
        for (int bb = 0; bb < 33; ++bb) red[(kq * 33 + bb) * 128 + cc] = acc[bb];
        __syncthreads();
        float* MOD = (float*)(F.ws + WS_MOD);
        for (int idx = F.tid; idx < 33 * 128; idx += NTHR) { const int bb = idx >> 7, c2 = idx & 127;
            const float v = (red[(0 * 33 + bb) * 128 + c2] + red[(1 * 33 + bb) * 128 + c2]) + (red[(2 * 33 + bb) * 128 + c2] + red[(3 * 33 + bb) * 128 + c2]);
            MOD[((size_t)l * 33 + bb) * NMOD + n0 + c2] = v + AIN(I_ADAB)[l * NMOD + n0 + c2]; }
        __syncthreads();
    }
    if (F.vcu == 192 + 8) {
        float* RT = (float*)(F.ws + WS_ROPE);
        for (int idx = F.tid; idx < 64 * 64; idx += NTHR) { const int pos = idx >> 6, m = idx & 63; const float fr = powf(10000.0f, -(float)(2 * m) / 128.0f); const float ang = (float)pos * fr;
            RT[2 * idx] = cosf(ang); RT[2 * idx + 1] = sinf(ang); }
    }
    {
        bf16* GW = (bf16*)(F.ws + WS_W + W_LRU_G); const float* gwsrc = AIN(I_LGW);
        for (int idx = F.vcu * NTHR + F.tid; idx < 8 * 640 * 160; idx += F.G * NTHR) { const int c = idx % 160, n = (idx / 160) % 640, blk = idx / (160 * 640); const int dg = n / 160, d = n % 160;
            GW[idx] = (bf16)f2bf(gwsrc[(((size_t)dg * 8 + blk) * 160 + c) * 160 + d]); }
    }
    {
        LAS float* scr = (LAS float*)(F.lds + F.wave * 16384);
        constexpr int TOTAL = 2 * (512 + 512 + 1024 + 512 + 1024 + 1024) + 4 * (2816 + 1408) + 1280 + 640 + 512 + 512 + 512 + 512;
        for (int it = F.gw; it < TOTAL; it += F.NGW) {
            int r = it;
#define JOB(Wp, K_, ldn_, c0_, nc_, dst_, ro_, sc_) { constexpr int items_ = ((K_) / 64) * ((nc_) / 32); if (r < items_) { transpose_item((Wp), (K_), (ldn_), (c0_), (nc_), (dst_), (ro_), (sc_), scr, r, F.lane); continue; } r -= items_; }
#define RETJOBS(j) { const float* win = AIN(I_RWIN) + (size_t)(j) * 1024 * 6144; bf16* Wa = Wb + (W_RET + (size_t)(j) * 18 * MiB) / 2; bf16* Wbb = Wa + (8 * MiB) / 2; bf16* Wo = Wa + (14 * MiB) / 2; \
            JOB(win, 1024, 6144, 0, 1024, Wa, -1000000, 1.f) JOB(win, 1024, 6144, 1024, 1024, Wa, -1000000 - 1024, 0.0625f) JOB(win, 1024, 6144, 4096, 2048, Wa, 2048, 1.f) \
            JOB(win, 1024, 6144, 1024, 1024, Wbb, -1000000, 0.0625f) JOB(win, 1024, 6144, 2048, 2048, Wbb, 1024, 1.f) \
            JOB(AIN(I_RWOUT) + (size_t)(j) * 2048 * 1024, 2048, 1024, 0, 1024, Wo, 0, 1.f) }
#define FFNJOBS(l) { bf16* Wup = Wb + (W_FFN + (size_t)(l) * (16 * MiB + 512 * 1024)) / 2; bf16* Wdn = Wup + (11 * MiB) / 2; \
            JOB(AIN(I_UP) + (size_t)(l) * 1024 * 5632, 1024, 5632, 0, 5632, Wup, -1, 1.f) JOB(AIN(I_DOWN) + (size_t)(l) * 2816 * 1024, 2816, 1024, 0, 1024, Wdn, 0, 1.f) }
            RETJOBS(0) RETJOBS(1) FFNJOBS(0) FFNJOBS(1) FFNJOBS(2) FFNJOBS(3)
            JOB(AIN(I_LWIN), 1024, 2560, 0, 2560, Wb + W_LRU_IN / 2, 0, 1.f) JOB(AIN(I_LWOUT), 1280, 1024, 0, 1024, Wb + W_LRU_OUT / 2, 0, 1.f)
            JOB(AIN(I_NQKV), 1024, 3072, 0, 1024, Wb + W_NA_QK / 2, 0, 0.125f) JOB(AIN(I_NQKV), 1024, 3072, 1024, 1024, Wb + W_NA_QK / 2, 1024, 1.f)
            JOB(AIN(I_NQKV), 1024, 3072, 2048, 1024, Wb + W_NA_V / 2, 0, 1.f) JOB(AIN(I_NWOUT), 1024, 1024, 0, 1024, Wb + W_NA_O / 2, 0, 1.f)
#undef JOB
#undef RETJOBS
#undef FFNJOBS
        }
    }
}

__device__ __forceinline__ void norm_phase(const Frame& F0, int b0, int nrows, const void* xs, const void* cs, int f32src, const float* gain, const float* modl, int shoff, int scoff) {
    const Frame F = refresh(F0);
    bf16* H = (bf16*)(F.ws + WS_ACT + A_H);
    for (int row = F.gw; row < nrows; row += F.NGW) {
        const int bl = row / PT, p = row % PT, b = b0 + bl;
        const size_t soff = p < CTXL ? ((size_t)b * CTXL + p) * D : ((size_t)b * SEQ + (p - CTXL)) * D; const void* sbase = p < CTXL ? cs : xs;
        const float* mod = modl + (size_t)(p < CTXL ? 32 : b) * NMOD;
        f32x4 v[4]; float ss = 0.f;
#pragma unroll
        for (int j = 0; j < 4; ++j) {
            if (f32src) v[j] = *(const f32x4*)((const float*)sbase + soff + 4 * F.lane + 256 * j);
            else { const u32x2 w = *(const u32x2*)((const bf16*)sbase + soff + 4 * F.lane + 256 * j); v[j] = (f32x4){bflo(w.x), bfhi(w.x), bflo(w.y), bfhi(w.y)}; }
            ss += (v[j].x * v[j].x + v[j].y * v[j].y) + (v[j].z * v[j].z + v[j].w * v[j].w); }
        const float rstd = 1.f / sqrtf(wave_sum(ss, F.lane) * (1.f / D) + EPS);
#pragma unroll
        for (int j = 0; j < 4; ++j) { const int c = 4 * F.lane + 256 * j;
            const f32x4 gn = *(const f32x4*)(gain + c), sh = *(const f32x4*)(mod + shoff + c), sc = *(const f32x4*)(mod + scoff + c);
            const f32x4 h = (v[j] * rstd) * gn; const f32x4 o = h * (sc + 1.f) + sh;
            u32x2 w; w.x = pk2(o.x, o.y); w.y = pk2(o.z, o.w);
            *(u32x2*)(H + (size_t)row * D + c) = w; }
    }
}

__device__ __forceinline__ void ffn_fix_phase(const Frame& F0, const float* cw, const float* cb) {
    const Frame F = refresh(F0);
    const bf16* EDGE = (const bf16*)(F.ws + WS_ACT + A_EDGE); bf16* ACT = (bf16*)(F.ws + WS_ACT + A_ACT);
    const int NOCT = FFN / 8;
    for (int it = F.vcu * NTHR + F.tid; it < NBATCH * 7 * 2 * NOCT; it += F.G * NTHR) {
        const int oc = it % NOCT, r2 = it / NOCT, side = r2 & 1, bd = (r2 >> 1) % 7, b = (r2 >> 1) / 7; const int c = oc * 8;
        const int pml = 9 * b + 1 + bd, pmh = pml + 1;
        const bf16* pp = side == 0 ? EDGE + ((size_t)pml * 4 + 2) * FFN2 : EDGE + ((size_t)pml * 4 + 3) * FFN2;
        const bf16* pc = side == 0 ? EDGE + ((size_t)pml * 4 + 3) * FFN2 : EDGE + ((size_t)pmh * 4 + 0) * FFN2;
        const bf16* pn = side == 0 ? EDGE + ((size_t)pmh * 4 + 0) * FFN2 : EDGE + ((size_t)pmh * 4 + 1) * FFN2;
        const size_t trow = side == 0 ? (size_t)pml * 256 + 255 : (size_t)pmh * 256;
        float ug[8], uv[8];
#pragma unroll
        for (int half = 0; half < 2; ++half) {
            const int col = half * FFN + c;
            const u32x4 prv = *(const u32x4*)(pp + col), cur = *(const u32x4*)(pc + col), nxt = *(const u32x4*)(pn + col);
            float* dst = half == 0 ? ug : uv;
#pragma unroll
            for (int q = 0; q < 4; ++q) {
                const f32x2 w0 = *(const f32x2*)(cw + 0 * FFN2 + col + 2 * q), w1 = *(const f32x2*)(cw + 1 * FFN2 + col + 2 * q), w2 = *(const f32x2*)(cw + 2 * FFN2 + col + 2 * q), bb = *(const f32x2*)(cb + col + 2 * q);
                dst[2 * q] = bb.x + w0.x * bflo(prv[q]) + w1.x * bflo(cur[q]) + w2.x * bflo(nxt[q]);
                dst[2 * q + 1] = bb.y + w0.y * bfhi(prv[q]) + w1.y * bfhi(cur[q]) + w2.y * bfhi(nxt[q]);
            }
        }
        float o[8];
#pragma unroll
        for (int e = 0; e < 8; ++e) o[e] = silu_f(ug[e]) * uv[e];
        u32x4 w; w.x = pk2(o[0], o[1]); w.y = pk2(o[2], o[3]); w.z = pk2(o[4], o[5]); w.w = pk2(o[6], o[7]);
        *(u32x4*)(ACT + trow * FFN + c) = w;
    }
}

__device__ __forceinline__ void rope_phase(const Frame& F0) {
    const Frame F = refresh(F0);
    bf16* QKG = (bf16*)(F.ws + WS_ACT + A_QKG); bf16* KVT = (bf16*)(F.ws + WS_ACT + A_KVT); const float* RT = (const float*)(F.ws + WS_ROPE);
    const size_t n1 = (size_t)NB * SEQ * 128;
    for (size_t it = (size_t)F.vcu * NTHR + F.tid; it < n1; it += (size_t)F.G * NTHR) {
        const int sub = (int)(it & 127); const size_t lr = it >> 7; const int bl = (int)(lr / SEQ), t = (int)(lr % SEQ);
        const int oct = sub & 7, hf = (sub >> 3) & 1, h = (sub >> 4) & 3, tens = sub >> 6;
        const int pos = hf == 0 ? (t >> 6) : (t & 63);
        bf16* p1 = QKG + ((size_t)bl * PT + CTXL + t) * 4096 + tens * 1024 + h * 256 + hf * 128 + oct * 8; bf16* p2 = p1 + 64;
        const u32x4 a = *(const u32x4*)p1, b = *(const u32x4*)p2; u32x4 oa, ob;
#pragma unroll
        for (int q = 0; q < 4; ++q) {
            const f32x4 cs = *(const f32x4*)(RT + 2 * (pos * 64 + oct * 8 + 2 * q));
            const float x1l = bflo(a[q]), x1h = bfhi(a[q]), x2l = bflo(b[q]), x2h = bfhi(b[q]);
            oa[q] = pk2(x1l * cs.x - x2l * cs.y, x1h * cs.z - x2h * cs.w);
            ob[q] = pk2(x1l * cs.y + x2l * cs.x, x1h * cs.w + x2h * cs.z);
        }
        *(u32x4*)p1 = oa; *(u32x4*)p2 = ob;
    }
    const size_t n2 = (size_t)4 * 2 * 64 * NB * (SEQ / 8);
    for (size_t it = (size_t)F.vcu * NTHR + F.tid; it < n2; it += (size_t)F.G * NTHR) {
        const int to = (int)(it % (SEQ / 8)); size_t r = it / (SEQ / 8); const int bl = (int)(r % NB); r /= NB; const int d = (int)(r & 63), hf = (int)((r >> 6) & 1), h = (int)(r >> 7);
        const int t0 = to * 8;
        bf16* p1 = KVT + (size_t)(h * 256 + hf * 128 + d) * TG + (size_t)bl * PT + CTXL + t0; bf16* p2 = p1 + (size_t)64 * TG;
        const u32x4 a = *(const u32x4*)p1, b = *(const u32x4*)p2; u32x4 oa, ob;
#pragma unroll
        for (int q = 0; q < 4; ++q) {
            const int pos0 = hf == 0 ? (t0 >> 6) : ((t0 & 63) + 2 * q), pos1 = hf == 0 ? pos0 : pos0 + 1;
            const f32x2 c0 = *(const f32x2*)(RT + 2 * (pos0 * 64 + d)), c1 = *(const f32x2*)(RT + 2 * (pos1 * 64 + d));
            const float x1l = bflo(a[q]), x1h = bfhi(a[q]), x2l = bflo(b[q]), x2h = bfhi(b[q]);
            oa[q] = pk2(x1l * c0.x - x2l * c0.y, x1h * c1.x - x2h * c1.y);
            ob[q] = pk2(x1l * c0.y + x2l * c0.x, x1h * c1.y + x2h * c1.x);
        }
        *(u32x4*)p1 = oa; *(u32x4*)p2 = ob;
    }
}

#define MFMA16(a, b, c) __builtin_amdgcn_mfma_f32_16x16x32_bf16((a), (b), (c), 0, 0, 0)
constexpr int QS_STRIDE = 528, PS_STRIDE = 272;
constexpr int LDS_RA = 0, LDS_RB = 65536;
__device__ __forceinline__ float ex2(float x) { return __builtin_amdgcn_exp2f(x); }
__device__ __forceinline__ int st_off(int r, int cb, int ncg) { return ((r >> 4) * ncg + (cb >> 6)) * 1024 + ((((r & 15) << 6) + (cb & 63)) ^ (((r >> 3) & 1) << 5)); }
template <int DIR>
__device__ __forceinline__ void ret_scan_pass(const Frame& F, const bf16* QKG, const bf16* KVT, bf16* Y, int bl, int h, int vs, float lgf, float lgb) {
    LAS unsigned char* RA = F.lds + LDS_RA; LAS unsigned char* RB = F.lds + LDS_RB;
    const int v0 = vs * 128 + F.wave * 16;
    const float lg2 = DIR == 0 ? lgf : lgb;
    const float gch = ex2(lg2 * 128.f);
    f32x4 S[16];
#pragma unroll
    for (int i = 0; i < 16; ++i) S[i] = (f32x4){0.f, 0.f, 0.f, 0.f};
    u32x4 qv[8], kv[8];
#define RET_PF_Q(cc) do { const size_t Rn = (size_t)bl * PT + (size_t)(cc) * 128; int tp = F.tid; asm volatile("" : "+v"(tp)); \
        _Pragma("unroll") for (int e = 0; e < 8; ++e) { const int q = tp + NTHR * e; qv[e] = *(const u32x4*)(QKG + (Rn + (q >> 5)) * 4096 + h * 256 + (q & 31) * 8); } } while (0)
#define RET_PF_K(cc) do { const size_t Rn = (size_t)bl * PT + (size_t)(cc) * 128; int tp = F.tid; asm volatile("" : "+v"(tp)); \
        _Pragma("unroll") for (int e = 0; e < 8; ++e) { const int q = tp + NTHR * e; \
            if (DIR == 0) kv[e] = *(const u32x4*)(QKG + (Rn + (q >> 5)) * 4096 + 1024 + h * 256 + (q & 31) * 8); \
            else kv[e] = *(const u32x4*)(KVT + (size_t)(h * 256 + (q >> 4)) * TG + Rn + (q & 15) * 8); } } while (0)
    RET_PF_Q(DIR == 0 ? 0 : 1); RET_PF_K(DIR == 0 ? 0 : 1);
    for (int step = 0; step < 18; ++step) {
        const int c = DIR == 0 ? step : (step < 2 ? 1 - step : 19 - step);
        const int cn = step == 17 ? c : (DIR == 0 ? step + 1 : (step + 1 < 2 ? 1 - (step + 1) : 19 - (step + 1)));
        const size_t R0 = (size_t)bl * PT + (size_t)c * 128;
        int tl = F.tid; asm volatile("" : "+v"(tl));
        const int l15 = tl & 15, g4 = (tl >> 4) & 3;
#pragma unroll
        for (int e = 0; e < 8; ++e) { const int q = tl + NTHR * e; const int m8 = q & 31, mm = m8 & 3;
            const int o0 = st_off(q >> 5, 64 * (m8 >> 2) + 32 * (mm & 1) + 8 * (mm >> 1), 8), o1 = st_off(q >> 5, 64 * (m8 >> 2) + 32 * (mm & 1) + 8 * (mm >> 1) + 16, 8);
            *(LAS u32x2*)(RA + o0) = (u32x2){qv[e].x, qv[e].y}; *(LAS u32x2*)(RA + o1) = (u32x2){qv[e].z, qv[e].w};
            if (DIR == 0) { *(LAS u32x2*)(RB + o0) = (u32x2){kv[e].x, kv[e].y}; *(LAS u32x2*)(RB + o1) = (u32x2){kv[e].z, kv[e].w}; }
            else *(LAS u32x4*)(RB + st_off(q >> 4, 16 * (q & 15), 4)) = kv[e]; }
        const int loff = ((l15 << 6) + 16 * g4) ^ (((l15 >> 3) & 1) << 5);
        bf16x8 vf[4];
#pragma unroll
        for (int ks = 0; ks < 4; ++ks) vf[ks] = *(const bf16x8*)(KVT + (size_t)(1024 + h * 512 + v0 + l15) * TG + R0 + 32 * ks + 8 * g4);
        __syncthreads();
        if (DIR == 1) RET_PF_Q(cn);
        f32x4 ya[8];
#pragma unroll
        for (int it = 0; it < 8; ++it) ya[it] = (f32x4){0.f, 0.f, 0.f, 0.f};
        if (DIR == 0) {
            f32x4 pt[8];
#pragma unroll
            for (int it = 0; it < 8; ++it) pt[it] = (f32x4){0.f, 0.f, 0.f, 0.f};
#pragma unroll
            for (int ks = 0; ks < 8; ++ks) {
                __builtin_amdgcn_sched_barrier(0);
                const bf16x8 af = *(const LAS bf16x8*)(RB + (F.wave * 8 + ks) * 1024 + loff);
#pragma unroll
                for (int ih = 0; ih < 2; ++ih) {
                    bf16x8 bq[4];
#pragma unroll
                    for (int it = 0; it < 4; ++it) bq[it] = *(const LAS bf16x8*)(RA + ((4 * ih + it) * 8 + ks) * 1024 + loff);
                    __builtin_amdgcn_sched_barrier(0);
#pragma unroll
                    for (int it = 0; it < 4; ++it) pt[4 * ih + it] = MFMA16(af, bq[it], pt[4 * ih + it]);
                    __builtin_amdgcn_sched_barrier(0);
                }
            }
            __syncthreads();
#pragma unroll
            for (int it = 0; it < 8; ++it) {
                const int i = 16 * it + l15; float pv[4];
                const float ixi = ex2(-lgf * (float)(i + 1));
#pragma unroll
                for (int r = 0; r < 4; ++r) { const int j = 16 * F.wave + 4 * g4 + r; const int dd = i - j;
                    const float f = dd > 0 ? ex2(-lgf * (float)(j + 1)) : (dd < 0 ? ex2(lgb * (float)(-dd)) * ixi : 2.f * ixi); pv[r] = pt[it][r] * f; }
                u32x2 w; w.x = pk2(pv[0], pv[1]); w.y = pk2(pv[2], pv[3]);
                *(LAS u32x2*)(RB + st_off(i, 32 * F.wave + 8 * g4, 4)) = w;
            }
            __syncthreads();
#pragma unroll
            for (int ks = 0; ks < 4; ++ks) {
                __builtin_amdgcn_sched_barrier(0);
                bf16x8 ap[8];
#pragma unroll
                for (int it = 0; it < 8; ++it) ap[it] = *(const LAS bf16x8*)(RB + (it * 4 + ks) * 1024 + loff);
                __builtin_amdgcn_sched_barrier(0);
#pragma unroll
                for (int it = 0; it < 8; ++it) ya[it] = MFMA16(ap[it], vf[ks], ya[it]);
            }
        }
        u32x4 kt2[8];
        if (DIR == 0) {
#pragma unroll
            for (int e = 0; e < 8; ++e) { const int q = tl + NTHR * e; kt2[e] = *(const u32x4*)(KVT + (size_t)(h * 256 + (q >> 4)) * TG + R0 + (q & 15) * 8); }
        }
        bf16x8 vfs[4];
        {
            float z[8]; const float z32 = ex2(lg2 * (DIR == 0 ? -32.f : 32.f));
#pragma unroll
            for (int e = 0; e < 8; ++e) z[e] = ex2(lg2 * (float)(DIR == 0 ? 127 - (8 * g4 + e) : 8 * g4 + e));
#pragma unroll
            for (int ks = 0; ks < 4; ++ks) {
                const u32x4 vv = __builtin_bit_cast(u32x4, vf[ks]); u32x4 o;
#pragma unroll
                for (int w = 0; w < 4; ++w) o[w] = pk2(bflo(vv[w]) * z[2 * w], bfhi(vv[w]) * z[2 * w + 1]);
                vfs[ks] = __builtin_bit_cast(bf16x8, o);
#pragma unroll
                for (int e = 0; e < 8; ++e) z[e] *= z32;
            }
        }
#pragma unroll
        for (int s = 0; s < 8; ++s) {
            __builtin_amdgcn_sched_barrier(0);
            u32x4 sb; sb.x = pk2(S[2 * s][0], S[2 * s][1]); sb.y = pk2(S[2 * s][2], S[2 * s][3]); sb.z = pk2(S[2 * s + 1][0], S[2 * s + 1][1]); sb.w = pk2(S[2 * s + 1][2], S[2 * s + 1][3]);
            const bf16x8 bfr = __builtin_bit_cast(bf16x8, sb);
            bf16x8 aq[8];
#pragma unroll
            for (int it = 0; it < 8; ++it) aq[it] = *(const LAS bf16x8*)(RA + (it * 8 + s) * 1024 + loff);
            __builtin_amdgcn_sched_barrier(0);
#pragma unroll
            for (int it = 0; it < 8; ++it) ya[it] = MFMA16(aq[it], bfr, ya[it]);
        }
        __builtin_amdgcn_sched_barrier(0);
        {
            float x0[4]; const float x16 = ex2(lg2 * (DIR == 0 ? 16.f : -16.f));
#pragma unroll
            for (int r = 0; r < 4; ++r) x0[r] = ex2(lg2 * (float)(DIR == 0 ? 4 * g4 + r + 1 : 128 - (4 * g4 + r)));
            if (DIR == 0) __syncthreads();
            LAS unsigned char* wscr = F.lds + 139776 + F.wave * 2048;
#pragma unroll
            for (int it = 0; it < 8; ++it) {
#pragma unroll
                for (int r = 0; r < 4; ++r) {
                    const unsigned short o = (unsigned short)f2bf(x0[r] * ya[it][r]);
                    if (DIR == 0) *(LAS bf16*)(RB + st_off(16 * it + 4 * g4 + r, 32 * F.wave + 2 * l15, 4)) = o;
                    else *(LAS bf16*)(wscr + (16 * (it & 3) + 4 * g4 + r) * 32 + l15 * 2) = o;
                    x0[r] *= x16;
                }
                if (DIR == 1 && (it & 3) == 3) {
                    asm volatile("s_waitcnt lgkmcnt(0)" ::: "memory");
                    const int ln = tl & 63;
#pragma unroll
                    for (int cch = 0; cch < 2; ++cch) { const int cq = ln + 64 * cch; const u32x4 yv = *(const LAS u32x4*)(wscr + cq * 16);
                        *(u32x4*)(Y + (R0 + 64 * (it >> 2) + (cq >> 1)) * 2048 + h * 512 + v0 + 8 * (cq & 1)) = yv; }
                    asm volatile("s_waitcnt lgkmcnt(0)" ::: "memory");
                }
            }
        }
#pragma unroll
        for (int i = 0; i < 16; ++i) S[i] = S[i] * gch;
        if (DIR == 0) {
#pragma unroll
            for (int e = 0; e < 8; ++e) { const int q = tl + NTHR * e; *(LAS u32x4*)(RA + st_off(q >> 4, 16 * (q & 15), 4)) = kt2[e]; }
            __syncthreads();
            u32x4 yold[4];
#pragma unroll
            for (int e = 0; e < 4; ++e) { const int q = tl + NTHR * e; yold[e] = *(const u32x4*)(Y + (R0 + (q >> 4)) * 2048 + h * 512 + vs * 128 + (q & 15) * 8); }
            RET_PF_Q(cn); RET_PF_K(cn);
#pragma unroll
            for (int e = 0; e < 4; ++e) {
                const int q = tl + NTHR * e, row = q >> 4, ch = q & 15;
                bf16* yp = Y + (R0 + row) * 2048 + h * 512 + vs * 128 + ch * 8;
                const u32x4 yv = *(const LAS u32x4*)(RB + st_off(row, 16 * ch, 4)); u32x4 o;
#pragma unroll
                for (int w = 0; w < 4; ++w) o[w] = pk2(bflo(yv[w]) + bflo(yold[e][w]), bfhi(yv[w]) + bfhi(yold[e][w]));
                *(u32x4*)yp = o;
            }
        } else {
            RET_PF_K(cn);
        }
        {
            LAS unsigned char* KT = DIR == 0 ? RA : RB;
#pragma unroll
            for (int ks = 0; ks < 4; ++ks)
#pragma unroll
                for (int dh = 0; dh < 2; ++dh) {
                    __builtin_amdgcn_sched_barrier(0);
                    bf16x8 ak[8];
#pragma unroll
                    for (int d8 = 0; d8 < 8; ++d8) ak[d8] = *(const LAS bf16x8*)(KT + ((8 * dh + d8) * 4 + ks) * 1024 + loff);
                    __builtin_amdgcn_sched_barrier(0);
#pragma unroll
                    for (int d8 = 0; d8 < 8; ++d8) S[8 * dh + d8] = MFMA16(ak[d8], vfs[ks], S[8 * dh + d8]);
                }
        }
        __syncthreads();
    }
#undef RET_PF_Q
#undef RET_PF_K
}
__device__ __forceinline__ void ret_scan_phase(const Frame& F0, const float* logit  , size_t yoff) {
    const Frame F = refresh(F0);
    const bf16* QKG = (const bf16*)(F.ws + WS_ACT + A_QKG); const bf16* KVT = (const bf16*)(F.ws + WS_ACT + A_KVT); bf16* Y = (bf16*)(F.ws + WS_ACT + A_Y + yoff);
    for (int u = F.vcu; u < NB * 16; u += F.G) {
        const int bl = u >> 4, h = (u >> 2) & 3, vs = u & 3;
        const float lgf = -log1pf(expf(-logit[h])) * 1.4426950408889634f, lgb = -log1pf(expf(-logit[4 + h])) * 1.4426950408889634f;
        ret_scan_pass<1>(F, QKG, KVT, Y, bl, h, vs, lgf, lgb);
        ret_scan_pass<0>(F, QKG, KVT, Y, bl, h, vs, lgf, lgb);
    }
}

__device__ __forceinline__ void t_phase(const Frame& F0) {
    const Frame F = refresh(F0);
    for (int it = F.gw; it < 2208; it += F.NGW) {
    const bf16* W; int N, n0; const float* sh; float* T;
    const float* MODp = (const float*)(F.ws + WS_MOD); float* TB = (float*)(F.ws + WS_T);
    if (it < 1408) { const int l = it / 352; W = (const bf16*)(F.ws + WS_W + W_FFN + (size_t)l * (16 * MiB + 512 * 1024)); N = 5632; n0 = (it % 352) * 16; sh = MODp + (size_t)l * 33 * NMOD + 3 * D; T = TB + TB_FFN + (size_t)l * TB_FFN_SZ; }
    else if (it < 1568) { W = (const bf16*)(F.ws + WS_W + W_LRU_IN); N = 2560; n0 = (it - 1408) * 16; sh = MODp + (size_t)1 * 33 * NMOD; T = TB + TB_LRU; }
    else if (it < 1696) { W = (const bf16*)(F.ws + WS_W + W_NA_QK); N = 2048; n0 = (it - 1568) * 16; sh = MODp + (size_t)2 * 33 * NMOD; T = TB + TB_NAQK; }
    else if (it < 1760) { W = (const bf16*)(F.ws + WS_W + W_NA_V); N = 1024; n0 = (it - 1696) * 16; sh = MODp + (size_t)2 * 33 * NMOD; T = TB + TB_NAV; }
    else if (it < 2016) { W = (const bf16*)(F.ws + WS_W + W_RET + 18 * MiB); N = 4096; n0 = (it - 1760) * 16; sh = MODp + (size_t)3 * 33 * NMOD; T = TB + TB_RETA; }
    else { W = (const bf16*)(F.ws + WS_W + W_RET + 18 * MiB + 8 * MiB); N = 3072; n0 = (it - 2016) * 16; sh = MODp + (size_t)3 * 33 * NMOD; T = TB + TB_RETB; }
    const int l15 = F.lane & 15, g4 = F.lane >> 4;
    f32x4 acc[3];
#pragma unroll
    for (int ct = 0; ct < 3; ++ct) acc[ct] = (f32x4){0.f, 0.f, 0.f, 0.f};
    const bf16* wp = W + (size_t)(n0 + l15) * 1024 + 8 * g4;
    for (int ks = 0; ks < 32; ++ks) {
        const bf16x8 a = *(const bf16x8*)(wp + 32 * ks);
#pragma unroll
        for (int ct = 0; ct < 3; ++ct) { const int mr = 16 * ct + l15 < 32 ? 16 * ct + l15 : 32;
            const float* sp = sh + (size_t)mr * NMOD + 32 * ks + 8 * g4; const f32x4 s0 = *(const f32x4*)sp, s1 = *(const f32x4*)(sp + 4);
            u32x4 bw; bw.x = pk2(s0.x, s0.y); bw.y = pk2(s0.z, s0.w); bw.z = pk2(s1.x, s1.y); bw.w = pk2(s1.z, s1.w);
            acc[ct] = MFMA16(a, __builtin_bit_cast(bf16x8, bw), acc[ct]); }
    }
#pragma unroll
    for (int ct = 0; ct < 3; ++ct) { const int mr = 16 * ct + l15;
        if (mr < 33) {
#pragma unroll
            for (int r = 0; r < 4; ++r) T[(size_t)mr * N + n0 + 4 * g4 + r] = acc[ct][r]; } }
    }
}

__device__ __forceinline__ void ret_gn_phase(const Frame& F0, const float* gn, size_t yoff) {
    const Frame F = refresh(F0);
    const bf16* Y = (const bf16*)(F.ws + WS_ACT + A_Y + yoff); const bf16* QKG = (const bf16*)(F.ws + WS_ACT + A_QKG); bf16* A2 = (bf16*)(F.ws + WS_ACT + A_Y + yoff);
    for (int row = F.gw; row < TG; row += F.NGW) {
#pragma unroll
        for (int h = 0; h < 4; ++h) {
            const int c = h * 512 + 8 * F.lane;
            const u32x4 yv = *(const u32x4*)(Y + (size_t)row * 2048 + c), gv = *(const u32x4*)(QKG + (size_t)row * 4096 + 2048 + c);
            float y[8]; float s = 0.f;
#pragma unroll
            for (int q = 0; q < 4; ++q) { y[2 * q] = bflo(yv[q]); y[2 * q + 1] = bfhi(yv[q]); s += y[2 * q] + y[2 * q + 1]; }
            const float mu = wave_sum(s, F.lane) * (1.f / 512.f); float s2 = 0.f;
#pragma unroll
            for (int e = 0; e < 8; ++e) { y[e] -= mu; s2 += y[e] * y[e]; }
            const float rstd = 1.f / sqrtf(wave_sum(s2, F.lane) * (1.f / 512.f) + EPS);
            float o[8];
#pragma unroll
            for (int q = 0; q < 4; ++q) { const f32x2 gg = *(const f32x2*)(gn + c + 2 * q);
                o[2 * q] = silu_f(bflo(gv[q])) * (y[2 * q] * rstd * gg.x); o[2 * q + 1] = silu_f(bfhi(gv[q])) * (y[2 * q + 1] * rstd * gg.y); }
            u32x4 w; w.x = pk2(o[0], o[1]); w.y = pk2(o[2], o[3]); w.z = pk2(o[4], o[5]); w.w = pk2(o[6], o[7]);
            *(u32x4*)(A2 + (size_t)row * 2048 + c) = w;
        }
    }
}

__device__ __forceinline__ float gelu_tanh(float x) { const float z = 0.7978845608028654f * (x + 0.044715f * x * x * x); const float e = __expf(2.f * z); const float th = 1.f - 2.f * __builtin_amdgcn_rcpf(e + 1.f); return 0.5f * x * (1.f + th); }
constexpr int XC_STRIDE = 336;
__device__ __forceinline__ void lru_gate_phase(const Frame& F0, const float* cw, const float* cb, const float* gb  , const float* lam  ) {
    const Frame F = refresh(F0);
    const bf16* YX = (const bf16*)(F.ws + WS_ACT + A_YX); const bf16* GW = (const bf16*)(F.ws + WS_W + W_LRU_G);
    bf16* LA = (bf16*)(F.ws + WS_ACT + A_LA); bf16* U = (bf16*)(F.ws + WS_ACT + A_U);
    const int l15 = F.lane & 15, g4 = F.lane >> 4;
    const int oc = F.tid % 20, rg = F.tid / 20; const bool act = rg < 22;
    float cwv[4][8], cbv[8];
#define LRU_LOAD_CW(kb_) do { const int cch = (kb_) * 160 + oc * 8; _Pragma("unroll") for (int w = 0; w < 4; ++w) { const f32x2 bb = *(const f32x2*)(cb + cch + 2 * w); cbv[2 * w] = bb.x; cbv[2 * w + 1] = bb.y; \
        _Pragma("unroll") for (int k = 0; k < 4; ++k) { const f32x2 ww = *(const f32x2*)(cw + k * LW + cch + 2 * w); cwv[k][2 * w] = ww.x; cwv[k][2 * w + 1] = ww.y; } } } while (0)
    const bool kbfix = (F.G & 7) == 0;
    LRU_LOAD_CW(F.vcu & 7);
    for (int it = F.vcu; it < (TG / 128) * 8; it += F.G) {
        const int rb = it >> 3, kb = it & 7; const int row0 = rb * 128;
        if (!kbfix) LRU_LOAD_CW(kb);
        if (act) {
            const int skey = (row0 / PT) * 2 + ((row0 % PT) >= CTXL ? 1 : 0);
            u32x4 xin[9];
#pragma unroll
            for (int q = 0; q < 9; ++q) {
                const int gr = row0 + rg * 6 - 2 + q; const bool ok = gr >= 0 && gr < TG && ((gr / PT) * 2 + ((gr % PT) >= CTXL ? 1 : 0)) == skey;
                xin[q] = ok ? *(const u32x4*)(YX + (size_t)gr * 2560 + LW + kb * 160 + oc * 8) : (u32x4){0u, 0u, 0u, 0u};
            }
#pragma unroll
            for (int jr = 0; jr < 6; ++jr) {
                const int r = rg * 6 + jr;
                if (r < 128) {
                    float o[8];
#pragma unroll
                    for (int e = 0; e < 8; ++e) o[e] = cbv[e];
#pragma unroll
                    for (int k = 0; k < 4; ++k)
#pragma unroll
                        for (int w = 0; w < 4; ++w) { o[2 * w] += cwv[k][2 * w] * bflo(xin[jr + k][w]); o[2 * w + 1] += cwv[k][2 * w + 1] * bfhi(xin[jr + k][w]); }
                    u32x4 w4; w4.x = pk2(o[0], o[1]); w4.y = pk2(o[2], o[3]); w4.z = pk2(o[4], o[5]); w4.w = pk2(o[6], o[7]);
                    *(LAS u32x4*)(F.lds + r * XC_STRIDE + oc * 16) = w4;
                }
            }
        }
        __syncthreads();
        const int dir = F.wave & 1;
        for (int nt = F.wave >> 1; nt < 10; nt += 4) {
            bf16x8 wr[5], wi[5];
            const bf16* wp = GW + ((size_t)kb * 640 + (dir * 2 + 0) * 160 + 16 * nt + l15) * 160 + 8 * g4;
#pragma unroll
            for (int ks = 0; ks < 5; ++ks) { wr[ks] = *(const bf16x8*)(wp + 32 * ks); wi[ks] = *(const bf16x8*)(wp + 160 * 160 + 32 * ks); }
            const int c0 = kb * 160 + 16 * nt + 4 * g4;
            const f32x4 br = *(const f32x4*)(gb + (dir * 2 + 0) * LW + c0), bi = *(const f32x4*)(gb + (dir * 2 + 1) * LW + c0), lm = *(const f32x4*)(lam + dir * LW + c0);
            f32x4 sp;
#pragma unroll
            for (int r = 0; r < 4; ++r) sp[r] = -8.f * log1pf(__expf(-lm[r]));
            for (int rt = 0; rt < 8; ++rt) {
                f32x4 ar = (f32x4){0.f, 0.f, 0.f, 0.f}, ai = ar;
                const LAS unsigned char* xrow = F.lds + (16 * rt + l15) * XC_STRIDE;
#pragma unroll
                for (int ks = 0; ks < 5; ++ks) { const bf16x8 xb = *(const LAS bf16x8*)(xrow + (32 * ks + 8 * g4) * 2); ar = MFMA16(wr[ks], xb, ar); ai = MFMA16(wi[ks], xb, ai); }
                const u32x2 xv = *(const LAS u32x2*)(xrow + (16 * nt + 4 * g4) * 2);
                const float x4[4] = {bflo(xv.x), bfhi(xv.x), bflo(xv.y), bfhi(xv.y)};
                float la[4], uu[4];
#pragma unroll
                for (int r = 0; r < 4; ++r) {
                    const float rg = sigmoid_f(ar[r] + br[r]), ig = sigmoid_f(ai[r] + bi[r]);
                    la[r] = rg * sp[r]; const float a2 = __expf(2.f * la[r]);
                    uu[r] = sqrtf(fmaxf(1.f - a2, 0.f)) * (ig * x4[r]);
                }
                const size_t o = ((size_t)dir * TG + (size_t)(row0 + 16 * rt + l15)) * LW + c0;
                u32x2 w1, w2; w1.x = pk2(la[0], la[1]); w1.y = pk2(la[2], la[3]); w2.x = pk2(uu[0], uu[1]); w2.y = pk2(uu[2], uu[3]);
                *(u32x2*)(LA + o) = w1; *(u32x2*)(U + o) = w2;
            }
        }
        __syncthreads();
    }
}

__device__ __forceinline__ void lru_scan_phase(const Frame& F0, size_t aoff) {
    const Frame F = refresh(F0);
    const bf16* LA = (const bf16*)(F.ws + WS_ACT + A_LA); const bf16* U = (const bf16*)(F.ws + WS_ACT + A_U); const bf16* YX = (const bf16*)(F.ws + WS_ACT + A_YX);
    bf16* A3 = (bf16*)(F.ws + WS_ACT + A_A3 + aoff);
    LAS f32x4* cbuf = (LAS f32x4*)F.lds;
    const int cp = F.tid % 40, k = F.tid / 40; const bool act = F.tid < 360;
    for (int it = F.vcu; it < NB * 16; it += F.G) {
        const int bl = it >> 4, cg = it & 15; const int c0 = cg * 80 + 2 * cp;
        for (int dir = 0; dir < 2; ++dir) {
            const size_t base = ((size_t)dir * TG + (size_t)bl * PT) * LW + c0;
            const int pstart = dir == 0 ? 256 * k : 256 * k + 255, pstep = dir == 0 ? 1 : -1;
            if (act) {
                float hx = 0.f, hy = 0.f, sx = 0.f, sy = 0.f;
                for (int s0 = 0; s0 < 256; s0 += 32) {
                    unsigned lv[32], uv[32];
#pragma unroll
                    for (int e = 0; e < 32; ++e) { const size_t o = base + (size_t)(pstart + pstep * (s0 + e)) * LW; lv[e] = *(const unsigned*)(LA + o); uv[e] = *(const unsigned*)(U + o); }
#pragma unroll
                    for (int e = 0; e < 32; ++e) { const float lx = bflo(lv[e]), ly = bfhi(lv[e]); hx = __expf(lx) * hx + bflo(uv[e]); hy = __expf(ly) * hy + bfhi(uv[e]); sx += lx; sy += ly; }
                }
                cbuf[k * 40 + cp] = (f32x4){__expf(sx), hx, __expf(sy), hy};
            }
            __syncthreads();
            if (act) {
                const int ok = dir == 0 ? k : (k == 0 ? 0 : 9 - k);
                float hx = 0.f, hy = 0.f;
                for (int o = 0; o < ok; ++o) { const int kk = dir == 0 ? o : (o == 0 ? 0 : 9 - o); const f32x4 cv = cbuf[kk * 40 + cp]; hx = cv.x * hx + cv.y; hy = cv.z * hy + cv.w; }
                for (int s0 = 0; s0 < 256; s0 += 16) {
                    unsigned lv[16], uv[16], fv[16], yv[16];
#pragma unroll
                    for (int e = 0; e < 16; ++e) { const int p = pstart + pstep * (s0 + e); const size_t o = base + (size_t)p * LW; lv[e] = *(const unsigned*)(LA + o); uv[e] = *(const unsigned*)(U + o);
                        if (dir == 1) { const size_t r = (size_t)bl * PT + p; fv[e] = *(const unsigned*)(A3 + r * LW + c0); yv[e] = *(const unsigned*)(YX + r * 2560 + c0); } }
#pragma unroll
                    for (int e = 0; e < 16; ++e) { const int p = pstart + pstep * (s0 + e); const size_t r = (size_t)bl * PT + p;
                        hx = __expf(bflo(lv[e])) * hx + bflo(uv[e]); hy = __expf(bfhi(lv[e])) * hy + bfhi(uv[e]);
                        unsigned w;
                        if (dir == 0) w = pk2(hx, hy);
                        else w = pk2((hx + bflo(fv[e])) * gelu_tanh(bflo(yv[e])), (hy + bfhi(fv[e])) * gelu_tanh(bfhi(yv[e])));
                        *(unsigned*)(A3 + r * LW + c0) = w; }
                }
            }
            __syncthreads();
        }
    }
}

constexpr int CK_STRIDE = 144, CV_STRIDE = 528, NA_CK = 0, NA_CV = 36864, NA_RP = 36864 + 33792;
__device__ __forceinline__ void na_attn_phase(const Frame& F0, const float* rpb  , size_t ooff) {
    const Frame F = refresh(F0);
    const bf16* QK = (const bf16*)(F.ws + WS_ACT + A_QK); const bf16* VT = (const bf16*)(F.ws + WS_ACT + A_VT); bf16* O = (bf16*)(F.ws + WS_ACT + A_O + ooff);
    const float L2E = 1.4426950408889634f;
    LAS unsigned char* CK = F.lds + NA_CK; LAS unsigned char* CV = F.lds + NA_CV; LAS float* RP = (LAS float*)(F.lds + NA_RP);
    for (int item = F.vcu; item < NB * 16; item += F.G) {
        const int bl = item >> 4, h = item & 15; const size_t cbase = (size_t)bl * PT;
        {
            int ts = F.tid; asm volatile("" : "+v"(ts));
#pragma unroll
            for (int e = 0; e < 4; ++e) { const int q = ts + NTHR * e;
                *(LAS u32x4*)(CK + (q >> 3) * CK_STRIDE + (q & 7) * 16) = *(const u32x4*)(QK + (cbase + (q >> 3)) * 2048 + 1024 + h * 64 + (q & 7) * 8);
                *(LAS u32x4*)(CV + (q >> 5) * CV_STRIDE + (q & 31) * 16) = *(const u32x4*)(VT + (size_t)(h * 64 + (q >> 5)) * TG + cbase + (q & 31) * 8); }
            if (ts < 465) RP[ts] = rpb[h * 465 + ts];
        }
        __syncthreads();
        int tl_ = F.tid; asm volatile("" : "+v"(tl_));
        const int l15 = tl_ & 15, g4 = (tl_ >> 4) & 3;
        bf16x8 qf[2], qn[2], kfa[4][2], kfb[4][2]; u32x2 vfa[2][4][2];
#define NA_CC0(qb_) ((qb_) == 0 ? 0 : ((qb_) == 1 ? 8 : ((qb_) == 2 ? 24 : 32)))
#define NA_START(r_) ((r_) - 4 < 0 ? 0 : ((r_) - 4 > 24 ? 24 : (r_) - 4))
        const unsigned qko = (unsigned)(l15 * 2048 + 8 * g4) * 2u, vto = (unsigned)(l15 * TG + 4 * g4) * 2u;
        const char* qkb = (const char*)(QK + cbase * 2048 + h * 64); const char* vtb = (const char*)(VT + (size_t)(h * 64) * TG + cbase);
#define NA_TK(st_, cc_, BLK, t) (CTXL + ((st_) + 2 * (BLK) + ((t) >> 1)) * 64 + (cc_) + 16 * ((t) & 1))
#define NA_LOADQ(dst, tq_) do { _Pragma("unroll") for (int s_ = 0; s_ < 2; ++s_) dst[s_] = *(const bf16x8*)(qkb + (size_t)(tq_) * 4096 + 64 * s_ + qko); } while (0)
#define NA_LOADK(kf, st_, cc_, BLK) do { _Pragma("unroll") for (int t = 0; t < 4; ++t) { const char* kp = qkb + (size_t)NA_TK(st_, cc_, BLK, t) * 4096 + 2048; \
            kf[t][0] = *(const bf16x8*)(kp + qko); kf[t][1] = *(const bf16x8*)(kp + 64 + qko); } } while (0)
#define NA_LOADV(vf, st_, cc_, BLK) do { _Pragma("unroll") for (int pr = 0; pr < 2; ++pr) _Pragma("unroll") for (int dt = 0; dt < 4; ++dt) { const char* vrow = vtb + (size_t)(16 * dt) * TG * 2; \
            vf[pr][dt][0] = *(const u32x2*)(vrow + (size_t)NA_TK(st_, cc_, BLK, 2 * pr) * 2 + vto); vf[pr][dt][1] = *(const u32x2*)(vrow + (size_t)NA_TK(st_, cc_, BLK, 2 * pr + 1) * 2 + vto); } } while (0)
#define NA_SOFTMAX() \
            float bm = -1e30f; \
            _Pragma("unroll") for (int t = 0; t < 4; ++t) bm = fmaxf(fmaxf(fmaxf(st[t][0], st[t][1]), fmaxf(st[t][2], st[t][3])), bm); \
            bm = fmaxf(bm, lane_get(bm, (tl_ & 63) ^ 16)); bm = fmaxf(bm, lane_get(bm, (tl_ & 63) ^ 32)); \
            const float mnew = fmaxf(mrun, bm); const float alpha = ex2((mrun - mnew) * L2E); mrun = mnew; \
            float ps = 0.f; u32x4 pa[2]; \
            _Pragma("unroll") for (int t = 0; t < 4; ++t) { float pv[4]; \
                _Pragma("unroll") for (int e = 0; e < 4; ++e) { pv[e] = ex2((st[t][e] - mnew) * L2E); ps += pv[e]; } \
                pa[t >> 1][2 * (t & 1)] = pk2(pv[0], pv[1]); pa[t >> 1][2 * (t & 1) + 1] = pk2(pv[2], pv[3]); } \
            lrun = lrun * alpha + ps; \
            { float ar[4]; _Pragma("unroll") for (int e = 0; e < 4; ++e) ar[e] = lane_get(alpha, 4 * g4 + e); \
              _Pragma("unroll") for (int dt = 0; dt < 4; ++dt) _Pragma("unroll") for (int e = 0; e < 4; ++e) o[dt][e] *= ar[e]; }
#define NA_BLOCK_WIN(kf, vf, BLK) do { f32x4 st[4]; \
            _Pragma("unroll") for (int t = 0; t < 4; ++t) { const int rr = start + 2 * (BLK) + (t >> 1), kc0 = cc0 + 16 * (t & 1); \
                f32x4 a = (f32x4){0.f, 0.f, 0.f, 0.f}; a = MFMA16(kf[t][0], qf[0], a); a = MFMA16(kf[t][1], qf[1], a); \
                const LAS float* bp = RP + (rr - r + 7) * 31 + (kc0 + 4 * g4 - qc + 15); \
                _Pragma("unroll") for (int e = 0; e < 4; ++e) { const int kc = kc0 + 4 * g4 + e; const bool ok = kc >= cs && kc < cs + 16; a[e] = ok ? a[e] + bp[ok ? e : 0] : -1e30f; } \
                st[t] = a; } \
            NA_SOFTMAX() \
            _Pragma("unroll") for (int pr = 0; pr < 2; ++pr) _Pragma("unroll") for (int dt = 0; dt < 4; ++dt) { \
                const u32x4 vb = (u32x4){vf[pr][dt][0].x, vf[pr][dt][0].y, vf[pr][dt][1].x, vf[pr][dt][1].y}; \
                o[dt] = MFMA16(__builtin_bit_cast(bf16x8, pa[pr]), __builtin_bit_cast(bf16x8, vb), o[dt]); } } while (0)
#define NA_BLOCK_CTX(BLK) do { f32x4 st[4]; \
            _Pragma("unroll") for (int t = 0; t < 4; ++t) { const LAS unsigned char* kp = CK + (64 * (BLK) + 16 * t) * CK_STRIDE + cko; \
                f32x4 a = (f32x4){0.f, 0.f, 0.f, 0.f}; a = MFMA16(*(const LAS bf16x8*)kp, qf[0], a); a = MFMA16(*(const LAS bf16x8*)(kp + 64), qf[1], a); st[t] = a; } \
            NA_SOFTMAX() \
            _Pragma("unroll") for (int pr = 0; pr < 2; ++pr) _Pragma("unroll") for (int dt = 0; dt < 4; ++dt) { const LAS unsigned char* vrow = CV + (16 * dt) * CV_STRIDE + (64 * (BLK) + 32 * pr) * 2 + cvo; \
                const u32x2 lo = *(const LAS u32x2*)vrow, hi = *(const LAS u32x2*)(vrow + 32); const u32x4 vb = (u32x4){lo.x, lo.y, hi.x, hi.y}; \
                o[dt] = MFMA16(__builtin_bit_cast(bf16x8, pa[pr]), __builtin_bit_cast(bf16x8, vb), o[dt]); } } while (0)
#define NA_FINISH(tq_) do { lrun += lane_get(lrun, (tl_ & 63) ^ 16); lrun += lane_get(lrun, (tl_ & 63) ^ 32); \
            _Pragma("unroll") for (int e = 0; e < 4; ++e) { const float inv = 1.f / lane_get(lrun, 4 * g4 + e); \
                _Pragma("unroll") for (int dt = 0; dt < 4; ++dt) O[(cbase + (tq_) + 4 * g4 + e) * 1024 + h * 64 + 16 * dt + l15] = (bf16)f2bf(o[dt][e] * inv); } } while (0)
        {
            const int r0_ = F.wave >> 2, qb0_ = F.wave & 3;
            NA_LOADQ(qn, CTXL + r0_ * 64 + 16 * qb0_); NA_LOADK(kfa, NA_START(r0_), NA_CC0(qb0_), 0); NA_LOADV(vfa, NA_START(r0_), NA_CC0(qb0_), 0);
        }
#pragma unroll 1
        for (int i = 0; i < 16; ++i) {
            const int uu = F.wave + 8 * i; const int r = uu >> 2, qb = uu & 3; const int Rq = CTXL + r * 64 + 16 * qb;
            const int start = NA_START(r), cc0 = NA_CC0(qb);
            const int qc = 16 * qb + l15; const int cs = qc - 8 < 0 ? 0 : (qc - 8 > 48 ? 48 : qc - 8);
            qf[0] = qn[0]; qf[1] = qn[1];
            int cko = l15 * CK_STRIDE + 16 * g4, cvo = l15 * CV_STRIDE + 8 * g4; asm volatile("" : "+v"(cko), "+v"(cvo));
            float mrun = -1e30f, lrun = 0.f;
            f32x4 o[4];
#pragma unroll
            for (int dt = 0; dt < 4; ++dt) o[dt] = (f32x4){0.f, 0.f, 0.f, 0.f};
            NA_LOADK(kfb, start, cc0, 1); __builtin_amdgcn_sched_barrier(0);
            NA_BLOCK_WIN(kfa, vfa, 0); __builtin_amdgcn_sched_barrier(0);
            NA_LOADV(vfa, start, cc0, 1); NA_LOADK(kfa, start, cc0, 2); __builtin_amdgcn_sched_barrier(0);
            NA_BLOCK_WIN(kfb, vfa, 1); __builtin_amdgcn_sched_barrier(0);
            NA_LOADV(vfa, start, cc0, 2); NA_LOADK(kfb, start, cc0, 3); __builtin_amdgcn_sched_barrier(0);
            NA_BLOCK_WIN(kfa, vfa, 2); __builtin_amdgcn_sched_barrier(0);
            NA_LOADV(vfa, start, cc0, 3); __builtin_amdgcn_sched_barrier(0);
            {
                const int un = uu + 8; const int rn = un >> 2, qbn = un & 3;
                if (i < 15) { NA_LOADQ(qn, CTXL + rn * 64 + 16 * qbn); NA_LOADK(kfa, NA_START(rn), NA_CC0(qbn), 0); }
                else NA_LOADQ(qn, 16 * (un - 128));
            }
            __builtin_amdgcn_sched_barrier(0);
            NA_BLOCK_WIN(kfb, vfa, 3); __builtin_amdgcn_sched_barrier(0);
            if (i < 15) { const int un = uu + 8; NA_LOADV(vfa, NA_START(un >> 2), NA_CC0(un & 3), 0); }
            __builtin_amdgcn_sched_barrier(0);
            NA_BLOCK_CTX(0); __builtin_amdgcn_sched_barrier(0); NA_BLOCK_CTX(1); __builtin_amdgcn_sched_barrier(0); NA_BLOCK_CTX(2); __builtin_amdgcn_sched_barrier(0); NA_BLOCK_CTX(3); __builtin_amdgcn_sched_barrier(0);
            NA_FINISH(Rq);
        }
#pragma unroll 1
        for (int i = 16; i < 18; ++i) {
            const int uu = F.wave + 8 * i; const int Rq = 16 * (uu - 128);
            qf[0] = qn[0]; qf[1] = qn[1];
            if (i == 16) NA_LOADQ(qn, 16 * (uu + 8 - 128));
            int cko = l15 * CK_STRIDE + 16 * g4, cvo = l15 * CV_STRIDE + 8 * g4; asm volatile("" : "+v"(cko), "+v"(cvo));
            float mrun = -1e30f, lrun = 0.f;
            f32x4 o[4];
#pragma unroll
            for (int dt = 0; dt < 4; ++dt) o[dt] = (f32x4){0.f, 0.f, 0.f, 0.f};
            NA_BLOCK_CTX(0); __builtin_amdgcn_sched_barrier(0); NA_BLOCK_CTX(1); __builtin_amdgcn_sched_barrier(0); NA_BLOCK_CTX(2); __builtin_amdgcn_sched_barrier(0); NA_BLOCK_CTX(3); __builtin_amdgcn_sched_barrier(0);
            NA_FINISH(Rq);
        }
#undef NA_CC0
#undef NA_START
#undef NA_TK
#undef NA_LOADQ
#undef NA_LOADK
#undef NA_LOADV
#undef NA_SOFTMAX
#undef NA_BLOCK_WIN
#undef NA_BLOCK_CTX
#undef NA_FINISH
        __syncthreads();
    }
}

__device__ __forceinline__ void final_norm_phase(const Frame& F0, const bf16* xfin, float* out, const float* gain) {
    const Frame F = refresh(F0);
    for (int row = F.gw; row < NBATCH * SEQ; row += F.NGW) {
        const bf16* src = xfin + (size_t)row * D; float* dst = out + (size_t)row * D;
        f32x4 v[4]; float ss = 0.f;
#pragma unroll
        for (int j = 0; j < 4; ++j) { const u32x2 w = *(const u32x2*)(src + 4 * F.lane + 256 * j); v[j] = (f32x4){bflo(w.x), bfhi(w.x), bflo(w.y), bfhi(w.y)};
            ss += (v[j].x * v[j].x + v[j].y * v[j].y) + (v[j].z * v[j].z + v[j].w * v[j].w); }
        const float rstd = 1.f / sqrtf(wave_sum(ss, F.lane) * (1.f / D) + EPS);
#pragma unroll
        for (int j = 0; j < 4; ++j) { const int c = 4 * F.lane + 256 * j; const f32x4 gn = *(const f32x4*)(gain + c); *(f32x4*)(dst + c) = (v[j] * rstd) * gn; }
    }
}

__device__ __forceinline__ void dbg_check_ffn(const Frame& F0, const float* up, const float* cw, const float* cb) {
    const Frame F = refresh(F0);
    if (F.vcu != 0 || F.tid >= 1) return;
    const bf16* Hh = (const bf16*)(F.ws + WS_ACT + A_H); const bf16* ACT = (const bf16*)(F.ws + WS_ACT + A_ACT);
    const int row = 276, c = 5;
    float u[2][5];
    for (int half = 0; half < 2; ++half) for (int k = 0; k < 5; ++k) {
        const int rr = row + (k == 0 ? -16 : (k == 4 ? 16 : k - 2)); const int col = half * FFN + c;
        float d = 0.f; for (int q = 0; q < 1024; ++q) d += bf2f(Hh[(size_t)rr * 1024 + q]) * up[(size_t)q * FFN2 + col]; u[half][k] = d; }
    const float got = bf2f(ACT[(size_t)row * FFN + c]);
    unsigned code = 9;
    for (int hyp = 8; hyp >= 1; --hyp) {
        float uv2[2];
        for (int half = 0; half < 2; ++half) { const int col = half * FFN + c; const float w0 = cw[col], w1 = cw[FFN2 + col], w2 = cw[2 * FFN2 + col], b = cb[col];
            float pv = u[half][1], cv = u[half][2], nv = u[half][3];
            if (hyp == 2) { pv = u[half][3]; nv = u[half][1]; }
            if (hyp == 3) { pv = 0.f; nv = 0.f; }
            if (hyp == 4) { pv = u[half][0]; nv = u[half][4]; }
            if (hyp == 5) { pv = u[half][4]; nv = u[half][0]; }
            if (hyp == 6) { pv = 0.f; }
            if (hyp == 7) { nv = 0.f; }
            if (hyp == 8) { pv = cv; nv = cv; }
            uv2[half] = b + w0 * pv + w1 * cv + w2 * nv; }
        const float ref = silu_f(uv2[0]) * uv2[1];
        if (fabsf(ref - got) <= 0.03f + 0.03f * fabsf(ref)) code = hyp;
    }
    atomicMin((unsigned*)(F.ws + WS_CTL) + CW_DBG, code);
}

__global__ void __launch_bounds__(NTHR, 2) mega_fwd(Args a) {
    extern __shared__ __attribute__((aligned(16))) unsigned char lds_raw[];
    Frame F;
    F.lds = (LAS unsigned char*)lds_raw;
    F.tid = threadIdx.x; F.lane = F.tid & 63; F.wave = __builtin_amdgcn_readfirstlane(F.tid >> 6);
    F.G = gridDim.x; { const int bx = blockIdx.x; F.vcu = (F.G % 8 == 0) ? (bx % 8) * (F.G / 8) + bx / 8 : bx; }
    F.gw = F.vcu * NWAVES + F.wave; F.NGW = F.G * NWAVES; F.ws = AWS;
    volatile LAS unsigned* MISC = (volatile LAS unsigned*)(F.lds + MISC_OFF);
    for (int u = F.tid; u < (LDS_BYTES - MISC_OFF) / 4; u += NTHR) ((LAS unsigned*)(F.lds + MISC_OFF))[u] = 0u;
    __syncthreads();
    unsigned* ctl = (unsigned*)(AWS + WS_CTL);
    XcdBarrier bar = xcd_barrier_post(ctl + CW_BAR, MISC + 8);
    (void)bar;
#define GRID_BAR() do { XcdBarrier b_; b_.bar = (unsigned*)(AWS + WS_CTL) + CW_BAR; unsigned x_ = xb_xcc_id(); asm volatile("" : "+s"(x_)); b_.x = x_; \
        b_.st = (volatile LAS unsigned*)(F.lds + MISC_OFF) + 8; b_.t0 = (F.wave == 0) && (lane_id() == 0); xcd_barrier(b_); } while (0)
#define MOD ((const float*)(AWS + WS_MOD))
#define XS ((bf16*)AOUT)
#define CS ((bf16*)(AWS + WS_CTX))
#define XFIN ((bf16*)(AWS + WS_ACT + A_H))
#define Wb ((bf16*)(AWS + WS_W))
#define H ((bf16*)(AWS + WS_ACT + A_H))
    const int bx = (int)blockIdx.x;

    if (DBG && blockIdx.x == 0 && threadIdx.x == 0) __hip_atomic_store((unsigned*)(AWS + WS_CTL) + CW_DBG, 0xffffffffu, RLX_AGENT);
    if (EN(1)) prologue(F); if (DUP & (1 << 1)) { GRID_BAR(); prologue(F); }
    GRID_BAR();

#define GEMM_BF16(Aptr, Btptr, M_, N_, K_, Optr, ldc_) do { pg8::Gemm gg{(const bf16*)(Aptr), (const bf16*)(Btptr), (M_), (N_), (K_)}; pg8::StaticOrder So; So.init((M_), (N_), F.G, bx); \
        pg8::EpiBf16 Ee{(bf16*)(Optr), (ldc_)}; pg8::gemm_phase<pg8::EpiBf16, pg8::StaticOrder, true>(F.lds, gg, So, Ee, F.wave); } while (0)
#define STATP ((float*)(AWS + WS_STAT))
#define TBP ((const float*)(AWS + WS_T))
#define GEMM_BF16N(SW, Aptr, Btptr, M_, N_, K_, Optr, ldc_, tile0_, Toff_, ldt_) do { pg8::Gemm gg{(const bf16*)(Aptr), (const bf16*)(Btptr), (M_), (N_), (K_)}; pg8::StaticOrder So; So.init((M_), (N_), F.G, bx); \
        pg8::EpiBf16N<SW> Ee{(bf16*)(Optr), (ldc_), STATP, TBP + (Toff_), (ldt_), F.lds + NSLOT_OFF, (tile0_)}; pg8::gemm_phase<pg8::EpiBf16N<SW>, pg8::StaticOrder, true>(F.lds, gg, So, Ee, F.wave); } while (0)
#define GEMM_RESID(Aptr, Btptr, M_, K_, sx, sc, f32s_, dx_, layer, goff_, b0_, NL_, NF_) do { pg8::Gemm gg{(const bf16*)(Aptr), (const bf16*)(Btptr), (M_), D, (K_)}; pg8::StaticOrder So; So.init((M_), D, F.G, bx, (layer) == 3 ? 1 : 0); \
        pg8::EpiResid Ee{(sx), (sc), (dx_), CS, MOD + (size_t)(layer) * 33 * NMOD, (goff_), (b0_), (f32s_), \
            (NF_) < 0 ? (bf16*)nullptr : H, ((NF_) == 0 && (NL_) == 3) ? HALT - (size_t)TG * D : H, ((NF_) > 0 ? AIN(I_NFFN) : AIN(I_NMIX)) + (NL_) * D, MOD + (size_t)(NL_) * 33 * NMOD, (NF_) > 0 ? 4 * D : D, STATP, F.lds + 131072}; \
        pg8::gemm_phase<pg8::EpiResid, pg8::StaticOrder, true>(F.lds, gg, So, Ee, F.wave); } while (0)
#define FFN_BLOCK(layer) do { \
        { bf16* Wup = Wb + (W_FFN + (size_t)(layer) * (16 * MiB + 512 * 1024)) / 2; bf16* Wdn = Wup + (11 * MiB) / 2; \
          for (int rep_ = 0; rep_ < ((DUP & (1 << 15)) ? 2 : 1); ++rep_) { if (rep_) GRID_BAR(); if (EN(3)) { pg8::Gemm gg{H, Wup, NBATCH * PT, FFN2, D}; pg8::StaticOrder So; So.init(NBATCH * PT, FFN2, F.G, bx, (layer) == 3 ? 1 : 0); \
              pg8::EpiConvGate Ee{(bf16*)(AWS + WS_ACT + A_ACT), (bf16*)(AWS + WS_ACT + A_EDGE), AIN(I_FCW) + (size_t)(layer) * 3 * FFN2, AIN(I_FCB) + (size_t)(layer) * FFN2, F.lds + 131072, F.lds + MISC_OFF + 512, STATP, TBP + TB_FFN + (size_t)(layer) * TB_FFN_SZ, F.lds + NSLOT_OFF}; \
              pg8::gemm_phase<pg8::EpiConvGate, pg8::StaticOrder, true>(F.lds, gg, So, Ee, F.wave); } } GRID_BAR(); \
          if (EN(4)) ffn_fix_phase(F, AIN(I_FCW) + (size_t)(layer) * 3 * FFN2, AIN(I_FCB) + (size_t)(layer) * FFN2); GRID_BAR(); \
          if (DBG && (layer) == 0) { dbg_check_ffn(F, AIN(I_UP), AIN(I_FCW), AIN(I_FCB)); GRID_BAR(); } \
          if (EN(5)) GEMM_RESID(AWS + WS_ACT + A_ACT, Wdn, NBATCH * PT, FFN, XS, CS, 0, (layer) == 3 ? XFIN : XS, (layer), 5 * D, 0, (layer) + 1, (layer) < 3 ? 0 : -1); GRID_BAR(); } } while (0)
#define HALT (XS + (size_t)NBATCH * SEQ * D)
#define RET_MIXER(layer, j, sx, sc, f32s_, DN_) do { \
        if (!(DN_)) { if (EN(2)) norm_phase(F, g * NB, TG, (sx), (sc), (f32s_), AIN(I_NMIX) + (layer) * D, MOD + (size_t)(layer) * 33 * NMOD, 0, D); GRID_BAR(); } \
        { bf16* Wa = Wb + (W_RET + (size_t)(j) * 18 * MiB) / 2; bf16* Wbb = Wa + (8 * MiB) / 2; const bf16* Hg = ((DN_) && g == 1) ? HALT : H; \
          if (EN(3)) { pg8::Gemm gg{Hg, Wa, TG, 4096, D}; pg8::StaticOrder So; So.init(TG, 4096, F.G, bx); pg8::EpiRopeQ<DN_> Ee{(bf16*)(AWS + WS_ACT + A_QKG), (const float*)(AWS + WS_ROPE), STATP, TBP + TB_RETA, F.lds + NSLOT_OFF, g * 144}; \
              pg8::gemm_phase<pg8::EpiRopeQ<DN_>, pg8::StaticOrder, true>(F.lds, gg, So, Ee, F.wave); } \
          if (EN(3)) { pg8::Gemm gg{Wbb, Hg, 3072, TG, D}; pg8::StaticOrder So; So.init(3072, TG, F.G, bx); pg8::EpiRopeKT<DN_> Ee{(bf16*)(AWS + WS_ACT + A_KVT), (const float*)(AWS + WS_ROPE), TG, STATP, TBP + TB_RETB, F.lds + NSLOT_OFF, g * 144}; \
              pg8::gemm_phase<pg8::EpiRopeKT<DN_>, pg8::StaticOrder, true>(F.lds, gg, So, Ee, F.wave); } GRID_BAR(); \
          if (EN(7)) ret_scan_phase(F, AIN(I_RDEC) + (j) * 8, (size_t)g * 144 * MiB); GRID_BAR(); \
          if (EN(8)) ret_gn_phase(F, AIN(I_RGN) + (j) * 2048, (size_t)g * 144 * MiB); GRID_BAR(); } } while (0)
#define RET_OUT(layer, j, sx, sc, f32s_) do { bf16* Wo = Wb + (W_RET + (size_t)(j) * 18 * MiB + 14 * MiB) / 2; \
        if (EN(5)) GEMM_RESID(AWS + WS_ACT + A_Y, Wo, NBATCH * PT, 2048, (sx), (sc), (f32s_), XS, (layer), 2 * D, 0, (layer), 1); GRID_BAR(); } while (0)

    if (EN(2)) t_phase(F);
    for (int g = 0; g < NG; ++g) RET_MIXER(0, 0, AIN(I_X), AIN(I_CTX), 1, false);
    RET_OUT(0, 0, AIN(I_X), AIN(I_CTX), 1);
    FFN_BLOCK(0);
    for (int g = 0; g < NG; ++g) {
        if (EN(3)) GEMM_BF16N(false, H + (size_t)g * TG * D, Wb + W_LRU_IN / 2, TG, 2560, D, AWS + WS_ACT + A_YX, 2560, g * 144, TB_LRU, 2560); GRID_BAR();
        if (EN(10)) lru_gate_phase(F, AIN(I_LCW), AIN(I_LCB), AIN(I_LGB), AIN(I_LLAM)); GRID_BAR();
        if (EN(11)) lru_scan_phase(F, (size_t)g * 90 * MiB); GRID_BAR();
    }
    if (EN(5)) GEMM_RESID(AWS + WS_ACT + A_A3, Wb + W_LRU_OUT / 2, NBATCH * PT, LW, XS, CS, 0, XS, 1, 2 * D, 0, 1, 1); GRID_BAR();
    FFN_BLOCK(1);
    for (int g = 0; g < NG; ++g) {
        if (EN(3)) GEMM_BF16N(false, H + (size_t)g * TG * D, Wb + W_NA_QK / 2, TG, 2048, D, AWS + WS_ACT + A_QK, 2048, g * 144, TB_NAQK, 2048);
        if (EN(3)) GEMM_BF16N(true, Wb + W_NA_V / 2, H + (size_t)g * TG * D, 1024, TG, D, AWS + WS_ACT + A_VT, TG, g * 144, TB_NAV, 1024); GRID_BAR();
        if (EN(13)) na_attn_phase(F, AIN(I_NRPB), (size_t)g * 72 * MiB); GRID_BAR();
    }
    if (EN(5)) GEMM_RESID(AWS + WS_ACT + A_O, Wb + W_NA_O / 2, NBATCH * PT, D, XS, CS, 0, XS, 2, 2 * D, 0, 2, 1); GRID_BAR();
    FFN_BLOCK(2);
    for (int g = 0; g < NG; ++g) RET_MIXER(3, 1, XS, CS, 0, true);
    RET_OUT(3, 1, XS, CS, 0);
    FFN_BLOCK(3);
    if (EN(14)) final_norm_phase(F, XFIN, AOUT, AIN(I_FNORM));
    if (DBG) { GRID_BAR(); const unsigned code = __hip_atomic_load((unsigned*)(AWS + WS_CTL) + CW_DBG, RLX_AGENT);
        if (code != 0xffffffffu) { float* o = AOUT; for (size_t i = (size_t)blockIdx.x * NTHR + threadIdx.x; i < (size_t)NBATCH * SEQ * D; i += (size_t)gridDim.x * NTHR) o[i] = 1000.f * (float)code; } }
}

extern "C" void kernel_launch(void* const* d_in, const int* in_sizes, int n_in, void* d_out, int out_size, void* d_ws, size_t ws_size, hipStream_t stream) {
    static int grid = 0;
    if (grid == 0) {
        if (n_in != 27 || ws_size < WS_END) { fprintf(stderr, "kernel_launch: need 27 inputs and >= %zu bytes of workspace; got %d, %zu\n", (size_t)WS_END, n_in, ws_size); grid = -1; return; }
        int dev = 0, cus = 0, per_cu = 0;
        if (hipGetDevice(&dev) != hipSuccess || hipDeviceGetAttribute(&cus, hipDeviceAttributeMultiprocessorCount, dev) != hipSuccess) { grid = -1; return; }
        if (hipFuncSetAttribute((const void*)mega_fwd, hipFuncAttributeMaxDynamicSharedMemorySize, LDS_BYTES) != hipSuccess) { fprintf(stderr, "kernel_launch: hipFuncSetAttribute failed\n"); grid = -1; return; }
        if (hipOccupancyMaxActiveBlocksPerMultiprocessor(&per_cu, (const void*)mega_fwd, NTHR, LDS_BYTES) != hipSuccess || per_cu < 1) { fprintf(stderr, "kernel_launch: occupancy query says %d\n", per_cu); }
        (void)hipGetLastError();
        grid = cus;
    }
    if (grid < 0) return;
    (void)hipMemsetAsync((char*)d_ws + WS_CTL, 0, CTL_ZERO_BYTES, stream);
    Args a{};
    for (int i = 0; i < 27; ++i) a.in[i] = (const float*)d_in[i];
    a.out = (float*)d_out; a.ws = (unsigned char*)d_ws;
    hipLaunchKernelGGL(mega_fwd, dim3(grid), dim3(NTHR), LDS_BYTES, stream, a);
}
```

```cpp
#include <hip/hip_runtime.h>
#include <cstdio>
#include <cstdint>

#ifndef DBG
#define DBG 0
#endif
#ifndef ONLY
#define ONLY 0
#endif
#define EN(k) (ONLY == 0 || ONLY == (k))
#ifndef DUP
#define DUP 0
#endif

#define GAS __attribute__((address_space(1)))
#define LAS __attribute__((address_space(3)))
typedef unsigned short bf16;
typedef short bf16x8 __attribute__((ext_vector_type(8)));
typedef float f32x4 __attribute__((ext_vector_type(4)));
typedef float f32x2 __attribute__((ext_vector_type(2)));
typedef unsigned u32x4 __attribute__((ext_vector_type(4)));
typedef unsigned u32x2 __attribute__((ext_vector_type(2)));
typedef GAS unsigned gu32;

__device__ __forceinline__ int lane_id() { unsigned m = ~0u; asm volatile("" : "+s"(m)); return (int)__builtin_amdgcn_mbcnt_hi(m, __builtin_amdgcn_mbcnt_lo(m, 0u)); }
namespace pg8 {
#define PG8_LAS __attribute__((address_space(3)))
typedef unsigned short bf16_t;
constexpr int BM = 256, BK = 64, HALF = 128, HTB = HALF * BK * 2, STAGE_BYTES = 8 * HTB, NXCD = 8, WGM = 8;
__host__ __device__ __forceinline__ int lds_byte(int r, int c) { const int st = (r >> 4) * 2 + (c >> 5), rr = r & 15, cc = c & 31, ob = rr * 64 + cc * 2; return st * 1024 + (ob ^ (((ob >> 9) & 1) << 5)); }
__host__ __device__ __forceinline__ void stage_rc(int b, int& R, int& C) { const int st = b / 1024, sb = b % 1024, swz = sb ^ (((sb >> 9) & 1) << 5); R = (st >> 1) * 16 + swz / 64; C = (st & 1) * 32 + (swz % 64) / 2; }
__host__ __device__ __forceinline__ int perm32(int rho) { const int n = rho >> 4, i = rho & 15; return 8 * (i >> 2) + 4 * n + (i & 3); }
struct Unit { int pm, pn; };
struct Gemm { const bf16_t* A; const bf16_t* Bt; int M, N, K; };
struct StaticOrder {
    int nM, nN, nwg, G, c;
    __host__ __device__ __forceinline__ void init(int M, int N, int G_, int c_, int lat_ = 0) { nM = M / BM; if (lat_) nM = nM / 9 * 8; nN = N / BM; nwg = nM * nN; G = G_; c = c_; if (lat_) nN = -nN; }
    __host__ __device__ __forceinline__ bool next(int i, Unit& u) const {
        const long L = (long)i * G + c; if (L >= nwg) return false;
        const int nn = nN < 0 ? -nN : nN;
        int wgid = (int)L; { const int q = nwg / NXCD, r = nwg % NXCD, xcd = wgid % NXCD, off = wgid / NXCD; wgid = (xcd < r ? xcd * (q + 1) : r * (q + 1) + (xcd - r) * q) + off; }
        const int nig = WGM * nn, gid = wgid / nig, fm = gid * WGM, gsz = (nM - fm) < WGM ? (nM - fm) : WGM;
        u.pm = fm + ((wgid % nig) % gsz); u.pn = (wgid % nig) / gsz; if (nN < 0) u.pm += (u.pm >> 3) + 1; return true;
    }
    __device__ __forceinline__ void a_ready(const Unit&) const {}
    __device__ __forceinline__ void done(const Unit&) const {}
};
__device__ __forceinline__ unsigned cvt_pk_bf16(float lo, float hi) { unsigned r; asm volatile("v_cvt_pk_bf16_f32 %0, %1, %2" : "=v"(r) : "v"(lo), "v"(hi)); return r; }

struct EpiBf16 {
    static constexpr bool PERM = true, AFTER_DRAIN = false, PERMA = false;
    bf16_t* O; int ldc;
    __device__ __forceinline__ f32x2 pre(const Unit&, int, int) const { return (f32x2){0.f, 0.f}; }
    __device__ __forceinline__ void operator()(const f32x4 (&acc)[2][2][4][2], const Unit& u, int wr, int wc, int fr_, int fq_, f32x2) const {
        int fr = fr_, fq = fq_; asm volatile("" : "+v"(fr), "+v"(fq));
        const int row0 = u.pm * BM + wr * 64 + fr; const int col0 = u.pn * BM + wc * 32 + 8 * fq;
#pragma unroll
        for (int ai = 0; ai < 2; ++ai)
#pragma unroll
            for (int m = 0; m < 4; ++m) { bf16_t* rowp = O + (size_t)(row0 + ai * HALF + m * 16) * ldc + col0;
#pragma unroll
                for (int bj = 0; bj < 2; ++bj) { const f32x4 v0 = acc[ai][bj][m][0], v1 = acc[ai][bj][m][1];
                    u32x4 w; w.x = cvt_pk_bf16(v0[0], v0[1]); w.y = cvt_pk_bf16(v0[2], v0[3]); w.z = cvt_pk_bf16(v1[0], v1[1]); w.w = cvt_pk_bf16(v1[2], v1[3]);
                    *(u32x4*)(rowp + bj * HALF) = w; } }
    }
};
constexpr int NSLOT_BYTES = 5120;
__device__ __forceinline__ void norm_pre(const float* stat, const float* T, int ldt, int tok_tile, int feat_tile, PG8_LAS unsigned char* nl, int tid_, int slot) {
    int tid = tid_; asm volatile("" : "+v"(tid));
    const int wv = __builtin_amdgcn_readfirstlane(tid >> 6), lane = tid & 63;
    const int mr = (tok_tile % 9 == 0) ? 32 : tok_tile / 9;
    if (wv < 4) __builtin_amdgcn_global_load_lds((const unsigned*)(stat + ((size_t)tok_tile * 256 + wv * 64 + lane) * 4), (PG8_LAS unsigned*)(nl + slot * NSLOT_BYTES + wv * 1024), 16, 0, 0);
    else if (wv == 4) __builtin_amdgcn_global_load_lds((const unsigned*)(T + (size_t)mr * ldt + feat_tile * 256 + lane * 4), (PG8_LAS unsigned*)(nl + slot * NSLOT_BYTES + 4096), 16, 0, 0);
}
__device__ __forceinline__ float norm_rstd(const PG8_LAS float* NL, int tok) { const f32x4 p = *(const PG8_LAS f32x4*)(NL + tok * 4); return __builtin_amdgcn_rsqf(((p.x + p.y) + (p.z + p.w)) * (1.f / 1024.f) + 1e-6f); }
template <bool NORM>
struct EpiRopeQ {
    static constexpr bool PERM = true, AFTER_DRAIN = false, PERMA = false;
    bf16_t* O; const float* RT; const float* stat; const float* T; PG8_LAS unsigned char* nl; int tile0;
    __device__ __forceinline__ f32x2 pre(const Unit& u, int tid, int slot) const { if (NORM) norm_pre(stat, T, 4096, tile0 + u.pm, u.pn, nl, tid, slot); return (f32x2){__int_as_float(slot), 0.f}; }
    __device__ __forceinline__ void operator()(const f32x4 (&acc)[2][2][4][2], const Unit& u, int wr, int wc, int fr_, int fq_, f32x2 wpre) const {
        int fr = fr_, fq = fq_; asm volatile("" : "+v"(fr), "+v"(fq));
        const PG8_LAS float* NL = (const PG8_LAS float*)(nl + __builtin_amdgcn_readfirstlane(__float_as_int(wpre.x)) * NSLOT_BYTES);
        f32x4 tc[2][2];
#pragma unroll
        for (int bj = 0; bj < 2; ++bj)
#pragma unroll
            for (int n = 0; n < 2; ++n) tc[bj][n] = NORM ? *(const PG8_LAS f32x4*)(NL + 1024 + bj * HALF + wc * 32 + 8 * fq + 4 * n) : (f32x4){0.f, 0.f, 0.f, 0.f};
#define RQ_VAL(ai, bj, m, n, rs) (NORM ? acc[ai][bj][m][n] * (rs) + tc[bj][n] : acc[ai][bj][m][n])
        if (u.pn >= 8) {
            const int row0 = u.pm * BM + wr * 64 + fr; const int col0 = u.pn * BM + wc * 32 + 8 * fq;
#pragma unroll
            for (int ai = 0; ai < 2; ++ai)
#pragma unroll
                for (int m = 0; m < 4; ++m) { bf16_t* rowp = O + (size_t)(row0 + ai * HALF + m * 16) * 4096 + col0;
                    const float rs = NORM ? norm_rstd(NL, ai * HALF + wr * 64 + m * 16 + fr) : 1.f;
#pragma unroll
                    for (int bj = 0; bj < 2; ++bj) { const f32x4 v0 = RQ_VAL(ai, bj, m, 0, rs), v1 = RQ_VAL(ai, bj, m, 1, rs);
                        u32x4 w; w.x = cvt_pk_bf16(v0[0], v0[1]); w.y = cvt_pk_bf16(v0[2], v0[3]); w.z = cvt_pk_bf16(v1[0], v1[1]); w.w = cvt_pk_bf16(v1[2], v1[3]);
                        *(u32x4*)(rowp + bj * HALF) = w; } }
            return;
        }
        const int pt = u.pm % 9; const bool lat = pt != 0;
        const int hfj = wc >> 1, m0 = (32 * wc + 8 * fq) & 63;
#pragma unroll
        for (int ai = 0; ai < 2; ++ai)
#pragma unroll
            for (int m = 0; m < 4; ++m) { const int rl = ai * HALF + wr * 64 + m * 16 + fr;
                bf16_t* rowp = O + (size_t)(u.pm * BM + rl) * 4096 + u.pn * BM + 128 * hfj + m0;
                const float rs = NORM ? norm_rstd(NL, rl) : 1.f;
                f32x4 a0 = RQ_VAL(ai, 0, m, 0, rs), a1 = RQ_VAL(ai, 0, m, 1, rs), b0 = RQ_VAL(ai, 1, m, 0, rs), b1 = RQ_VAL(ai, 1, m, 1, rs);
                if (lat) { const int t = (pt - 1) * 256 + rl; const int pos = hfj == 0 ? (t >> 6) : (t & 63);
                    const float* cp = RT + 2 * (pos * 64 + m0);
                    const f32x4 c0 = *(const f32x4*)cp, c1 = *(const f32x4*)(cp + 4), c2 = *(const f32x4*)(cp + 8), c3 = *(const f32x4*)(cp + 12);
                    const f32x4 co0 = (f32x4){c0.x, c0.z, c1.x, c1.z}, si0 = (f32x4){c0.y, c0.w, c1.y, c1.w}, co1 = (f32x4){c2.x, c2.z, c3.x, c3.z}, si1 = (f32x4){c2.y, c2.w, c3.y, c3.w};
                    const f32x4 n0 = a0 * co0 - b0 * si0, n1 = a1 * co1 - b1 * si1; b0 = a0 * si0 + b0 * co0; b1 = a1 * si1 + b1 * co1; a0 = n0; a1 = n1; }
                u32x4 w; w.x = cvt_pk_bf16(a0[0], a0[1]); w.y = cvt_pk_bf16(a0[2], a0[3]); w.z = cvt_pk_bf16(a1[0], a1[1]); w.w = cvt_pk_bf16(a1[2], a1[3]);
                *(u32x4*)rowp = w;
                w.x = cvt_pk_bf16(b0[0], b0[1]); w.y = cvt_pk_bf16(b0[2], b0[3]); w.z = cvt_pk_bf16(b1[0], b1[1]); w.w = cvt_pk_bf16(b1[2], b1[3]);
                *(u32x4*)(rowp + 64) = w; }
#undef RQ_VAL
    }
};
template <bool NORM>
struct EpiRopeKT {
    static constexpr bool PERM = true, AFTER_DRAIN = false, PERMA = false;
    bf16_t* O; const float* RT; int ldc; const float* stat; const float* T; PG8_LAS unsigned char* nl; int tile0;
    __device__ __forceinline__ f32x2 pre(const Unit& u, int tid, int slot) const { if (NORM) norm_pre(stat, T, 3072, tile0 + u.pn, u.pm, nl, tid, slot); return (f32x2){__int_as_float(slot), 0.f}; }
    __device__ __forceinline__ void operator()(const f32x4 (&acc)[2][2][4][2], const Unit& u, int wr, int wc, int fr_, int fq_, f32x2 wpre) const {
        int fr = fr_, fq = fq_; asm volatile("" : "+v"(fr), "+v"(fq));
        const PG8_LAS float* NL = (const PG8_LAS float*)(nl + __builtin_amdgcn_readfirstlane(__float_as_int(wpre.x)) * NSLOT_BYTES);
        f32x4 rc[2][2];
#pragma unroll
        for (int bj = 0; bj < 2; ++bj)
#pragma unroll
            for (int n = 0; n < 2; ++n) { const int cl = bj * HALF + wc * 32 + 8 * fq + 4 * n;
                rc[bj][n] = NORM ? (f32x4){norm_rstd(NL, cl), norm_rstd(NL, cl + 1), norm_rstd(NL, cl + 2), norm_rstd(NL, cl + 3)} : (f32x4){1.f, 1.f, 1.f, 1.f}; }
#define RK_VAL(ai, bj, m, n) (NORM ? acc[ai][bj][m][n] * rc[bj][n] + NL[1024 + (ai) * HALF + wr * 64 + (m) * 16 + fr] : acc[ai][bj][m][n])
        const int col0 = u.pn * BM + wc * 32 + 8 * fq;
        if (u.pm >= 4) {
            const int row0 = u.pm * BM + wr * 64 + fr;
#pragma unroll
            for (int ai = 0; ai < 2; ++ai)
#pragma unroll
                for (int m = 0; m < 4; ++m) { bf16_t* rowp = O + (size_t)(row0 + ai * HALF + m * 16) * ldc + col0;
#pragma unroll
                    for (int bj = 0; bj < 2; ++bj) { const f32x4 v0 = RK_VAL(ai, bj, m, 0), v1 = RK_VAL(ai, bj, m, 1);
                        u32x4 w; w.x = cvt_pk_bf16(v0[0], v0[1]); w.y = cvt_pk_bf16(v0[2], v0[3]); w.z = cvt_pk_bf16(v1[0], v1[1]); w.w = cvt_pk_bf16(v1[2], v1[3]);
                        *(u32x4*)(rowp + bj * HALF) = w; } }
            return;
        }
        const int pt = u.pn % 9; const bool lat = pt != 0;
#pragma unroll
        for (int m = 0; m < 4; ++m) { const int mi = m * 16 + fr;
            bf16_t* rowp = O + (size_t)(u.pm * BM + 128 * wr + mi) * ldc + col0;
#pragma unroll
            for (int bj = 0; bj < 2; ++bj) {
                f32x4 a0 = RK_VAL(0, bj, m, 0), a1 = RK_VAL(0, bj, m, 1), b0 = RK_VAL(1, bj, m, 0), b1 = RK_VAL(1, bj, m, 1);
                if (lat) { const int tb = (pt - 1) * 256 + bj * HALF + wc * 32 + 8 * fq;
                    f32x4 co0, si0, co1, si1;
                    if (wr == 0) { const f32x2 c = *(const f32x2*)(RT + 2 * ((tb >> 6) * 64 + mi)); co0 = (f32x4){c.x, c.x, c.x, c.x}; si0 = (f32x4){c.y, c.y, c.y, c.y}; co1 = co0; si1 = si0; }
                    else { const float* cp = RT + 2 * ((tb & 63) * 64 + mi);
#pragma unroll
                        for (int e = 0; e < 4; ++e) { const f32x2 c = *(const f32x2*)(cp + 128 * e), d = *(const f32x2*)(cp + 128 * (e + 4)); co0[e] = c.x; si0[e] = c.y; co1[e] = d.x; si1[e] = d.y; } }
                    const f32x4 n0 = a0 * co0 - b0 * si0, n1 = a1 * co1 - b1 * si1; b0 = a0 * si0 + b0 * co0; b1 = a1 * si1 + b1 * co1; a0 = n0; a1 = n1; }
                u32x4 w; w.x = cvt_pk_bf16(a0[0], a0[1]); w.y = cvt_pk_bf16(a0[2], a0[3]); w.z = cvt_pk_bf16(a1[0], a1[1]); w.w = cvt_pk_bf16(a1[2], a1[3]);
                *(u32x4*)(rowp + bj * HALF) = w;
                w.x = cvt_pk_bf16(b0[0], b0[1]); w.y = cvt_pk_bf16(b0[2], b0[3]); w.z = cvt_pk_bf16(b1[0], b1[1]); w.w = cvt_pk_bf16(b1[2], b1[3]);
                *(u32x4*)(rowp + (size_t)64 * ldc + bj * HALF) = w; } }
#undef RK_VAL
    }
};
template <bool SWAP>
struct EpiBf16N {
    static constexpr bool PERM = true, AFTER_DRAIN = false, PERMA = false;
    bf16_t* O; int ldc; const float* stat; const float* T; int ldt; PG8_LAS unsigned char* nl; int tile0;
    __device__ __forceinline__ f32x2 pre(const Unit& u, int tid, int slot) const { norm_pre(stat, T, ldt, tile0 + (SWAP ? u.pn : u.pm), SWAP ? u.pm : u.pn, nl, tid, slot); return (f32x2){__int_as_float(slot), 0.f}; }
    __device__ __forceinline__ void operator()(const f32x4 (&acc)[2][2][4][2], const Unit& u, int wr, int wc, int fr_, int fq_, f32x2 wpre) const {
        int fr = fr_, fq = fq_; asm volatile("" : "+v"(fr), "+v"(fq));
        const PG8_LAS float* NL = (const PG8_LAS float*)(nl + __builtin_amdgcn_readfirstlane(__float_as_int(wpre.x)) * NSLOT_BYTES);
        const int row0 = u.pm * BM + wr * 64 + fr; const int col0 = u.pn * BM + wc * 32 + 8 * fq;
        f32x4 cv[2][2];
#pragma unroll
        for (int bj = 0; bj < 2; ++bj)
#pragma unroll
            for (int n = 0; n < 2; ++n) { const int cl = bj * HALF + wc * 32 + 8 * fq + 4 * n;
                if (!SWAP) cv[bj][n] = *(const PG8_LAS f32x4*)(NL + 1024 + cl);
                else cv[bj][n] = (f32x4){norm_rstd(NL, cl), norm_rstd(NL, cl + 1), norm_rstd(NL, cl + 2), norm_rstd(NL, cl + 3)}; }
#pragma unroll
        for (int ai = 0; ai < 2; ++ai)
#pragma unroll
            for (int m = 0; m < 4; ++m) { bf16_t* rowp = O + (size_t)(row0 + ai * HALF + m * 16) * ldc + col0;
                const int rl = ai * HALF + wr * 64 + m * 16 + fr;
                const float rv = SWAP ? NL[1024 + rl] : norm_rstd(NL, rl);
#pragma unroll
                for (int bj = 0; bj < 2; ++bj) { f32x4 v0, v1;
                    if (!SWAP) { v0 = acc[ai][bj][m][0] * rv + cv[bj][0]; v1 = acc[ai][bj][m][1] * rv + cv[bj][1]; }
                    else { v0 = acc[ai][bj][m][0] * cv[bj][0] + rv; v1 = acc[ai][bj][m][1] * cv[bj][1] + rv; }
                    u32x4 w; w.x = cvt_pk_bf16(v0[0], v0[1]); w.y = cvt_pk_bf16(v0[2], v0[3]); w.z = cvt_pk_bf16(v1[0], v1[1]); w.w = cvt_pk_bf16(v1[2], v1[3]);
                    *(u32x4*)(rowp + bj * HALF) = w; } }
    }
};
struct EpiResid {
    static constexpr bool PERM = true, AFTER_DRAIN = false, PERMA = false;
    const void* src_x; const void* src_c; bf16_t* dst_x; bf16_t* dst_c; const float* modl; int goff; int b0; int f32src;
    bf16_t* Hn; bf16_t* Hn2; const float* ngain; const float* nmodl; int nscoff; float* stat; PG8_LAS unsigned char* eb;
    __device__ __forceinline__ f32x2 pre(const Unit&, int, int) const { return (f32x2){0.f, 0.f}; }
    __device__ __forceinline__ void operator()(const f32x4 (&acc)[2][2][4][2], const Unit& u, int wr, int wc, int fr_, int fq_, f32x2) const {
        int fr = fr_, fq = fq_; asm volatile("" : "+v"(fr), "+v"(fq));
        const int bl = u.pm / 9, pt = u.pm % 9, b = b0 + bl;
        const float* gate = modl + (size_t)(pt == 0 ? 32 : b) * 6144 + goff;
        const size_t rbase = pt == 0 ? (size_t)b * 256 : (size_t)b * 2048 + (size_t)(pt - 1) * 256;
        const void* s = pt == 0 ? src_c : src_x; bf16_t* d = pt == 0 ? dst_c : dst_x;
        const int r0 = wr * 64 + fr, col0 = u.pn * BM + wc * 32 + 8 * fq;
        f32x4 gv[2][2], cf[2][2];
        const bool dn = Hn != nullptr;
#pragma unroll
        for (int bj = 0; bj < 2; ++bj)
#pragma unroll
            for (int n = 0; n < 2; ++n) { gv[bj][n] = *(const f32x4*)(gate + col0 + bj * HALF + 4 * n);
                if (dn) { const float* nsc = nmodl + (size_t)(pt == 0 ? 32 : b) * 6144 + nscoff; cf[bj][n] = *(const f32x4*)(ngain + col0 + bj * HALF + 4 * n) * (*(const f32x4*)(nsc + col0 + bj * HALF + 4 * n) + 1.f); } }
        float ss[2][4];
#pragma unroll
        for (int ai = 0; ai < 2; ++ai)
#pragma unroll
            for (int m = 0; m < 4; ++m) ss[ai][m] = 0.f;
#pragma unroll
        for (int ai = 0; ai < 2; ++ai)
#pragma unroll
            for (int m = 0; m < 4; ++m) { const size_t off = (rbase + (size_t)(r0 + ai * HALF + m * 16)) * 1024 + col0;
#pragma unroll
                for (int bj = 0; bj < 2; ++bj) { f32x4 x0, x1;
                    if (f32src) { const float* sf = (const float*)s + off + bj * HALF; x0 = *(const f32x4*)sf; x1 = *(const f32x4*)(sf + 4); }
                    else { const u32x4 xv = *(const u32x4*)((const bf16_t*)s + off + bj * HALF);
                        x0 = (f32x4){__builtin_bit_cast(float, xv.x << 16), __builtin_bit_cast(float, xv.x & 0xffff0000u), __builtin_bit_cast(float, xv.y << 16), __builtin_bit_cast(float, xv.y & 0xffff0000u)};
                        x1 = (f32x4){__builtin_bit_cast(float, xv.z << 16), __builtin_bit_cast(float, xv.z & 0xffff0000u), __builtin_bit_cast(float, xv.w << 16), __builtin_bit_cast(float, xv.w & 0xffff0000u)}; }
                    const f32x4 o0 = x0 + gv[bj][0] * acc[ai][bj][m][0], o1 = x1 + gv[bj][1] * acc[ai][bj][m][1];
                    u32x4 w; w.x = cvt_pk_bf16(o0[0], o0[1]); w.y = cvt_pk_bf16(o0[2], o0[3]); w.z = cvt_pk_bf16(o1[0], o1[1]); w.w = cvt_pk_bf16(o1[2], o1[3]);
                    *(u32x4*)(d + off + bj * HALF) = w;
                    if (dn) {
                        const f32x4 y0 = (f32x4){__builtin_bit_cast(float, w.x << 16), __builtin_bit_cast(float, w.x & 0xffff0000u), __builtin_bit_cast(float, w.y << 16), __builtin_bit_cast(float, w.y & 0xffff0000u)};
                        const f32x4 y1 = (f32x4){__builtin_bit_cast(float, w.z << 16), __builtin_bit_cast(float, w.z & 0xffff0000u), __builtin_bit_cast(float, w.w << 16), __builtin_bit_cast(float, w.w & 0xffff0000u)};
                        ss[ai][m] += ((y0[0] * y0[0] + y0[1] * y0[1]) + (y0[2] * y0[2] + y0[3] * y0[3])) + ((y1[0] * y1[0] + y1[1] * y1[1]) + (y1[2] * y1[2] + y1[3] * y1[3]));
                        const f32x4 h0 = y0 * cf[bj][0], h1 = y1 * cf[bj][1];
                        u32x4 hw; hw.x = cvt_pk_bf16(h0[0], h0[1]); hw.y = cvt_pk_bf16(h0[2], h0[3]); hw.z = cvt_pk_bf16(h1[0], h1[1]); hw.w = cvt_pk_bf16(h1[2], h1[3]);
                        *(u32x4*)((u.pm < 144 ? Hn : Hn2) + ((size_t)u.pm * BM + (size_t)(r0 + ai * HALF + m * 16)) * 1024 + col0 + bj * HALF) = hw; }
                } }
        if (dn) {
            PG8_LAS float* ST = (PG8_LAS float*)eb;
            const int ln = fr + 16 * fq;
#pragma unroll
            for (int ai = 0; ai < 2; ++ai)
#pragma unroll
                for (int m = 0; m < 4; ++m) { float v = ss[ai][m];
                    v += __builtin_bit_cast(float, __builtin_amdgcn_ds_bpermute((ln ^ 16) << 2, __builtin_bit_cast(int, v)));
                    v += __builtin_bit_cast(float, __builtin_amdgcn_ds_bpermute((ln ^ 32) << 2, __builtin_bit_cast(int, v)));
                    if (fq == 0) ST[(ai * HALF + r0 + m * 16) * 4 + wc] = v; }
            asm volatile("s_waitcnt lgkmcnt(0)" ::: "memory"); __builtin_amdgcn_s_barrier(); asm volatile("" ::: "memory");
            const int t = (wr * 4 + wc) * 64 + ln;
            if (t < 256) { const f32x4 p = *(const PG8_LAS f32x4*)(ST + t * 4); stat[((size_t)u.pm * BM + t) * 4 + u.pn] = (p.x + p.y) + (p.z + p.w); }
        }
    }
};

__device__ __forceinline__ float dpp_prev(float x) { return __int_as_float(__builtin_amdgcn_update_dpp(__float_as_int(x), __float_as_int(x), 0x121, 0xf, 0xf, false)); }
__device__ __forceinline__ float dpp_next(float x) { return __int_as_float(__builtin_amdgcn_update_dpp(__float_as_int(x), __float_as_int(x), 0x12F, 0xf, 0xf, false)); }
__device__ __forceinline__ f32x4 rot_prev(f32x4 v) { f32x4 r; r.x = dpp_prev(v.x); r.y = dpp_prev(v.y); r.z = dpp_prev(v.z); r.w = dpp_prev(v.w); return r; }
__device__ __forceinline__ f32x4 rot_next(f32x4 v) { f32x4 r; r.x = dpp_next(v.x); r.y = dpp_next(v.y); r.z = dpp_next(v.z); r.w = dpp_next(v.w); return r; }
struct EpiConvGate {
    static constexpr bool PERM = true, AFTER_DRAIN = false, PERMA = true;
    bf16_t* ACT; bf16_t* EDGE; const float* cw; const float* cb; PG8_LAS unsigned char* eb; PG8_LAS unsigned char* wl; const float* stat; const float* T; PG8_LAS unsigned char* nl;
    __device__ __forceinline__ f32x2 pre(const Unit& u, int tid, int slot) const { const int wv = __builtin_amdgcn_readfirstlane(tid >> 6), lane = tid & 63;
#pragma unroll
        for (int i = 0; i < 2; ++i) { const int idx = (2 * wv + i) * 64 + lane, k = idx >> 8, j = idx & 255, bj = j >> 7, jj = j & 127;
            const float* p = (k < 3 ? cw + k * 5632 : cb) + bj * 2816 + u.pn * 128 + jj;
            __builtin_amdgcn_global_load_lds((const unsigned*)p, (PG8_LAS unsigned*)(wl + slot * 4096 + (2 * wv + i) * 256), 4, 0, 0); }
        norm_pre(stat, T, 5632, u.pm, u.pn, nl, tid, slot);
        return (f32x2){__int_as_float(slot), 0.f}; }
    __device__ __forceinline__ void operator()(const f32x4 (&acc)[2][2][4][2], const Unit& u, int wr, int wc, int fr_, int fq_, f32x2 wpre) const {
        int fr = fr_, fq = fq_; asm volatile("" : "+v"(fr), "+v"(fq));
        const int slot = __builtin_amdgcn_readfirstlane(__float_as_int(wpre.x));
        PG8_LAS float* E = (PG8_LAS float*)eb; PG8_LAS float* WL = (PG8_LAS float*)(wl + slot * 4096); const PG8_LAS float* NL = (const PG8_LAS float*)(nl + slot * NSLOT_BYTES);
#define EB_IDX(wc_, wr_, ai_, wh_) (((((wc_) * 2 + (wr_)) * 2 + (ai_)) * 2 + (wh_)) * 64 + fq * 16)
        if (fr == 0) {
#pragma unroll
            for (int ai = 0; ai < 2; ++ai) { const float r = norm_rstd(NL, ai * HALF + wr * 64);
#pragma unroll
                for (int bj = 0; bj < 2; ++bj)
#pragma unroll
                    for (int n = 0; n < 2; ++n) *(PG8_LAS f32x4*)(E + EB_IDX(wc, wr, ai, 0) + bj * 8 + n * 4) = acc[ai][bj][0][n] * r; }
        }
        if (fr == 15) {
#pragma unroll
            for (int ai = 0; ai < 2; ++ai) { const float r = norm_rstd(NL, ai * HALF + wr * 64 + 63);
#pragma unroll
                for (int bj = 0; bj < 2; ++bj)
#pragma unroll
                    for (int n = 0; n < 2; ++n) *(PG8_LAS f32x4*)(E + EB_IDX(wc, wr, ai, 1) + bj * 8 + n * 4) = acc[ai][bj][3][n] * r; }
        }
        asm volatile("s_waitcnt lgkmcnt(0)" ::: "memory"); __builtin_amdgcn_s_barrier(); asm volatile("" ::: "memory");
        const f32x4 zero4 = (f32x4){0.f, 0.f, 0.f, 0.f};
        const int c8 = u.pn * 128 + wc * 32 + 8 * fq;
#pragma unroll
        for (int ai = 0; ai < 2; ++ai) {
            float rs[4];
#pragma unroll
            for (int m = 0; m < 4; ++m) rs[m] = norm_rstd(NL, ai * HALF + wr * 64 + 4 * fr + m);
            u32x2 actp[2][4];
#pragma unroll
            for (int n = 0; n < 2; ++n) {
                const int jc = wc * 32 + 8 * fq + 4 * n;
                f32x4 gt[4];
#pragma unroll
                for (int bj = 0; bj < 2; ++bj) {
                    f32x4 w[3];
#pragma unroll
                    for (int k = 0; k < 3; ++k) w[k] = *(const PG8_LAS f32x4*)(WL + k * 256 + bj * 128 + jc);
                    const f32x4 tq = *(const PG8_LAS f32x4*)(NL + 1024 + bj * 128 + jc);
                    const f32x4 bb = *(const PG8_LAS f32x4*)(WL + 3 * 256 + bj * 128 + jc) + tq * ((w[0] + w[1]) + w[2]);
                    f32x4 ep = zero4 - tq, en = zero4 - tq;
                    if (wr == 1) ep = *(const PG8_LAS f32x4*)(E + EB_IDX(wc, 0, ai, 1) + bj * 8 + n * 4);
                    else if (ai == 1) ep = *(const PG8_LAS f32x4*)(E + EB_IDX(wc, 1, 0, 1) + bj * 8 + n * 4);
                    if (wr == 0) en = *(const PG8_LAS f32x4*)(E + EB_IDX(wc, 1, ai, 0) + bj * 8 + n * 4);
                    else if (ai == 0) en = *(const PG8_LAS f32x4*)(E + EB_IDX(wc, 0, 1, 0) + bj * 8 + n * 4);
                    f32x4 a4[4];
#pragma unroll
                    for (int m = 0; m < 4; ++m) a4[m] = acc[ai][bj][m][n] * rs[m];
                    f32x4 pv0 = rot_prev(a4[3]), nv3 = rot_next(a4[0]);
                    pv0 = fr == 0 ? ep : pv0; nv3 = fr == 15 ? en : nv3;
#pragma unroll
                    for (int m = 0; m < 4; ++m) {
                        const f32x4 pv = m == 0 ? pv0 : a4[m == 0 ? 0 : m - 1];
                        const f32x4 nv = m == 3 ? nv3 : a4[m == 3 ? 3 : m + 1];
                        const f32x4 uv = bb + w[0] * pv + w[1] * a4[m] + w[2] * nv;
                        if (bj == 0) {
#pragma unroll
                            for (int e = 0; e < 4; ++e) gt[m][e] = uv[e] * __builtin_amdgcn_rcpf(1.f + __builtin_amdgcn_exp2f(uv[e] * -1.4426950408889634f));
                        } else { const f32x4 o = gt[m] * uv; actp[n][m].x = cvt_pk_bf16(o[0], o[1]); actp[n][m].y = cvt_pk_bf16(o[2], o[3]); }
                    }
                }
            }
#pragma unroll
            for (int m = 0; m < 4; ++m) { const u32x4 pk = (u32x4){actp[0][m].x, actp[0][m].y, actp[1][m].x, actp[1][m].y};
                *(u32x4*)(ACT + (size_t)(u.pm * BM + ai * HALF + wr * 64 + 4 * fr + m) * 2816 + c8) = pk; }
        }
        if ((wr == 0 && fr == 0) || (wr == 1 && fr == 15)) {
#pragma unroll
            for (int k = 0; k < 2; ++k) {
                const int rl = wr == 0 ? k : 254 + k; const float r = norm_rstd(NL, rl);
#pragma unroll
                for (int bj = 0; bj < 2; ++bj) { const int jc = bj * 128 + wc * 32 + 8 * fq;
                    const f32x4 q0 = wr == 0 ? acc[0][bj][k][0] : acc[1][bj][2 + k][0], q1 = wr == 0 ? acc[0][bj][k][1] : acc[1][bj][2 + k][1];
                    const f32x4 v0 = q0 * r + *(const PG8_LAS f32x4*)(NL + 1024 + jc), v1 = q1 * r + *(const PG8_LAS f32x4*)(NL + 1024 + jc + 4);
                    u32x4 pk; pk.x = cvt_pk_bf16(v0[0], v0[1]); pk.y = cvt_pk_bf16(v0[2], v0[3]); pk.z = cvt_pk_bf16(v1[0], v1[1]); pk.w = cvt_pk_bf16(v1[2], v1[3]);
                    *(u32x4*)(EDGE + ((size_t)u.pm * 4 + (wr == 0 ? k : 2 + k)) * 5632 + bj * 2816 + c8) = pk; }
            }
        }
#undef EB_IDX
    }
};

template <class Epi, class Sched, bool ALIGN_EPI = false>
__device__ __forceinline__ void gemm_phase(PG8_LAS unsigned char* lds, const Gemm g, const Sched& S, const Epi& E, int wave_id) {
    int tid_ = wave_id * 64 + lane_id(); asm volatile("" : "+v"(tid_)); const int tid = tid_, wid = __builtin_amdgcn_readfirstlane(tid >> 6), lane = tid & 63, wr = wid >> 2, wc = wid & 3, fr = lane & 15, fq = lane >> 4;
    const int K = g.K, nt = K / BK;
    unsigned voffA[2], voffB[2];
#pragma unroll
    for (int i = 0; i < 2; ++i) { int R, C; stage_rc(tid * 16 + i * 8192, R, C); const int Rb = Epi::PERM ? ((R & ~31) + perm32(R & 31)) : R;
        const int Ra = Epi::PERMA ? ((R & ~63) + 4 * (R & 15) + ((R >> 4) & 3)) : R;
        voffA[i] = (unsigned)(Ra * K + C) * 2u; voffB[i] = (unsigned)(Rb * K + C) * 2u; }
    const size_t kstep = (size_t)(BK * 2);
    const size_t hstep = (size_t)HALF * K * 2;
    const size_t tstep = 2 * hstep;
    const unsigned ldsw = (unsigned)wid * 1024u;
    const int aoff = lds_byte(wr * 64 + fr, fq * 8), boff = lds_byte(wc * 32 + fr, fq * 8);
#define PG8_SA(b, h) (((b) * 2 + (h)) * HTB)
#define PG8_SB(b, h) ((4 + (b) * 2 + (h)) * HTB)
#define PG8_STAGE(bufoff, gbase, voff) do { _Pragma("unroll") for (int _i = 0; _i < 2; ++_i) \
        __builtin_amdgcn_global_load_lds((const unsigned*)((const char*)(gbase) + (voff)[_i]), (PG8_LAS unsigned*)(lds + (bufoff) + ldsw + _i * 8192), 16, 0, 0); } while (0)
#define PG8_LDA(dst, b, h) do { _Pragma("unroll") for (int m = 0; m < 4; ++m) _Pragma("unroll") for (int k = 0; k < 2; ++k) dst[m][k] = *(const PG8_LAS bf16x8*)(lds + PG8_SA(b, h) + aoff + m * 2048 + k * 1024); } while (0)
#define PG8_LDB(dst, b, h) do { _Pragma("unroll") for (int n = 0; n < 2; ++n) _Pragma("unroll") for (int k = 0; k < 2; ++k) dst[n][k] = *(const PG8_LAS bf16x8*)(lds + PG8_SB(b, h) + boff + n * 2048 + k * 1024); } while (0)
#define PG8_MMA(ai, bj, At, Bt) do { __builtin_amdgcn_s_setprio(1); _Pragma("unroll") for (int m = 0; m < 4; ++m) _Pragma("unroll") for (int n = 0; n < 2; ++n) _Pragma("unroll") for (int k = 0; k < 2; ++k) \
        acc[ai][bj][m][n] = __builtin_amdgcn_mfma_f32_16x16x32_bf16(Bt[n][k], At[m][k], acc[ai][bj][m][n], 0, 0, 0); __builtin_amdgcn_s_setprio(0); } while (0)
#define PG8_WAIT_V(n) asm volatile("s_waitcnt vmcnt(" #n ")" ::: "memory")
#define PG8_WAIT_L(n) asm volatile("s_waitcnt lgkmcnt(" #n ")" ::: "memory")
#define PG8_BAR __builtin_amdgcn_s_barrier()
#define PG8_SCHED __builtin_amdgcn_sched_barrier(0)
    Unit cur, nxt; int ui = 0;
    if (!S.next(0, cur)) return;
    f32x4 acc[2][2][4][2];
#pragma unroll
    for (int a = 0; a < 2; ++a)
#pragma unroll
        for (int b = 0; b < 2; ++b)
#pragma unroll
            for (int m = 0; m < 4; ++m)
#pragma unroll
                for (int n = 0; n < 2; ++n) acc[a][b][m][n] = (f32x4){0.f, 0.f, 0.f, 0.f};
    bf16x8 At[4][2], B0[2][2], B1[2][2];
    const char* cA = (const char*)g.A + (size_t)cur.pm * tstep; const char* cB = (const char*)g.Bt + (size_t)cur.pn * tstep;
    S.a_ready(cur);
    (void)E.pre(cur, tid, 0);
    {
        PG8_STAGE(PG8_SB(0, 0), cB, voffB); PG8_STAGE(PG8_SB(0, 1), cB + hstep, voffB); PG8_STAGE(PG8_SA(0, 0), cA, voffA); PG8_STAGE(PG8_SA(0, 1), cA + hstep, voffA);
        if (wr == 1) PG8_BAR;
        PG8_WAIT_V(2); PG8_BAR;
        PG8_STAGE(PG8_SB(1, 0), cB + kstep, voffB); PG8_STAGE(PG8_SA(1, 0), cA + kstep, voffA); PG8_STAGE(PG8_SB(1, 1), cB + hstep + kstep, voffB);
        PG8_WAIT_V(6); PG8_BAR;
    }
    for (;;) {
        const bool has_next = S.next(ui + 1, nxt);
        const char* nA = has_next ? (const char*)g.A + (size_t)nxt.pm * tstep : cA; const char* nB = has_next ? (const char*)g.Bt + (size_t)nxt.pn * tstep : cB;
        for (int t = 0; t < nt; t += 2) {
            const bool last = (t == nt - 2);
            const char* a1 = cA + (size_t)(t + 1) * kstep;
            const char* a2 = last ? nA : cA + (size_t)(t + 2) * kstep; const char* b2 = last ? nB : cB + (size_t)(t + 2) * kstep;
            const char* a3 = a2 + kstep; const char* b3 = b2 + kstep;
            if (last && has_next) S.a_ready(nxt);
            PG8_LDB(B0, 0, 0); PG8_LDB(B1, 0, 1); PG8_SCHED; PG8_LDA(At, 0, 0); PG8_STAGE(PG8_SA(1, 1), a1 + hstep, voffA);
            PG8_WAIT_V(8); PG8_WAIT_L(0); PG8_BAR; PG8_MMA(0, 0, At, B0); PG8_MMA(0, 1, At, B1); PG8_BAR; PG8_SCHED;
            PG8_LDA(At, 0, 1); PG8_STAGE(PG8_SB(0, 0), b2, voffB); PG8_STAGE(PG8_SB(0, 1), b2 + hstep, voffB); PG8_STAGE(PG8_SA(0, 0), a2, voffA);
            PG8_WAIT_V(8); PG8_WAIT_L(0); PG8_BAR; PG8_MMA(1, 0, At, B0); PG8_MMA(1, 1, At, B1); PG8_BAR; PG8_SCHED;
            PG8_LDB(B0, 1, 0); PG8_LDB(B1, 1, 1); PG8_SCHED; PG8_LDA(At, 1, 0); PG8_STAGE(PG8_SA(0, 1), a2 + hstep, voffA);
            PG8_WAIT_V(8); PG8_WAIT_L(0); PG8_BAR; PG8_MMA(0, 0, At, B0); PG8_MMA(0, 1, At, B1); PG8_BAR; PG8_SCHED;
            PG8_LDA(At, 1, 1); PG8_STAGE(PG8_SB(1, 0), b3, voffB); PG8_STAGE(PG8_SB(1, 1), b3 + hstep, voffB); PG8_STAGE(PG8_SA(1, 0), a3, voffA);
            PG8_WAIT_V(8); PG8_WAIT_L(0); PG8_BAR; PG8_MMA(1, 0, At, B0); PG8_MMA(1, 1, At, B1); PG8_BAR; PG8_SCHED;
        }
        if constexpr (ALIGN_EPI) { if (wr == 0) PG8_BAR; }
        { const int l2 = lane_id(); E(acc, cur, wr, wc, l2 & 15, l2 >> 4, (f32x2){__int_as_float(ui & 1), 0.f}); } S.done(cur);
        if (!has_next) break;
        (void)E.pre(nxt, wave_id * 64 + lane_id(), (ui + 1) & 1);
#pragma unroll
        for (int a = 0; a < 2; ++a)
#pragma unroll
            for (int b = 0; b < 2; ++b)
#pragma unroll
                for (int m = 0; m < 4; ++m)
#pragma unroll
                    for (int n = 0; n < 2; ++n) acc[a][b][m][n] = (f32x4){0.f, 0.f, 0.f, 0.f};
        cur = nxt; cA = nA; cB = nB; ++ui;
        if constexpr (ALIGN_EPI) { if (wr == 1) PG8_BAR; }
    }
    PG8_WAIT_V(0);
    if constexpr (!ALIGN_EPI) { if (wr == 0) PG8_BAR; }
    PG8_BAR;
#undef PG8_SA
#undef PG8_SB
#undef PG8_STAGE
#undef PG8_LDA
#undef PG8_LDB
#undef PG8_MMA
#undef PG8_WAIT_V
#undef PG8_WAIT_L
#undef PG8_BAR
#undef PG8_SCHED
}
}

constexpr int D = 1024, NBATCH = 32, SEQ = 2048, CTXL = 256, PT = 2304, NB = 16, NG = 2, TG = NB * PT;
constexpr int FFN = 2816, FFN2 = 5632, LW = 1280, NMOD = 6144;
constexpr float EPS = 1e-6f;
constexpr int NWAVES = 8, NTHR = 512;

constexpr size_t MiB = 1u << 20;
constexpr size_t WS_CTL = 0, CTL_ZERO_BYTES = 1 * MiB;
constexpr size_t WS_MOD = 1 * MiB;
constexpr size_t WS_ROPE = 5 * MiB;
constexpr size_t WS_CTX = 8 * MiB;
constexpr size_t WS_T = 24 * MiB;
constexpr size_t WS_STAT = 30 * MiB;
constexpr int TB_FFN = 0, TB_FFN_SZ = 33 * 5632, TB_LRU = 4 * TB_FFN_SZ, TB_NAQK = TB_LRU + 33 * 2560, TB_NAV = TB_NAQK + 33 * 2048, TB_RETA = TB_NAV + 33 * 1024, TB_RETB = TB_RETA + 33 * 4096;
constexpr size_t WS_W = 40 * MiB;
constexpr size_t WS_ACT = 160 * MiB;
constexpr size_t WS_END = 1024 * MiB;
constexpr size_t W_RET = 0;
constexpr size_t W_FFN = 36 * MiB;
constexpr size_t W_LRU_IN = 102 * MiB, W_LRU_OUT = 107 * MiB, W_LRU_G = 109 * MiB + 512 * 1024;
constexpr size_t W_NA_QK = 112 * MiB, W_NA_V = 116 * MiB, W_NA_O = 118 * MiB;
constexpr size_t A_H = 0;
constexpr size_t A_QKG = 72 * MiB, A_KVT = 360 * MiB, A_Y = 576 * MiB;
constexpr size_t A_ACT = 144 * MiB, A_EDGE = 540 * MiB;
constexpr size_t A_YX = 144 * MiB, A_LA = 324 * MiB, A_U = 504 * MiB, A_A3 = 684 * MiB;
constexpr size_t A_QK = 144 * MiB, A_VT = 288 * MiB, A_O = 360 * MiB;
constexpr int CW_BAR = 4096, CW_DBG = 8192;

constexpr int RING_BYTES = 139264;
constexpr int MISC_OFF = RING_BYTES;
constexpr int NSLOT_OFF = MISC_OFF + 512 + 8192;
constexpr int LDS_BYTES = NSLOT_OFF + 2 * 5120;

#define RLX_AGENT __ATOMIC_RELAXED, __HIP_MEMORY_SCOPE_AGENT
__device__ __forceinline__ unsigned f2bf(float f) { unsigned u = __builtin_bit_cast(unsigned, f); return (u + 0x7fffu + ((u >> 16) & 1u)) >> 16; }
__device__ __forceinline__ unsigned pk2(float lo, float hi) { unsigned r; asm("v_cvt_pk_bf16_f32 %0, %1, %2" : "=v"(r) : "v"(lo), "v"(hi)); return r; }
__device__ __forceinline__ float bf2f(unsigned short h) { return __builtin_bit_cast(float, (unsigned)h << 16); }
__device__ __forceinline__ float bflo(unsigned w) { return __builtin_bit_cast(float, w << 16); }
__device__ __forceinline__ float bfhi(unsigned w) { return __builtin_bit_cast(float, w & 0xffff0000u); }
__device__ __forceinline__ float silu_f(float x) { return x * __builtin_amdgcn_rcpf(1.f + __expf(-x)); }
__device__ __forceinline__ float sigmoid_f(float x) { return __builtin_amdgcn_rcpf(1.f + __expf(-x)); }
__device__ __forceinline__ float lane_get(float v, int src) { return __builtin_bit_cast(float, __builtin_amdgcn_ds_bpermute(src << 2, __builtin_bit_cast(int, v))); }
__device__ __forceinline__ float wave_sum(float v, int lane) {
#pragma unroll
    for (int o = 1; o < 64; o <<= 1) v += lane_get(v, lane ^ o);
    return v;
}

#define XB_TMO      128
#define XB_XCNT(j)  (256  + 64 * (j))
#define XB_XSUB(j)  (1280 + 64 * (j))
#define XB_XGEN(j)  (2304 + 64 * (j))
#define XB_TOP      3328
#define XB_TOPGEN   3392
#define XCD_BAR_WORDS 3456
#define XB_SPIN_CAP (1u << 18)
__device__ __forceinline__ unsigned xb_ld(unsigned* p)              { return __hip_atomic_load(p, __ATOMIC_RELAXED, __HIP_MEMORY_SCOPE_AGENT); }
__device__ __forceinline__ unsigned xb_add(unsigned* p, unsigned v) { return __hip_atomic_fetch_add(p, v, __ATOMIC_RELAXED, __HIP_MEMORY_SCOPE_AGENT); }
__device__ __forceinline__ unsigned xb_xcc_id() { return (unsigned)__builtin_amdgcn_s_getreg((3 << 11) | 20) & 0xFu; }
#define XB_SPIN(cond, bar) do { unsigned _sp = 0; while (cond) { __builtin_amdgcn_s_sleep(1); \
    if ((++_sp & 255u) == 0u) { if (xb_ld(&(bar)[XB_TMO])) break; if (_sp > XB_SPIN_CAP) { atomicAdd(&(bar)[XB_TMO], 1u); break; } } } } while (0)
struct XcdBarrier { unsigned* bar; unsigned x; volatile LAS unsigned* st; bool t0; };
__device__ __forceinline__ XcdBarrier xcd_barrier_post(unsigned* bar, volatile LAS unsigned* st) {
    XcdBarrier b; b.bar = bar; b.x = xb_xcc_id(); b.st = st; b.t0 = threadIdx.x == 0;
    if (threadIdx.x == 0) (void)xb_add(&bar[XB_XCNT(b.x)], 1u);
    return b;
}
__device__ __forceinline__ void xcd_barrier_complete(unsigned* bar, unsigned x, unsigned& nloc, unsigned& nx) {
    const unsigned G = gridDim.x * gridDim.y * gridDim.z;
    unsigned sum, cnt, mine, sp = 0u;
    for (;;) {
        sum = 0u; cnt = 0u; mine = 0u;
#pragma unroll
        for (unsigned j = 0; j < 16; ++j) { const unsigned c = xb_ld(&bar[XB_XCNT(j)]); sum += c; cnt += (c > 0u) ? 1u : 0u; mine = (j == x) ? c : mine; }
        if (sum == G) break;
        __builtin_amdgcn_s_sleep(1);
        if ((++sp & 255u) == 0u) { if (xb_ld(&bar[XB_TMO])) break; if (sp > XB_SPIN_CAP) { atomicAdd(&bar[XB_TMO], 1u); break; } }
    }
    nloc = mine > 0u ? mine : 1u; nx = cnt > 0u ? cnt : 1u;
}
__device__ __forceinline__ void xcd_barrier(const XcdBarrier& b) {
    asm volatile("s_waitcnt vmcnt(0)" ::: "memory");
    __syncthreads();
    if (b.t0) {
        unsigned* bar = b.bar;
        __builtin_amdgcn_s_waitcnt(0);
        unsigned nloc = b.st[0], nx = b.st[1];
        if (nloc == 0u) { xcd_barrier_complete(bar, b.x, nloc, nx); b.st[0] = nloc; b.st[1] = nx; }
        const unsigned old = xb_add(&bar[XB_XSUB(b.x)], 1u);
        const unsigned gen = old / nloc;
        if (old + 1u == (gen + 1u) * nloc) {
            __builtin_amdgcn_fence(__ATOMIC_RELEASE, "agent");
            asm volatile("s_waitcnt vmcnt(0)" ::: "memory");
            const unsigned og = xb_add(&bar[XB_TOP], 1u);
            const unsigned tg = og / nx;
            if (og + 1u == (tg + 1u) * nx) xb_add(&bar[XB_TOPGEN], 1u);
            else XB_SPIN(xb_ld(&bar[XB_TOPGEN]) == tg, bar);
            __builtin_amdgcn_fence(__ATOMIC_ACQUIRE, "agent");
            xb_add(&bar[XB_XGEN(b.x)], 1u);
            asm volatile("s_waitcnt vmcnt(0)" ::: "memory");
        } else {
            XB_SPIN(xb_ld(&bar[XB_XGEN(b.x)]) == gen, bar);
            __builtin_amdgcn_fence(__ATOMIC_ACQUIRE, "agent");
            asm volatile("s_waitcnt vmcnt(0)" ::: "memory");
        }
    }
    __syncthreads();
}

struct Args { const float* in[27]; float* out; unsigned char* ws; };
enum { I_X = 0, I_C, I_CTX, I_CCTX, I_ADAW, I_ADAB, I_NMIX, I_NFFN, I_UP, I_FCW, I_FCB, I_DOWN, I_RWIN, I_RDEC, I_RGN, I_RWOUT,
       I_LWIN, I_LCW, I_LCB, I_LGW, I_LGB, I_LLAM, I_LWOUT, I_NQKV, I_NRPB, I_NWOUT, I_FNORM };

typedef const __attribute__((address_space(4))) Args* CArgsP;
__device__ __forceinline__ CArgsP fresh_args() { CArgsP p = (CArgsP)__builtin_amdgcn_kernarg_segment_ptr(); asm volatile("" : "+s"(p)); return p; }
#define AIN(i) (fresh_args()->in[(i)])
#define AOUT (fresh_args()->out)
#define AWS (fresh_args()->ws)
struct Frame {
    LAS unsigned char* lds;
    int tid, lane, wave, vcu, G, gw, NGW;
    unsigned char* ws;
};

__device__ __forceinline__ Frame refresh(const Frame& F0) {
    Frame F = F0; int t = F0.wave * 64 + lane_id(); asm volatile("" : "+v"(t));
    F.tid = t; F.lane = t & 63; F.gw = F.vcu * NWAVES + F.wave;
    return F;
}
__device__ __forceinline__ void transpose_item(const float* W, int K, int ldn, int c0, int ncols, bf16* WT, int row_off, float scale, LAS float* scr, int item, int lane) {
    const int nblk = ncols / 32, kb = item / nblk, nb = item % nblk, k0 = 64 * kb, n0 = 32 * nb;
    if (row_off <= -1000000) { const int dim = n0 & 255; row_off = (-1000000 - row_off) + (n0 & ~255) + 128 * ((dim & 127) >> 6) + 64 * (dim >> 7) + (dim & 63) - n0; }
    else if (row_off < 0) { const int cc = c0 + n0; row_off = (cc < 2816 ? 256 * (cc / 128) + (cc % 128) : 256 * ((cc - 2816) / 128) + 128 + ((cc - 2816) % 128)) - n0; }
    {
        f32x4 v[8];
#pragma unroll
        for (int i = 0; i < 8; ++i) v[i] = *(const f32x4*)(W + (size_t)(k0 + 8 * i + (lane >> 3)) * ldn + c0 + n0 + 4 * (lane & 7));
#pragma unroll
        for (int i = 0; i < 8; ++i) { LAS float* d = scr + (8 * i + (lane >> 3)) * 33 + 4 * (lane & 7); d[0] = v[i].x * scale; d[1] = v[i].y * scale; d[2] = v[i].z * scale; d[3] = v[i].w * scale; }
    }
    asm volatile("s_waitcnt lgkmcnt(0)" ::: "memory");
    const int c = lane & 7;
#pragma unroll
    for (int j = 0; j < 4; ++j) { const int n = (lane >> 3) + 8 * j; const LAS float* s = scr + (8 * c) * 33 + n;
        u32x4 o; o.x = pk2(s[0 * 33], s[1 * 33]); o.y = pk2(s[2 * 33], s[3 * 33]); o.z = pk2(s[4 * 33], s[5 * 33]); o.w = pk2(s[6 * 33], s[7 * 33]);
        *(u32x4*)(WT + (size_t)(row_off + n0 + n) * K + k0 + 8 * c) = o; }
    asm volatile("s_waitcnt lgkmcnt(0)" ::: "memory");
}

__device__ __forceinline__ void prologue(const Frame& F0) {
    const Frame F = refresh(F0);
    bf16* Wb = (bf16*)(F.ws + WS_W);
    if (F.vcu < 192) {
        const int l = F.vcu / 48, n0 = (F.vcu % 48) * 128;
        LAS float* s = (LAS float*)F.lds;
        for (int idx = F.tid; idx < 33 * 1024; idx += NTHR) { const int bb = idx >> 10, k = idx & 1023; const float v = bb < 32 ? AIN(I_C)[bb * 1024 + k] : AIN(I_CCTX)[k]; s[idx] = silu_f(v); }
        __syncthreads();
        const int cc = F.tid & 127, kq = F.tid >> 7;
        float acc[33];
#pragma unroll
        for (int bb = 0; bb < 33; ++bb) acc[bb] = 0.f;
        const float* wp = AIN(I_ADAW) + ((size_t)l * 1024 + kq * 256) * NMOD + n0 + cc;
        for (int k = 0; k < 256; k += 4) {
            const float w0 = wp[(size_t)(k + 0) * NMOD], w1 = wp[(size_t)(k + 1) * NMOD], w2 = wp[(size_t)(k + 2) * NMOD], w3 = wp[(size_t)(k + 3) * NMOD];
#pragma unroll
            for (int bb = 0; bb < 33; ++bb) { const f32x4 sv = *(const LAS f32x4*)(s + bb * 1024 + kq * 256 + k); acc[bb] += (sv.x * w0 + sv.y * w1) + (sv.z * w2 + sv.w * w3); }
        }
        __syncthreads();
        LAS float* red = (LAS float*)F.lds;
#pragma unroll
        for (int bb = 0; bb < 33; ++bb) red[(kq * 33 + bb) * 128 + cc] = acc[bb];
        __syncthreads();
        float* MOD = (float*)(F.ws + WS_MOD);
        for (int idx = F.tid; idx < 33 * 128; idx += NTHR) { const int bb = idx >> 7, c2 = idx & 127;
            const float v = (red[(0 * 33 + bb) * 128 + c2] + red[(1 * 33 + bb) * 128 + c2]) + (red[(2 * 33 + bb) * 128 + c2] + red[(3 * 33 + bb) * 128 + c2]);
            MOD[((size_t)l * 33 + bb) * NMOD + n0 + c2] = v + AIN(I_ADAB)[l * NMOD + n0 + c2]; }
        __syncthreads();
    }
    if (F.vcu == 192 + 8) {
        float* RT = (float*)(F.ws + WS_ROPE);
        for (int idx = F.tid; idx < 64 * 64; idx += NTHR) { const int pos = idx >> 6, m = idx & 63; const float fr = powf(10000.0f, -(float)(2 * m) / 128.0f); const float ang = (float)pos * fr;
            RT[2 * idx] = cosf(ang); RT[2 * idx + 1] = sinf(ang); }
    }
    {
        bf16* GW = (bf16*)(F.ws + WS_W + W_LRU_G); const float* gwsrc = AIN(I_LGW);
        for (int idx = F.vcu * NTHR + F.tid; idx < 8 * 640 * 160; idx += F.G * NTHR) { const int c = idx % 160, n = (idx / 160) % 640, blk = idx / (160 * 640); const int dg = n / 160, d = n % 160;
            GW[idx] = (bf16)f2bf(gwsrc[(((size_t)dg * 8 + blk) * 160 + c) * 160 + d]); }
    }
    {
        LAS float* scr = (LAS float*)(F.lds + F.wave * 16384);
        constexpr int TOTAL = 2 * (512 + 512 + 1024 + 512 + 1024 + 1024) + 4 * (2816 + 1408) + 1280 + 640 + 512 + 512 + 512 + 512;
        for (int it = F.gw; it < TOTAL; it += F.NGW) {
            int r = it;
#define JOB(Wp, K_, ldn_, c0_, nc_, dst_, ro_, sc_) { constexpr int items_ = ((K_) / 64) * ((nc_) / 32); if (r < items_) { transpose_item((Wp), (K_), (ldn_), (c0_), (nc_), (dst_), (ro_), (sc_), scr, r, F.lane); continue; } r -= items_; }
#define RETJOBS(j) { const float* win = AIN(I_RWIN) + (size_t)(j) * 1024 * 6144; bf16* Wa = Wb + (W_RET + (size_t)(j) * 18 * MiB) / 2; bf16* Wbb = Wa + (8 * MiB) / 2; bf16* Wo = Wa + (14 * MiB) / 2; \
            JOB(win, 1024, 6144, 0, 1024, Wa, -1000000, 1.f) JOB(win, 1024, 6144, 1024, 1024, Wa, -1000000 - 1024, 0.0625f) JOB(win, 1024, 6144, 4096, 2048, Wa, 2048, 1.f) \
            JOB(win, 1024, 6144, 1024, 1024, Wbb, -1000000, 0.0625f) JOB(win, 1024, 6144, 2048, 2048, Wbb, 1024, 1.f) \
            JOB(AIN(I_RWOUT) + (size_t)(j) * 2048 * 1024, 2048, 1024, 0, 1024, Wo, 0, 1.f) }
#define FFNJOBS(l) { bf16* Wup = Wb + (W_FFN + (size_t)(l) * (16 * MiB + 512 * 1024)) / 2; bf16* Wdn = Wup + (11 * MiB) / 2; \
            JOB(AIN(I_UP) + (size_t)(l) * 1024 * 5632, 1024, 5632, 0, 5632, Wup, -1, 1.f) JOB(AIN(I_DOWN) + (size_t)(l) * 2816 * 1024, 2816, 1024, 0, 1024, Wdn, 0, 1.f) }
            RETJOBS(0) RETJOBS(1) FFNJOBS(0) FFNJOBS(1) FFNJOBS(2) FFNJOBS(3)
            JOB(AIN(I_LWIN), 1024, 2560, 0, 2560, Wb + W_LRU_IN / 2, 0, 1.f) JOB(AIN(I_LWOUT), 1280, 1024, 0, 1024, Wb + W_LRU_OUT / 2, 0, 1.f)
            JOB(AIN(I_NQKV), 1024, 3072, 0, 1024, Wb + W_NA_QK / 2, 0, 0.125f) JOB(AIN(I_NQKV), 1024, 3072, 1024, 1024, Wb + W_NA_QK / 2, 1024, 1.f)
            JOB(AIN(I_NQKV), 1024, 3072, 2048, 1024, Wb + W_NA_V / 2, 0, 1.f) JOB(AIN(I_NWOUT), 1024, 1024, 0, 1024, Wb + W_NA_O / 2, 0, 1.f)
#undef JOB
#undef RETJOBS
#undef FFNJOBS
        }
    }
}

__device__ __forceinline__ void norm_phase(const Frame& F0, int b0, int nrows, const void* xs, const void* cs, int f32src, const float* gain, const float* modl, int shoff, int scoff) {
    const Frame F = refresh(F0);
    bf16* H = (bf16*)(F.ws + WS_ACT + A_H);
    for (int row = F.gw; row < nrows; row += F.NGW) {
        const int bl = row / PT, p = row % PT, b = b0 + bl;
        const size_t soff = p < CTXL ? ((size_t)b * CTXL + p) * D : ((size_t)b * SEQ + (p - CTXL)) * D; const void* sbase = p < CTXL ? cs : xs;
        const float* mod = modl + (size_t)(p < CTXL ? 32 : b) * NMOD;
        f32x4 v[4]; float ss = 0.f;
#pragma unroll
        for (int j = 0; j < 4; ++j) {
            if (f32src) v[j] = *(const f32x4*)((const float*)sbase + soff + 4 * F.lane + 256 * j);
            else { const u32x2 w = *(const u32x2*)((const bf16*)sbase + soff + 4 * F.lane + 256 * j); v[j] = (f32x4){bflo(w.x), bfhi(w.x), bflo(w.y), bfhi(w.y)}; }
            ss += (v[j].x * v[j].x + v[j].y * v[j].y) + (v[j].z * v[j].z + v[j].w * v[j].w); }
        const float rstd = 1.f / sqrtf(wave_sum(ss, F.lane) * (1.f / D) + EPS);
#pragma unroll
        for (int j = 0; j < 4; ++j) { const int c = 4 * F.lane + 256 * j;
            const f32x4 gn = *(const f32x4*)(gain + c), sh = *(const f32x4*)(mod + shoff + c), sc = *(const f32x4*)(mod + scoff + c);
            const f32x4 h = (v[j] * rstd) * gn; const f32x4 o = h * (sc + 1.f) + sh;
            u32x2 w; w.x = pk2(o.x, o.y); w.y = pk2(o.z, o.w);
            *(u32x2*)(H + (size_t)row * D + c) = w; }
    }
}

__device__ __forceinline__ void ffn_fix_phase(const Frame& F0, const float* cw, const float* cb) {
    const Frame F = refresh(F0);
    const bf16* EDGE = (const bf16*)(F.ws + WS_ACT + A_EDGE); bf16* ACT = (bf16*)(F.ws + WS_ACT + A_ACT);
    const int NOCT = FFN / 8;
    for (int it = F.vcu * NTHR + F.tid; it < NBATCH * 7 * 2 * NOCT; it += F.G * NTHR) {
        const int oc = it % NOCT, r2 = it / NOCT, side = r2 & 1, bd = (r2 >> 1) % 7, b = (r2 >> 1) / 7; const int c = oc * 8;
        const int pml = 9 * b + 1 + bd, pmh = pml + 1;
        const bf16* pp = side == 0 ? EDGE + ((size_t)pml * 4 + 2) * FFN2 : EDGE + ((size_t)pml * 4 + 3) * FFN2;
        const bf16* pc = side == 0 ? EDGE + ((size_t)pml * 4 + 3) * FFN2 : EDGE + ((size_t)pmh * 4 + 0) * FFN2;
        const bf16* pn = side == 0 ? EDGE + ((size_t)pmh * 4 + 0) * FFN2 : EDGE + ((size_t)pmh * 4 + 1) * FFN2;
        const size_t trow = side == 0 ? (size_t)pml * 256 + 255 : (size_t)pmh * 256;
        float ug[8], uv[8];
#pragma unroll
        for (int half = 0; half < 2; ++half) {
            const int col = half * FFN + c;
            const u32x4 prv = *(const u32x4*)(pp + col), cur = *(const u32x4*)(pc + col), nxt = *(const u32x4*)(pn + col);
            float* dst = half == 0 ? ug : uv;
#pragma unroll
            for (int q = 0; q < 4; ++q) {
                const f32x2 w0 = *(const f32x2*)(cw + 0 * FFN2 + col + 2 * q), w1 = *(const f32x2*)(cw + 1 * FFN2 + col + 2 * q), w2 = *(const f32x2*)(cw + 2 * FFN2 + col + 2 * q), bb = *(const f32x2*)(cb + col + 2 * q);
                dst[2 * q] = bb.x + w0.x * bflo(prv[q]) + w1.x * bflo(cur[q]) + w2.x * bflo(nxt[q]);
                dst[2 * q + 1] = bb.y + w0.y * bfhi(prv[q]) + w1.y * bfhi(cur[q]) + w2.y * bfhi(nxt[q]);
            }
        }
        float o[8];
#pragma unroll
        for (int e = 0; e < 8; ++e) o[e] = silu_f(ug[e]) * uv[e];
        u32x4 w; w.x = pk2(o[0], o[1]); w.y = pk2(o[2], o[3]); w.z = pk2(o[4], o[5]); w.w = pk2(o[6], o[7]);
        *(u32x4*)(ACT + trow * FFN + c) = w;
    }
}

__device__ __forceinline__ void rope_phase(const Frame& F0) {
    const Frame F = refresh(F0);
    bf16* QKG = (bf16*)(F.ws + WS_ACT + A_QKG); bf16* KVT = (bf16*)(F.ws + WS_ACT + A_KVT); const float* RT = (const float*)(F.ws + WS_ROPE);
    const size_t n1 = (size_t)NB * SEQ * 128;
    for (size_t it = (size_t)F.vcu * NTHR + F.tid; it < n1; it += (size_t)F.G * NTHR) {
        const int sub = (int)(it & 127); const size_t lr = it >> 7; const int bl = (int)(lr / SEQ), t = (int)(lr % SEQ);
        const int oct = sub & 7, hf = (sub >> 3) & 1, h = (sub >> 4) & 3, tens = sub >> 6;
        const int pos = hf == 0 ? (t >> 6) : (t & 63);
        bf16* p1 = QKG + ((size_t)bl * PT + CTXL + t) * 4096 + tens * 1024 + h * 256 + hf * 128 + oct * 8; bf16* p2 = p1 + 64;
        const u32x4 a = *(const u32x4*)p1, b = *(const u32x4*)p2; u32x4 oa, ob;
#pragma unroll
        for (int q = 0; q < 4; ++q) {
            const f32x4 cs = *(const f32x4*)(RT + 2 * (pos * 64 + oct * 8 + 2 * q));
            const float x1l = bflo(a[q]), x1h = bfhi(a[q]), x2l = bflo(b[q]), x2h = bfhi(b[q]);
            oa[q] = pk2(x1l * cs.x - x2l * cs.y, x1h * cs.z - x2h * cs.w);
            ob[q] = pk2(x1l * cs.y + x2l * cs.x, x1h * cs.w + x2h * cs.z);
        }
        *(u32x4*)p1 = oa; *(u32x4*)p2 = ob;
    }
    const size_t n2 = (size_t)4 * 2 * 64 * NB * (SEQ / 8);
    for (size_t it = (size_t)F.vcu * NTHR + F.tid; it < n2; it += (size_t)F.G * NTHR) {
        const int to = (int)(it % (SEQ / 8)); size_t r = it / (SEQ / 8); const int bl = (int)(r % NB); r /= NB; const int d = (int)(r & 63), hf = (int)((r >> 6) & 1), h = (int)(r >> 7);
        const int t0 = to * 8;
        bf16* p1 = KVT + (size_t)(h * 256 + hf * 128 + d) * TG + (size_t)bl * PT + CTXL + t0; bf16* p2 = p1 + (size_t)64 * TG;
        const u32x4 a = *(const u32x4*)p1, b = *(const u32x4*)p2; u32x4 oa, ob;
#pragma unroll
        for (int q = 0; q < 4; ++q) {
            const int pos0 = hf == 0 ? (t0 >> 6) : ((t0 & 63) + 2 * q), pos1 = hf == 0 ? pos0 : pos0 + 1;
            const f32x2 c0 = *(const f32x2*)(RT + 2 * (pos0 * 64 + d)), c1 = *(const f32x2*)(RT + 2 * (pos1 * 64 + d));
            const float x1l = bflo(a[q]), x1h = bfhi(a[q]), x2l = bflo(b[q]), x2h = bfhi(b[q]);
            oa[q] = pk2(x1l * c0.x - x2l * c0.y, x1h * c1.x - x2h * c1.y);
            ob[q] = pk2(x1l * c0.y + x2l * c0.x, x1h * c1.y + x2h * c1.x);
        }
        *(u32x4*)p1 = oa; *(u32x4*)p2 = ob;
    }
}

#define MFMA16(a, b, c) __builtin_amdgcn_mfma_f32_16x16x32_bf16((a), (b), (c), 0, 0, 0)
constexpr int QS_STRIDE = 528, PS_STRIDE = 272;
constexpr int LDS_RA = 0, LDS_RB = 65536;
__device__ __forceinline__ float ex2(float x) { return __builtin_amdgcn_exp2f(x); }
__device__ __forceinline__ int st_off(int r, int cb, int ncg) { return ((r >> 4) * ncg + (cb >> 6)) * 1024 + ((((r & 15) << 6) + (cb & 63)) ^ (((r >> 3) & 1) << 5)); }
template <int DIR>
__device__ __forceinline__ void ret_scan_pass(const Frame& F, const bf16* QKG, const bf16* KVT, bf16* Y, int bl, int h, int vs, float lgf, float lgb) {
    LAS unsigned char* RA = F.lds + LDS_RA; LAS unsigned char* RB = F.lds + LDS_RB;
    const int v0 = vs * 128 + F.wave * 16;
    const float lg2 = DIR == 0 ? lgf : lgb;
    const float gch = ex2(lg2 * 128.f);
    f32x4 S[16];
#pragma unroll
    for (int i = 0; i < 16; ++i) S[i] = (f32x4){0.f, 0.f, 0.f, 0.f};
    u32x4 qv[8], kv[8];
#define RET_PF_Q(cc) do { const size_t Rn = (size_t)bl * PT + (size_t)(cc) * 128; int tp = F.tid; asm volatile("" : "+v"(tp)); \
        _Pragma("unroll") for (int e = 0; e < 8; ++e) { const int q = tp + NTHR * e; qv[e] = *(const u32x4*)(QKG + (Rn + (q >> 5)) * 4096 + h * 256 + (q & 31) * 8); } } while (0)
#define RET_PF_K(cc) do { const size_t Rn = (size_t)bl * PT + (size_t)(cc) * 128; int tp = F.tid; asm volatile("" : "+v"(tp)); \
        _Pragma("unroll") for (int e = 0; e < 8; ++e) { const int q = tp + NTHR * e; \
            if (DIR == 0) kv[e] = *(const u32x4*)(QKG + (Rn + (q >> 5)) * 4096 + 1024 + h * 256 + (q & 31) * 8); \
            else kv[e] = *(const u32x4*)(KVT + (size_t)(h * 256 + (q >> 4)) * TG + Rn + (q & 15) * 8); } } while (0)
    RET_PF_Q(DIR == 0 ? 0 : 1); RET_PF_K(DIR == 0 ? 0 : 1);
    for (int step = 0; step < 18; ++step) {
        const int c = DIR == 0 ? step : (step < 2 ? 1 - step : 19 - step);
        const int cn = step == 17 ? c : (DIR == 0 ? step + 1 : (step + 1 < 2 ? 1 - (step + 1) : 19 - (step + 1)));
        const size_t R0 = (size_t)bl * PT + (size_t)c * 128;
        int tl = F.tid; asm volatile("" : "+v"(tl));
        const int l15 = tl & 15, g4 = (tl >> 4) & 3;
#pragma unroll
        for (int e = 0; e < 8; ++e) { const int q = tl + NTHR * e; const int m8 = q & 31, mm = m8 & 3;
            const int o0 = st_off(q >> 5, 64 * (m8 >> 2) + 32 * (mm & 1) + 8 * (mm >> 1), 8), o1 = st_off(q >> 5, 64 * (m8 >> 2) + 32 * (mm & 1) + 8 * (mm >> 1) + 16, 8);
            *(LAS u32x2*)(RA + o0) = (u32x2){qv[e].x, qv[e].y}; *(LAS u32x2*)(RA + o1) = (u32x2){qv[e].z, qv[e].w};
            if (DIR == 0) { *(LAS u32x2*)(RB + o0) = (u32x2){kv[e].x, kv[e].y}; *(LAS u32x2*)(RB + o1) = (u32x2){kv[e].z, kv[e].w}; }
            else *(LAS u32x4*)(RB + st_off(q >> 4, 16 * (q & 15), 4)) = kv[e]; }
        const int loff = ((l15 << 6) + 16 * g4) ^ (((l15 >> 3) & 1) << 5);
        bf16x8 vf[4];
#pragma unroll
        for (int ks = 0; ks < 4; ++ks) vf[ks] = *(const bf16x8*)(KVT + (size_t)(1024 + h * 512 + v0 + l15) * TG + R0 + 32 * ks + 8 * g4);
        __syncthreads();
        if (DIR == 1) RET_PF_Q(cn);
        f32x4 ya[8];
#pragma unroll
        for (int it = 0; it < 8; ++it) ya[it] = (f32x4){0.f, 0.f, 0.f, 0.f};
        if (DIR == 0) {
            f32x4 pt[8];
#pragma unroll
            for (int it = 0; it < 8; ++it) pt[it] = (f32x4){0.f, 0.f, 0.f, 0.f};
#pragma unroll
            for (int ks = 0; ks < 8; ++ks) {
                __builtin_amdgcn_sched_barrier(0);
                const bf16x8 af = *(const LAS bf16x8*)(RB + (F.wave * 8 + ks) * 1024 + loff);
#pragma unroll
                for (int ih = 0; ih < 2; ++ih) {
                    bf16x8 bq[4];
#pragma unroll
                    for (int it = 0; it < 4; ++it) bq[it] = *(const LAS bf16x8*)(RA + ((4 * ih + it) * 8 + ks) * 1024 + loff);
                    __builtin_amdgcn_sched_barrier(0);
#pragma unroll
                    for (int it = 0; it < 4; ++it) pt[4 * ih + it] = MFMA16(af, bq[it], pt[4 * ih + it]);
                    __builtin_amdgcn_sched_barrier(0);
                }
            }
            __syncthreads();
#pragma unroll
            for (int it = 0; it < 8; ++it) {
                const int i = 16 * it + l15; float pv[4];
                const float ixi = ex2(-lgf * (float)(i + 1));
#pragma unroll
                for (int r = 0; r < 4; ++r) { const int j = 16 * F.wave + 4 * g4 + r; const int dd = i - j;
                    const float f = dd > 0 ? ex2(-lgf * (float)(j + 1)) : (dd < 0 ? ex2(lgb * (float)(-dd)) * ixi : 2.f * ixi); pv[r] = pt[it][r] * f; }
                u32x2 w; w.x = pk2(pv[0], pv[1]); w.y = pk2(pv[2], pv[3]);
                *(LAS u32x2*)(RB + st_off(i, 32 * F.wave + 8 * g4, 4)) = w;
            }
            __syncthreads();
#pragma unroll
            for (int ks = 0; ks < 4; ++ks) {
                __builtin_amdgcn_sched_barrier(0);
                bf16x8 ap[8];
#pragma unroll
                for (int it = 0; it < 8; ++it) ap[it] = *(const LAS bf16x8*)(RB + (it * 4 + ks) * 1024 + loff);
                __builtin_amdgcn_sched_barrier(0);
#pragma unroll
                for (int it = 0; it < 8; ++it) ya[it] = MFMA16(ap[it], vf[ks], ya[it]);
            }
        }
        u32x4 kt2[8];
        if (DIR == 0) {
#pragma unroll
            for (int e = 0; e < 8; ++e) { const int q = tl + NTHR * e; kt2[e] = *(const u32x4*)(KVT + (size_t)(h * 256 + (q >> 4)) * TG + R0 + (q & 15) * 8); }
        }
        bf16x8 vfs[4];
        {
            float z[8]; const float z32 = ex2(lg2 * (DIR == 0 ? -32.f : 32.f));
#pragma unroll
            for (int e = 0; e < 8; ++e) z[e] = ex2(lg2 * (float)(DIR == 0 ? 127 - (8 * g4 + e) : 8 * g4 + e));
#pragma unroll
            for (int ks = 0; ks < 4; ++ks) {
                const u32x4 vv = __builtin_bit_cast(u32x4, vf[ks]); u32x4 o;
#pragma unroll
                for (int w = 0; w < 4; ++w) o[w] = pk2(bflo(vv[w]) * z[2 * w], bfhi(vv[w]) * z[2 * w + 1]);
                vfs[ks] = __builtin_bit_cast(bf16x8, o);
#pragma unroll
                for (int e = 0; e < 8; ++e) z[e] *= z32;
            }
        }
#pragma unroll
        for (int s = 0; s < 8; ++s) {
            __builtin_amdgcn_sched_barrier(0);
            u32x4 sb; sb.x = pk2(S[2 * s][0], S[2 * s][1]); sb.y = pk2(S[2 * s][2], S[2 * s][3]); sb.z = pk2(S[2 * s + 1][0], S[2 * s + 1][1]); sb.w = pk2(S[2 * s + 1][2], S[2 * s + 1][3]);
            const bf16x8 bfr = __builtin_bit_cast(bf16x8, sb);
            bf16x8 aq[8];
#pragma unroll
            for (int it = 0; it < 8; ++it) aq[it] = *(const LAS bf16x8*)(RA + (it * 8 + s) * 1024 + loff);
            __builtin_amdgcn_sched_barrier(0);
#pragma unroll
            for (int it = 0; it < 8; ++it) ya[it] = MFMA16(aq[it], bfr, ya[it]);
        }
        __builtin_amdgcn_sched_barrier(0);
        {
            float x0[4]; const float x16 = ex2(lg2 * (DIR == 0 ? 16.f : -16.f));
#pragma unroll
            for (int r = 0; r < 4; ++r) x0[r] = ex2(lg2 * (float)(DIR == 0 ? 4 * g4 + r + 1 : 128 - (4 * g4 + r)));
            if (DIR == 0) __syncthreads();
            LAS unsigned char* wscr = F.lds + 139776 + F.wave * 2048;
#pragma unroll
            for (int it = 0; it < 8; ++it) {
#pragma unroll
                for (int r = 0; r < 4; ++r) {
                    const unsigned short o = (unsigned short)f2bf(x0[r] * ya[it][r]);
                    if (DIR == 0) *(LAS bf16*)(RB + st_off(16 * it + 4 * g4 + r, 32 * F.wave + 2 * l15, 4)) = o;
                    else *(LAS bf16*)(wscr + (16 * (it & 3) + 4 * g4 + r) * 32 + l15 * 2) = o;
                    x0[r] *= x16;
                }
                if (DIR == 1 && (it & 3) == 3) {
                    asm volatile("s_waitcnt lgkmcnt(0)" ::: "memory");
                    const int ln = tl & 63;
#pragma unroll
                    for (int cch = 0; cch < 2; ++cch) { const int cq = ln + 64 * cch; const u32x4 yv = *(const LAS u32x4*)(wscr + cq * 16);
                        *(u32x4*)(Y + (R0 + 64 * (it >> 2) + (cq >> 1)) * 2048 + h * 512 + v0 + 8 * (cq & 1)) = yv; }
                    asm volatile("s_waitcnt lgkmcnt(0)" ::: "memory");
                }
            }
        }
#pragma unroll
        for (int i = 0; i < 16; ++i) S[i] = S[i] * gch;
        if (DIR == 0) {
#pragma unroll
            for (int e = 0; e < 8; ++e) { const int q = tl + NTHR * e; *(LAS u32x4*)(RA + st_off(q >> 4, 16 * (q & 15), 4)) = kt2[e]; }
            __syncthreads();
            u32x4 yold[4];
#pragma unroll
            for (int e = 0; e < 4; ++e) { const int q = tl + NTHR * e; yold[e] = *(const u32x4*)(Y + (R0 + (q >> 4)) * 2048 + h * 512 + vs * 128 + (q & 15) * 8); }
            RET_PF_Q(cn); RET_PF_K(cn);
#pragma unroll
            for (int e = 0; e < 4; ++e) {
                const int q = tl + NTHR * e, row = q >> 4, ch = q & 15;
                bf16* yp = Y + (R0 + row) * 2048 + h * 512 + vs * 128 + ch * 8;
                const u32x4 yv = *(const LAS u32x4*)(RB + st_off(row, 16 * ch, 4)); u32x4 o;
#pragma unroll
                for (int w = 0; w < 4; ++w) o[w] = pk2(bflo(yv[w]) + bflo(yold[e][w]), bfhi(yv[w]) + bfhi(yold[e][w]));
                *(u32x4*)yp = o;
            }
        } else {
            RET_PF_K(cn);
        }
        {
            LAS unsigned char* KT = DIR == 0 ? RA : RB;
#pragma unroll
            for (int ks = 0; ks < 4; ++ks)
#pragma unroll
                for (int dh = 0; dh < 2; ++dh) {
                    __builtin_amdgcn_sched_barrier(0);
                    bf16x8 ak[8];
#pragma unroll
                    for (int d8 = 0; d8 < 8; ++d8) ak[d8] = *(const LAS bf16x8*)(KT + ((8 * dh + d8) * 4 + ks) * 1024 + loff);
                    __builtin_amdgcn_sched_barrier(0);
#pragma unroll
                    for (int d8 = 0; d8 < 8; ++d8) S[8 * dh + d8] = MFMA16(ak[d8], vfs[ks], S[8 * dh + d8]);
                }
        }
        __syncthreads();
    }
#undef RET_PF_Q
#undef RET_PF_K
}
__device__ __forceinline__ void ret_scan_phase(const Frame& F0, const float* logit  , size_t yoff) {
    const Frame F = refresh(F0);
    const bf16* QKG = (const bf16*)(F.ws + WS_ACT + A_QKG); const bf16* KVT = (const bf16*)(F.ws + WS_ACT + A_KVT); bf16* Y = (bf16*)(F.ws + WS_ACT + A_Y + yoff);
    for (int u = F.vcu; u < NB * 16; u += F.G) {
        const int bl = u >> 4, h = (u >> 2) & 3, vs = u & 3;
        const float lgf = -log1pf(expf(-logit[h])) * 1.4426950408889634f, lgb = -log1pf(expf(-logit[4 + h])) * 1.4426950408889634f;
        ret_scan_pass<1>(F, QKG, KVT, Y, bl, h, vs, lgf, lgb);
        ret_scan_pass<0>(F, QKG, KVT, Y, bl, h, vs, lgf, lgb);
    }
}

__device__ __forceinline__ void t_phase(const Frame& F0) {
    const Frame F = refresh(F0);
    for (int it = F.gw; it < 2208; it += F.NGW) {
    const bf16* W; int N, n0; const float* sh; float* T;
    const float* MODp = (const float*)(F.ws + WS_MOD); float* TB = (float*)(F.ws + WS_T);
    if (it < 1408) { const int l = it / 352; W = (const bf16*)(F.ws + WS_W + W_FFN + (size_t)l * (16 * MiB + 512 * 1024)); N = 5632; n0 = (it % 352) * 16; sh = MODp + (size_t)l * 33 * NMOD + 3 * D; T = TB + TB_FFN + (size_t)l * TB_FFN_SZ; }
    else if (it < 1568) { W = (const bf16*)(F.ws + WS_W + W_LRU_IN); N = 2560; n0 = (it - 1408) * 16; sh = MODp + (size_t)1 * 33 * NMOD; T = TB + TB_LRU; }
    else if (it < 1696) { W = (const bf16*)(F.ws + WS_W + W_NA_QK); N = 2048; n0 = (it - 1568) * 16; sh = MODp + (size_t)2 * 33 * NMOD; T = TB + TB_NAQK; }
    else if (it < 1760) { W = (const bf16*)(F.ws + WS_W + W_NA_V); N = 1024; n0 = (it - 1696) * 16; sh = MODp + (size_t)2 * 33 * NMOD; T = TB + TB_NAV; }
    else if (it < 2016) { W = (const bf16*)(F.ws + WS_W + W_RET + 18 * MiB); N = 4096; n0 = (it - 1760) * 16; sh = MODp + (size_t)3 * 33 * NMOD; T = TB + TB_RETA; }
    else { W = (const bf16*)(F.ws + WS_W + W_RET + 18 * MiB + 8 * MiB); N = 3072; n0 = (it - 2016) * 16; sh = MODp + (size_t)3 * 33 * NMOD; T = TB + TB_RETB; }
    const int l15 = F.lane & 15, g4 = F.lane >> 4;
    f32x4 acc[3];
#pragma unroll
    for (int ct = 0; ct < 3; ++ct) acc[ct] = (f32x4){0.f, 0.f, 0.f, 0.f};
    const bf16* wp = W + (size_t)(n0 + l15) * 1024 + 8 * g4;
    for (int ks = 0; ks < 32; ++ks) {
        const bf16x8 a = *(const bf16x8*)(wp + 32 * ks);
#pragma unroll
        for (int ct = 0; ct < 3; ++ct) { const int mr = 16 * ct + l15 < 32 ? 16 * ct + l15 : 32;
            const float* sp = sh + (size_t)mr * NMOD + 32 * ks + 8 * g4; const f32x4 s0 = *(const f32x4*)sp, s1 = *(const f32x4*)(sp + 4);
            u32x4 bw; bw.x = pk2(s0.x, s0.y); bw.y = pk2(s0.z, s0.w); bw.z = pk2(s1.x, s1.y); bw.w = pk2(s1.z, s1.w);
            acc[ct] = MFMA16(a, __builtin_bit_cast(bf16x8, bw), acc[ct]); }
    }
#pragma unroll
    for (int ct = 0; ct < 3; ++ct) { const int mr = 16 * ct + l15;
        if (mr < 33) {
#pragma unroll
            for (int r = 0; r < 4; ++r) T[(size_t)mr * N + n0 + 4 * g4 + r] = acc[ct][r]; } }
    }
}

__device__ __forceinline__ void ret_gn_phase(const Frame& F0, const float* gn, size_t yoff) {
    const Frame F = refresh(F0);
    const bf16* Y = (const bf16*)(F.ws + WS_ACT + A_Y + yoff); const bf16* QKG = (const bf16*)(F.ws + WS_ACT + A_QKG); bf16* A2 = (bf16*)(F.ws + WS_ACT + A_Y + yoff);
    for (int row = F.gw; row < TG; row += F.NGW) {
#pragma unroll
        for (int h = 0; h < 4; ++h) {
            const int c = h * 512 + 8 * F.lane;
            const u32x4 yv = *(const u32x4*)(Y + (size_t)row * 2048 + c), gv = *(const u32x4*)(QKG + (size_t)row * 4096 + 2048 + c);
            float y[8]; float s = 0.f;
#pragma unroll
            for (int q = 0; q < 4; ++q) { y[2 * q] = bflo(yv[q]); y[2 * q + 1] = bfhi(yv[q]); s += y[2 * q] + y[2 * q + 1]; }
            const float mu = wave_sum(s, F.lane) * (1.f / 512.f); float s2 = 0.f;
#pragma unroll
            for (int e = 0; e < 8; ++e) { y[e] -= mu; s2 += y[e] * y[e]; }
            const float rstd = 1.f / sqrtf(wave_sum(s2, F.lane) * (1.f / 512.f) + EPS);
            float o[8];
#pragma unroll
            for (int q = 0; q < 4; ++q) { const f32x2 gg = *(const f32x2*)(gn + c + 2 * q);
                o[2 * q] = silu_f(bflo(gv[q])) * (y[2 * q] * rstd * gg.x); o[2 * q + 1] = silu_f(bfhi(gv[q])) * (y[2 * q + 1] * rstd * gg.y); }
            u32x4 w; w.x = pk2(o[0], o[1]); w.y = pk2(o[2], o[3]); w.z = pk2(o[4], o[5]); w.w = pk2(o[6], o[7]);
            *(u32x4*)(A2 + (size_t)row * 2048 + c) = w;
        }
    }
}

__device__ __forceinline__ float gelu_tanh(float x) { const float z = 0.7978845608028654f * (x + 0.044715f * x * x * x); const float e = __expf(2.f * z); const float th = 1.f - 2.f * __builtin_amdgcn_rcpf(e + 1.f); return 0.5f * x * (1.f + th); }
constexpr int XC_STRIDE = 336;
__device__ __forceinline__ void lru_gate_phase(const Frame& F0, const float* cw, const float* cb, const float* gb  , const float* lam  ) {
    const Frame F = refresh(F0);
    const bf16* YX = (const bf16*)(F.ws + WS_ACT + A_YX); const bf16* GW = (const bf16*)(F.ws + WS_W + W_LRU_G);
    bf16* LA = (bf16*)(F.ws + WS_ACT + A_LA); bf16* U = (bf16*)(F.ws + WS_ACT + A_U);
    const int l15 = F.lane & 15, g4 = F.lane >> 4;
    const int oc = F.tid % 20, rg = F.tid / 20; const bool act = rg < 22;
    float cwv[4][8], cbv[8];
#define LRU_LOAD_CW(kb_) do { const int cch = (kb_) * 160 + oc * 8; _Pragma("unroll") for (int w = 0; w < 4; ++w) { const f32x2 bb = *(const f32x2*)(cb + cch + 2 * w); cbv[2 * w] = bb.x; cbv[2 * w + 1] = bb.y; \
        _Pragma("unroll") for (int k = 0; k < 4; ++k) { const f32x2 ww = *(const f32x2*)(cw + k * LW + cch + 2 * w); cwv[k][2 * w] = ww.x; cwv[k][2 * w + 1] = ww.y; } } } while (0)
    const bool kbfix = (F.G & 7) == 0;
    LRU_LOAD_CW(F.vcu & 7);
    for (int it = F.vcu; it < (TG / 128) * 8; it += F.G) {
        const int rb = it >> 3, kb = it & 7; const int row0 = rb * 128;
        if (!kbfix) LRU_LOAD_CW(kb);
        if (act) {
            const int skey = (row0 / PT) * 2 + ((row0 % PT) >= CTXL ? 1 : 0);
            u32x4 xin[9];
#pragma unroll
            for (int q = 0; q < 9; ++q) {
                const int gr = row0 + rg * 6 - 2 + q; const bool ok = gr >= 0 && gr < TG && ((gr / PT) * 2 + ((gr % PT) >= CTXL ? 1 : 0)) == skey;
                xin[q] = ok ? *(const u32x4*)(YX + (size_t)gr * 2560 + LW + kb * 160 + oc * 8) : (u32x4){0u, 0u, 0u, 0u};
            }
#pragma unroll
            for (int jr = 0; jr < 6; ++jr) {
                const int r = rg * 6 + jr;
                if (r < 128) {
                    float o[8];
#pragma unroll
                    for (int e = 0; e < 8; ++e) o[e] = cbv[e];
#pragma unroll
                    for (int k = 0; k < 4; ++k)
#pragma unroll
                        for (int w = 0; w < 4; ++w) { o[2 * w] += cwv[k][2 * w] * bflo(xin[jr + k][w]); o[2 * w + 1] += cwv[k][2 * w + 1] * bfhi(xin[jr + k][w]); }
                    u32x4 w4; w4.x = pk2(o[0], o[1]); w4.y = pk2(o[2], o[3]); w4.z = pk2(o[4], o[5]); w4.w = pk2(o[6], o[7]);
                    *(LAS u32x4*)(F.lds + r * XC_STRIDE + oc * 16) = w4;
                }
            }
        }
        __syncthreads();
        const int dir = F.wave & 1;
        for (int nt = F.wave >> 1; nt < 10; nt += 4) {
            bf16x8 wr[5], wi[5];
            const bf16* wp = GW + ((size_t)kb * 640 + (dir * 2 + 0) * 160 + 16 * nt + l15) * 160 + 8 * g4;
#pragma unroll
            for (int ks = 0; ks < 5; ++ks) { wr[ks] = *(const bf16x8*)(wp + 32 * ks); wi[ks] = *(const bf16x8*)(wp + 160 * 160 + 32 * ks); }
            const int c0 = kb * 160 + 16 * nt + 4 * g4;
            const f32x4 br = *(const f32x4*)(gb + (dir * 2 + 0) * LW + c0), bi = *(const f32x4*)(gb + (dir * 2 + 1) * LW + c0), lm = *(const f32x4*)(lam + dir * LW + c0);
            f32x4 sp;
#pragma unroll
            for (int r = 0; r < 4; ++r) sp[r] = -8.f * log1pf(__expf(-lm[r]));
            for (int rt = 0; rt < 8; ++rt) {
                f32x4 ar = (f32x4){0.f, 0.f, 0.f, 0.f}, ai = ar;
                const LAS unsigned char* xrow = F.lds + (16 * rt + l15) * XC_STRIDE;
#pragma unroll
                for (int ks = 0; ks < 5; ++ks) { const bf16x8 xb = *(const LAS bf16x8*)(xrow + (32 * ks + 8 * g4) * 2); ar = MFMA16(wr[ks], xb, ar); ai = MFMA16(wi[ks], xb, ai); }
                const u32x2 xv = *(const LAS u32x2*)(xrow + (16 * nt + 4 * g4) * 2);
                const float x4[4] = {bflo(xv.x), bfhi(xv.x), bflo(xv.y), bfhi(xv.y)};
                float la[4], uu[4];
#pragma unroll
                for (int r = 0; r < 4; ++r) {
                    const float rg = sigmoid_f(ar[r] + br[r]), ig = sigmoid_f(ai[r] + bi[r]);
                    la[r] = rg * sp[r]; const float a2 = __expf(2.f * la[r]);
                    uu[r] = sqrtf(fmaxf(1.f - a2, 0.f)) * (ig * x4[r]);
                }
                const size_t o = ((size_t)dir * TG + (size_t)(row0 + 16 * rt + l15)) * LW + c0;
                u32x2 w1, w2; w1.x = pk2(la[0], la[1]); w1.y = pk2(la[2], la[3]); w2.x = pk2(uu[0], uu[1]); w2.y = pk2(uu[2], uu[3]);
                *(u32x2*)(LA + o) = w1; *(u32x2*)(U + o) = w2;
            }
        }
        __syncthreads();
    }
}

__device__ __forceinline__ void lru_scan_phase(const Frame& F0, size_t aoff) {
    const Frame F = refresh(F0);
    const bf16* LA = (const bf16*)(F.ws + WS_ACT + A_LA); const bf16* U = (const bf16*)(F.ws + WS_ACT + A_U); const bf16* YX = (const bf16*)(F.ws + WS_ACT + A_YX);
    bf16* A3 = (bf16*)(F.ws + WS_ACT + A_A3 + aoff);
    LAS f32x4* cbuf = (LAS f32x4*)F.lds;
    const int cp = F.tid % 40, k = F.tid / 40; const bool act = F.tid < 360;
    for (int it = F.vcu; it < NB * 16; it += F.G) {
        const int bl = it >> 4, cg = it & 15; const int c0 = cg * 80 + 2 * cp;
        for (int dir = 0; dir < 2; ++dir) {
            const size_t base = ((size_t)dir * TG + (size_t)bl * PT) * LW + c0;
            const int pstart = dir == 0 ? 256 * k : 256 * k + 255, pstep = dir == 0 ? 1 : -1;
            if (act) {
                float hx = 0.f, hy = 0.f, sx = 0.f, sy = 0.f;
                for (int s0 = 0; s0 < 256; s0 += 32) {
                    unsigned lv[32], uv[32];
#pragma unroll
                    for (int e = 0; e < 32; ++e) { const size_t o = base + (size_t)(pstart + pstep * (s0 + e)) * LW; lv[e] = *(const unsigned*)(LA + o); uv[e] = *(const unsigned*)(U + o); }
#pragma unroll
                    for (int e = 0; e < 32; ++e) { const float lx = bflo(lv[e]), ly = bfhi(lv[e]); hx = __expf(lx) * hx + bflo(uv[e]); hy = __expf(ly) * hy + bfhi(uv[e]); sx += lx; sy += ly; }
                }
                cbuf[k * 40 + cp] = (f32x4){__expf(sx), hx, __expf(sy), hy};
            }
            __syncthreads();
            if (act) {
                const int ok = dir == 0 ? k : (k == 0 ? 0 : 9 - k);
                float hx = 0.f, hy = 0.f;
                for (int o = 0; o < ok; ++o) { const int kk = dir == 0 ? o : (o == 0 ? 0 : 9 - o); const f32x4 cv = cbuf[kk * 40 + cp]; hx = cv.x * hx + cv.y; hy = cv.z * hy + cv.w; }
                for (int s0 = 0; s0 < 256; s0 += 16) {
                    unsigned lv[16], uv[16], fv[16], yv[16];
#pragma unroll
                    for (int e = 0; e < 16; ++e) { const int p = pstart + pstep * (s0 + e); const size_t o = base + (size_t)p * LW; lv[e] = *(const unsigned*)(LA + o); uv[e] = *(const unsigned*)(U + o);
                        if (dir == 1) { const size_t r = (size_t)bl * PT + p; fv[e] = *(const unsigned*)(A3 + r * LW + c0); yv[e] = *(const unsigned*)(YX + r * 2560 + c0); } }
#pragma unroll
                    for (int e = 0; e < 16; ++e) { const int p = pstart + pstep * (s0 + e); const size_t r = (size_t)bl * PT + p;
                        hx = __expf(bflo(lv[e])) * hx + bflo(uv[e]); hy = __expf(bfhi(lv[e])) * hy + bfhi(uv[e]);
                        unsigned w;
                        if (dir == 0) w = pk2(hx, hy);
                        else w = pk2((hx + bflo(fv[e])) * gelu_tanh(bflo(yv[e])), (hy + bfhi(fv[e])) * gelu_tanh(bfhi(yv[e])));
                        *(unsigned*)(A3 + r * LW + c0) = w; }
                }
            }
            __syncthreads();
        }
    }
}

constexpr int CK_STRIDE = 144, CV_STRIDE = 528, NA_CK = 0, NA_CV = 36864, NA_RP = 36864 + 33792;
__device__ __forceinline__ void na_attn_phase(const Frame& F0, const float* rpb  , size_t ooff) {
    const Frame F = refresh(F0);
    const bf16* QK = (const bf16*)(F.ws + WS_ACT + A_QK); const bf16* VT = (const bf16*)(F.ws + WS_ACT + A_VT); bf16* O = (bf16*)(F.ws + WS_ACT + A_O + ooff);
    const float L2E = 1.4426950408889634f;
    LAS unsigned char* CK = F.lds + NA_CK; LAS unsigned char* CV = F.lds + NA_CV; LAS float* RP = (LAS float*)(F.lds + NA_RP);
    for (int item = F.vcu; item < NB * 16; item += F.G) {
        const int bl = item >> 4, h = item & 15; const size_t cbase = (size_t)bl * PT;
        {
            int ts = F.tid; asm volatile("" : "+v"(ts));
#pragma unroll
            for (int e = 0; e < 4; ++e) { const int q = ts + NTHR * e;
                *(LAS u32x4*)(CK + (q >> 3) * CK_STRIDE + (q & 7) * 16) = *(const u32x4*)(QK + (cbase + (q >> 3)) * 2048 + 1024 + h * 64 + (q & 7) * 8);
                *(LAS u32x4*)(CV + (q >> 5) * CV_STRIDE + (q & 31) * 16) = *(const u32x4*)(VT + (size_t)(h * 64 + (q >> 5)) * TG + cbase + (q & 31) * 8); }
            if (ts < 465) RP[ts] = rpb[h * 465 + ts];
        }
        __syncthreads();
        int tl_ = F.tid; asm volatile("" : "+v"(tl_));
        const int l15 = tl_ & 15, g4 = (tl_ >> 4) & 3;
        bf16x8 qf[2], qn[2], kfa[4][2], kfb[4][2]; u32x2 vfa[2][4][2];
#define NA_CC0(qb_) ((qb_) == 0 ? 0 : ((qb_) == 1 ? 8 : ((qb_) == 2 ? 24 : 32)))
#define NA_START(r_) ((r_) - 4 < 0 ? 0 : ((r_) - 4 > 24 ? 24 : (r_) - 4))
        const unsigned qko = (unsigned)(l15 * 2048 + 8 * g4) * 2u, vto = (unsigned)(l15 * TG + 4 * g4) * 2u;
        const char* qkb = (const char*)(QK + cbase * 2048 + h * 64); const char* vtb = (const char*)(VT + (size_t)(h * 64) * TG + cbase);
#define NA_TK(st_, cc_, BLK, t) (CTXL + ((st_) + 2 * (BLK) + ((t) >> 1)) * 64 + (cc_) + 16 * ((t) & 1))
#define NA_LOADQ(dst, tq_) do { _Pragma("unroll") for (int s_ = 0; s_ < 2; ++s_) dst[s_] = *(const bf16x8*)(qkb + (size_t)(tq_) * 4096 + 64 * s_ + qko); } while (0)
#define NA_LOADK(kf, st_, cc_, BLK) do { _Pragma("unroll") for (int t = 0; t < 4; ++t) { const char* kp = qkb + (size_t)NA_TK(st_, cc_, BLK, t) * 4096 + 2048; \
            kf[t][0] = *(const bf16x8*)(kp + qko); kf[t][1] = *(const bf16x8*)(kp + 64 + qko); } } while (0)
#define NA_LOADV(vf, st_, cc_, BLK) do { _Pragma("unroll") for (int pr = 0; pr < 2; ++pr) _Pragma("unroll") for (int dt = 0; dt < 4; ++dt) { const char* vrow = vtb + (size_t)(16 * dt) * TG * 2; \
            vf[pr][dt][0] = *(const u32x2*)(vrow + (size_t)NA_TK(st_, cc_, BLK, 2 * pr) * 2 + vto); vf[pr][dt][1] = *(const u32x2*)(vrow + (size_t)NA_TK(st_, cc_, BLK, 2 * pr + 1) * 2 + vto); } } while (0)
#define NA_SOFTMAX() \
            float bm = -1e30f; \
            _Pragma("unroll") for (int t = 0; t < 4; ++t) bm = fmaxf(fmaxf(fmaxf(st[t][0], st[t][1]), fmaxf(st[t][2], st[t][3])), bm); \
            bm = fmaxf(bm, lane_get(bm, (tl_ & 63) ^ 16)); bm = fmaxf(bm, lane_get(bm, (tl_ & 63) ^ 32)); \
            const float mnew = fmaxf(mrun, bm); const float alpha = ex2((mrun - mnew) * L2E); mrun = mnew; \
            float ps = 0.f; u32x4 pa[2]; \
            _Pragma("unroll") for (int t = 0; t < 4; ++t) { float pv[4]; \
                _Pragma("unroll") for (int e = 0; e < 4; ++e) { pv[e] = ex2((st[t][e] - mnew) * L2E); ps += pv[e]; } \
                pa[t >> 1][2 * (t & 1)] = pk2(pv[0], pv[1]); pa[t >> 1][2 * (t & 1) + 1] = pk2(pv[2], pv[3]); } \
            lrun = lrun * alpha + ps; \
            { float ar[4]; _Pragma("unroll") for (int e = 0; e < 4; ++e) ar[e] = lane_get(alpha, 4 * g4 + e); \
              _Pragma("unroll") for (int dt = 0; dt < 4; ++dt) _Pragma("unroll") for (int e = 0; e < 4; ++e) o[dt][e] *= ar[e]; }
#define NA_BLOCK_WIN(kf, vf, BLK) do { f32x4 st[4]; \
            _Pragma("unroll") for (int t = 0; t < 4; ++t) { const int rr = start + 2 * (BLK) + (t >> 1), kc0 = cc0 + 16 * (t & 1); \
                f32x4 a = (f32x4){0.f, 0.f, 0.f, 0.f}; a = MFMA16(kf[t][0], qf[0], a); a = MFMA16(kf[t][1], qf[1], a); \
                const LAS float* bp = RP + (rr - r + 7) * 31 + (kc0 + 4 * g4 - qc + 15); \
                _Pragma("unroll") for (int e = 0; e < 4; ++e) { const bool ok = (unsigned)(kc0 + 4 * g4 + e - cs) < 16u; a[e] = ok ? a[e] + bp[e] : -1e30f; }     \
                st[t] = a; } \
            NA_SOFTMAX() \
            _Pragma("unroll") for (int pr = 0; pr < 2; ++pr) _Pragma("unroll") for (int dt = 0; dt < 4; ++dt) { \
                const u32x4 vb = (u32x4){vf[pr][dt][0].x, vf[pr][dt][0].y, vf[pr][dt][1].x, vf[pr][dt][1].y}; \
                o[dt] = MFMA16(__builtin_bit_cast(bf16x8, pa[pr]), __builtin_bit_cast(bf16x8, vb), o[dt]); } } while (0)
#define NA_BLOCK_CTX(BLK) do { f32x4 st[4]; \
            _Pragma("unroll") for (int t = 0; t < 4; ++t) { const LAS unsigned char* kp = CK + (64 * (BLK) + 16 * t) * CK_STRIDE + cko; \
                f32x4 a = (f32x4){0.f, 0.f, 0.f, 0.f}; a = MFMA16(*(const LAS bf16x8*)kp, qf[0], a); a = MFMA16(*(const LAS bf16x8*)(kp + 64), qf[1], a); st[t] = a; } \
            NA_SOFTMAX() \
            _Pragma("unroll") for (int pr = 0; pr < 2; ++pr) _Pragma("unroll") for (int dt = 0; dt < 4; ++dt) { const LAS unsigned char* vrow = CV + (16 * dt) * CV_STRIDE + (64 * (BLK) + 32 * pr) * 2 + cvo; \
                const u32x2 lo = *(const LAS u32x2*)vrow, hi = *(const LAS u32x2*)(vrow + 32); const u32x4 vb = (u32x4){lo.x, lo.y, hi.x, hi.y}; \
                o[dt] = MFMA16(__builtin_bit_cast(bf16x8, pa[pr]), __builtin_bit_cast(bf16x8, vb), o[dt]); } } while (0)
#define NA_FINISH(tq_) do { lrun += lane_get(lrun, (tl_ & 63) ^ 16); lrun += lane_get(lrun, (tl_ & 63) ^ 32); \
            _Pragma("unroll") for (int e = 0; e < 4; ++e) { const float inv = 1.f / lane_get(lrun, 4 * g4 + e); \
                _Pragma("unroll") for (int dt = 0; dt < 4; ++dt) O[(cbase + (tq_) + 4 * g4 + e) * 1024 + h * 64 + 16 * dt + l15] = (bf16)f2bf(o[dt][e] * inv); } } while (0)
        {
            const int r0_ = F.wave >> 2, qb0_ = F.wave & 3;
            NA_LOADQ(qn, CTXL + r0_ * 64 + 16 * qb0_); NA_LOADK(kfa, NA_START(r0_), NA_CC0(qb0_), 0); NA_LOADV(vfa, NA_START(r0_), NA_CC0(qb0_), 0);
        }
#pragma unroll 1
        for (int i = 0; i < 16; ++i) {
            const int uu = F.wave + 8 * i; const int r = uu >> 2, qb = uu & 3; const int Rq = CTXL + r * 64 + 16 * qb;
            const int start = NA_START(r), cc0 = NA_CC0(qb);
            const int qc = 16 * qb + l15; const int cs = qc - 8 < 0 ? 0 : (qc - 8 > 48 ? 48 : qc - 8);
            qf[0] = qn[0]; qf[1] = qn[1];
            int cko = l15 * CK_STRIDE + 16 * g4, cvo = l15 * CV_STRIDE + 8 * g4; asm volatile("" : "+v"(cko), "+v"(cvo));
            float mrun = -1e30f, lrun = 0.f;
            f32x4 o[4];
#pragma unroll
            for (int dt = 0; dt < 4; ++dt) o[dt] = (f32x4){0.f, 0.f, 0.f, 0.f};
            NA_LOADK(kfb, start, cc0, 1); __builtin_amdgcn_sched_barrier(0);
            NA_BLOCK_WIN(kfa, vfa, 0); __builtin_amdgcn_sched_barrier(0);
            NA_LOADV(vfa, start, cc0, 1); NA_LOADK(kfa, start, cc0, 2); __builtin_amdgcn_sched_barrier(0);
            NA_BLOCK_WIN(kfb, vfa, 1); __builtin_amdgcn_sched_barrier(0);
            NA_LOADV(vfa, start, cc0, 2); NA_LOADK(kfb, start, cc0, 3); __builtin_amdgcn_sched_barrier(0);
            NA_BLOCK_WIN(kfa, vfa, 2); __builtin_amdgcn_sched_barrier(0);
            NA_LOADV(vfa, start, cc0, 3); __builtin_amdgcn_sched_barrier(0);
            {
                const int un = uu + 8; const int rn = un >> 2, qbn = un & 3;
                if (i < 15) { NA_LOADQ(qn, CTXL + rn * 64 + 16 * qbn); NA_LOADK(kfa, NA_START(rn), NA_CC0(qbn), 0); }
                else NA_LOADQ(qn, 16 * (un - 128));
            }
            __builtin_amdgcn_sched_barrier(0);
            NA_BLOCK_WIN(kfb, vfa, 3); __builtin_amdgcn_sched_barrier(0);
            if (i < 15) { const int un = uu + 8; NA_LOADV(vfa, NA_START(un >> 2), NA_CC0(un & 3), 0); }
            __builtin_amdgcn_sched_barrier(0);
            NA_BLOCK_CTX(0); __builtin_amdgcn_sched_barrier(0); NA_BLOCK_CTX(1); __builtin_amdgcn_sched_barrier(0); NA_BLOCK_CTX(2); __builtin_amdgcn_sched_barrier(0); NA_BLOCK_CTX(3); __builtin_amdgcn_sched_barrier(0);
            NA_FINISH(Rq);
        }
#pragma unroll 1
        for (int i = 16; i < 18; ++i) {
            const int uu = F.wave + 8 * i; const int Rq = 16 * (uu - 128);
            qf[0] = qn[0]; qf[1] = qn[1];
            if (i == 16) NA_LOADQ(qn, 16 * (uu + 8 - 128));
            int cko = l15 * CK_STRIDE + 16 * g4, cvo = l15 * CV_STRIDE + 8 * g4; asm volatile("" : "+v"(cko), "+v"(cvo));
            float mrun = -1e30f, lrun = 0.f;
            f32x4 o[4];
#pragma unroll
            for (int dt = 0; dt < 4; ++dt) o[dt] = (f32x4){0.f, 0.f, 0.f, 0.f};
            NA_BLOCK_CTX(0); __builtin_amdgcn_sched_barrier(0); NA_BLOCK_CTX(1); __builtin_amdgcn_sched_barrier(0); NA_BLOCK_CTX(2); __builtin_amdgcn_sched_barrier(0); NA_BLOCK_CTX(3); __builtin_amdgcn_sched_barrier(0);
            NA_FINISH(Rq);
        }
#undef NA_CC0
#undef NA_START
#undef NA_TK
#undef NA_LOADQ
#undef NA_LOADK
#undef NA_LOADV
#undef NA_SOFTMAX
#undef NA_BLOCK_WIN
#undef NA_BLOCK_CTX
#undef NA_FINISH
        __syncthreads();
    }
}

__device__ __forceinline__ void final_norm_phase(const Frame& F0, const bf16* xfin, float* out, const float* gain) {
    const Frame F = refresh(F0);
    for (int row = F.gw; row < NBATCH * SEQ; row += F.NGW) {
        const bf16* src = xfin + (size_t)row * D; float* dst = out + (size_t)row * D;
        f32x4 v[4]; float ss = 0.f;
#pragma unroll
        for (int j = 0; j < 4; ++j) { const u32x2 w = *(const u32x2*)(src + 4 * F.lane + 256 * j); v[j] = (f32x4){bflo(w.x), bfhi(w.x), bflo(w.y), bfhi(w.y)};
            ss += (v[j].x * v[j].x + v[j].y * v[j].y) + (v[j].z * v[j].z + v[j].w * v[j].w); }
        const float rstd = 1.f / sqrtf(wave_sum(ss, F.lane) * (1.f / D) + EPS);
#pragma unroll
        for (int j = 0; j < 4; ++j) { const int c = 4 * F.lane + 256 * j; const f32x4 gn = *(const f32x4*)(gain + c); *(f32x4*)(dst + c) = (v[j] * rstd) * gn; }
    }
}

__device__ __forceinline__ void dbg_check_ffn(const Frame& F0, const float* up, const float* cw, const float* cb) {
    const Frame F = refresh(F0);
    if (F.vcu != 0 || F.tid >= 1) return;
    const bf16* Hh = (const bf16*)(F.ws + WS_ACT + A_H); const bf16* ACT = (const bf16*)(F.ws + WS_ACT + A_ACT);
    const int row = 276, c = 5;
    float u[2][5];
    for (int half = 0; half < 2; ++half) for (int k = 0; k < 5; ++k) {
        const int rr = row + (k == 0 ? -16 : (k == 4 ? 16 : k - 2)); const int col = half * FFN + c;
        float d = 0.f; for (int q = 0; q < 1024; ++q) d += bf2f(Hh[(size_t)rr * 1024 + q]) * up[(size_t)q * FFN2 + col]; u[half][k] = d; }
    const float got = bf2f(ACT[(size_t)row * FFN + c]);
    unsigned code = 9;
    for (int hyp = 8; hyp >= 1; --hyp) {
        float uv2[2];
        for (int half = 0; half < 2; ++half) { const int col = half * FFN + c; const float w0 = cw[col], w1 = cw[FFN2 + col], w2 = cw[2 * FFN2 + col], b = cb[col];
            float pv = u[half][1], cv = u[half][2], nv = u[half][3];
            if (hyp == 2) { pv = u[half][3]; nv = u[half][1]; }
            if (hyp == 3) { pv = 0.f; nv = 0.f; }
            if (hyp == 4) { pv = u[half][0]; nv = u[half][4]; }
            if (hyp == 5) { pv = u[half][4]; nv = u[half][0]; }
            if (hyp == 6) { pv = 0.f; }
            if (hyp == 7) { nv = 0.f; }
            if (hyp == 8) { pv = cv; nv = cv; }
            uv2[half] = b + w0 * pv + w1 * cv + w2 * nv; }
        const float ref = silu_f(uv2[0]) * uv2[1];
        if (fabsf(ref - got) <= 0.03f + 0.03f * fabsf(ref)) code = hyp;
    }
    atomicMin((unsigned*)(F.ws + WS_CTL) + CW_DBG, code);
}

__global__ void __launch_bounds__(NTHR, 2) mega_fwd(Args a) {
    extern __shared__ __attribute__((aligned(16))) unsigned char lds_raw[];
    Frame F;
    F.lds = (LAS unsigned char*)lds_raw;
    F.tid = threadIdx.x; F.lane = F.tid & 63; F.wave = __builtin_amdgcn_readfirstlane(F.tid >> 6);
    F.G = gridDim.x; { const int bx = blockIdx.x; F.vcu = (F.G % 8 == 0) ? (bx % 8) * (F.G / 8) + bx / 8 : bx; }
    F.gw = F.vcu * NWAVES + F.wave; F.NGW = F.G * NWAVES; F.ws = AWS;
    volatile LAS unsigned* MISC = (volatile LAS unsigned*)(F.lds + MISC_OFF);
    for (int u = F.tid; u < (LDS_BYTES - MISC_OFF) / 4; u += NTHR) ((LAS unsigned*)(F.lds + MISC_OFF))[u] = 0u;
    __syncthreads();
    unsigned* ctl = (unsigned*)(AWS + WS_CTL);
    XcdBarrier bar = xcd_barrier_post(ctl + CW_BAR, MISC + 8);
    (void)bar;
#define GRID_BAR() do { XcdBarrier b_; b_.bar = (unsigned*)(AWS + WS_CTL) + CW_BAR; unsigned x_ = xb_xcc_id(); asm volatile("" : "+s"(x_)); b_.x = x_; \
        b_.st = (volatile LAS unsigned*)(F.lds + MISC_OFF) + 8; b_.t0 = (F.wave == 0) && (lane_id() == 0); xcd_barrier(b_); } while (0)
#define MOD ((const float*)(AWS + WS_MOD))
#define XS ((bf16*)AOUT)
#define CS ((bf16*)(AWS + WS_CTX))
#define XFIN ((bf16*)(AWS + WS_ACT + A_H))
#define Wb ((bf16*)(AWS + WS_W))
#define H ((bf16*)(AWS + WS_ACT + A_H))
    const int bx = (int)blockIdx.x;

    if (DBG && blockIdx.x == 0 && threadIdx.x == 0) __hip_atomic_store((unsigned*)(AWS + WS_CTL) + CW_DBG, 0xffffffffu, RLX_AGENT);
    if (EN(1)) prologue(F); if (DUP & (1 << 1)) { GRID_BAR(); prologue(F); }
    GRID_BAR();

#define GEMM_BF16(Aptr, Btptr, M_, N_, K_, Optr, ldc_) do { pg8::Gemm gg{(const bf16*)(Aptr), (const bf16*)(Btptr), (M_), (N_), (K_)}; pg8::StaticOrder So; So.init((M_), (N_), F.G, bx); \
        pg8::EpiBf16 Ee{(bf16*)(Optr), (ldc_)}; pg8::gemm_phase<pg8::EpiBf16, pg8::StaticOrder, true>(F.lds, gg, So, Ee, F.wave); } while (0)
#define STATP ((float*)(AWS + WS_STAT))
#define TBP ((const float*)(AWS + WS_T))
#define GEMM_BF16N(SW, Aptr, Btptr, M_, N_, K_, Optr, ldc_, tile0_, Toff_, ldt_) do { pg8::Gemm gg{(const bf16*)(Aptr), (const bf16*)(Btptr), (M_), (N_), (K_)}; pg8::StaticOrder So; So.init((M_), (N_), F.G, bx); \
        pg8::EpiBf16N<SW> Ee{(bf16*)(Optr), (ldc_), STATP, TBP + (Toff_), (ldt_), F.lds + NSLOT_OFF, (tile0_)}; pg8::gemm_phase<pg8::EpiBf16N<SW>, pg8::StaticOrder, true>(F.lds, gg, So, Ee, F.wave); } while (0)
#define GEMM_RESID(Aptr, Btptr, M_, K_, sx, sc, f32s_, dx_, layer, goff_, b0_, NL_, NF_) do { pg8::Gemm gg{(const bf16*)(Aptr), (const bf16*)(Btptr), (M_), D, (K_)}; pg8::StaticOrder So; So.init((M_), D, F.G, bx, (layer) == 3 ? 1 : 0); \
        pg8::EpiResid Ee{(sx), (sc), (dx_), CS, MOD + (size_t)(layer) * 33 * NMOD, (goff_), (b0_), (f32s_), \
            (NF_) < 0 ? (bf16*)nullptr : H, ((NF_) == 0 && (NL_) == 3) ? HALT - (size_t)TG * D : H, ((NF_) > 0 ? AIN(I_NFFN) : AIN(I_NMIX)) + (NL_) * D, MOD + (size_t)(NL_) * 33 * NMOD, (NF_) > 0 ? 4 * D : D, STATP, F.lds + 131072}; \
        pg8::gemm_phase<pg8::EpiResid, pg8::StaticOrder, true>(F.lds, gg, So, Ee, F.wave); } while (0)
#define FFN_BLOCK(layer) do { \
        { bf16* Wup = Wb + (W_FFN + (size_t)(layer) * (16 * MiB + 512 * 1024)) / 2; bf16* Wdn = Wup + (11 * MiB) / 2; \
          for (int rep_ = 0; rep_ < ((DUP & (1 << 15)) ? 2 : 1); ++rep_) { if (rep_) GRID_BAR(); if (EN(3)) { pg8::Gemm gg{H, Wup, NBATCH * PT, FFN2, D}; pg8::StaticOrder So; So.init(NBATCH * PT, FFN2, F.G, bx, (layer) == 3 ? 1 : 0); \
              pg8::EpiConvGate Ee{(bf16*)(AWS + WS_ACT + A_ACT), (bf16*)(AWS + WS_ACT + A_EDGE), AIN(I_FCW) + (size_t)(layer) * 3 * FFN2, AIN(I_FCB) + (size_t)(layer) * FFN2, F.lds + 131072, F.lds + MISC_OFF + 512, STATP, TBP + TB_FFN + (size_t)(layer) * TB_FFN_SZ, F.lds + NSLOT_OFF}; \
              pg8::gemm_phase<pg8::EpiConvGate, pg8::StaticOrder, true>(F.lds, gg, So, Ee, F.wave); } } GRID_BAR(); \
          if (EN(4)) ffn_fix_phase(F, AIN(I_FCW) + (size_t)(layer) * 3 * FFN2, AIN(I_FCB) + (size_t)(layer) * FFN2); GRID_BAR(); \
          if (DBG && (layer) == 0) { dbg_check_ffn(F, AIN(I_UP), AIN(I_FCW), AIN(I_FCB)); GRID_BAR(); } \
          if (EN(5)) GEMM_RESID(AWS + WS_ACT + A_ACT, Wdn, NBATCH * PT, FFN, XS, CS, 0, (layer) == 3 ? XFIN : XS, (layer), 5 * D, 0, (layer) + 1, (layer) < 3 ? 0 : -1); GRID_BAR(); } } while (0)
#define HALT (XS + (size_t)NBATCH * SEQ * D)
#define RET_MIXER(layer, j, sx, sc, f32s_, DN_) do { \
        if (!(DN_)) { if (EN(2)) norm_phase(F, g * NB, TG, (sx), (sc), (f32s_), AIN(I_NMIX) + (layer) * D, MOD + (size_t)(layer) * 33 * NMOD, 0, D); GRID_BAR(); } \
        { bf16* Wa = Wb + (W_RET + (size_t)(j) * 18 * MiB) / 2; bf16* Wbb = Wa + (8 * MiB) / 2; const bf16* Hg = ((DN_) && g == 1) ? HALT : H; \
          if (EN(3)) { pg8::Gemm gg{Hg, Wa, TG, 4096, D}; pg8::StaticOrder So; So.init(TG, 4096, F.G, bx); pg8::EpiRopeQ<DN_> Ee{(bf16*)(AWS + WS_ACT + A_QKG), (const float*)(AWS + WS_ROPE), STATP, TBP + TB_RETA, F.lds + NSLOT_OFF, g * 144}; \
              pg8::gemm_phase<pg8::EpiRopeQ<DN_>, pg8::StaticOrder, true>(F.lds, gg, So, Ee, F.wave); } \
          if (EN(3)) { pg8::Gemm gg{Wbb, Hg, 3072, TG, D}; pg8::StaticOrder So; So.init(3072, TG, F.G, bx); pg8::EpiRopeKT<DN_> Ee{(bf16*)(AWS + WS_ACT + A_KVT), (const float*)(AWS + WS_ROPE), TG, STATP, TBP + TB_RETB, F.lds + NSLOT_OFF, g * 144}; \
              pg8::gemm_phase<pg8::EpiRopeKT<DN_>, pg8::StaticOrder, true>(F.lds, gg, So, Ee, F.wave); } GRID_BAR(); \
          if (EN(7)) ret_scan_phase(F, AIN(I_RDEC) + (j) * 8, (size_t)g * 144 * MiB); GRID_BAR(); \
          if (EN(8)) ret_gn_phase(F, AIN(I_RGN) + (j) * 2048, (size_t)g * 144 * MiB); GRID_BAR(); } } while (0)
#define RET_OUT(layer, j, sx, sc, f32s_) do { bf16* Wo = Wb + (W_RET + (size_t)(j) * 18 * MiB + 14 * MiB) / 2; \
        if (EN(5)) GEMM_RESID(AWS + WS_ACT + A_Y, Wo, NBATCH * PT, 2048, (sx), (sc), (f32s_), XS, (layer), 2 * D, 0, (layer), 1); GRID_BAR(); } while (0)

    if (EN(2)) t_phase(F);
    for (int g = 0; g < NG; ++g) RET_MIXER(0, 0, AIN(I_X), AIN(I_CTX), 1, false);
    RET_OUT(0, 0, AIN(I_X), AIN(I_CTX), 1);
    FFN_BLOCK(0);
    for (int g = 0; g < NG; ++g) {
        if (EN(3)) GEMM_BF16N(false, H + (size_t)g * TG * D, Wb + W_LRU_IN / 2, TG, 2560, D, AWS + WS_ACT + A_YX, 2560, g * 144, TB_LRU, 2560); GRID_BAR();
        if (EN(10)) lru_gate_phase(F, AIN(I_LCW), AIN(I_LCB), AIN(I_LGB), AIN(I_LLAM)); GRID_BAR();
        if (EN(11)) lru_scan_phase(F, (size_t)g * 90 * MiB); GRID_BAR();
    }
    if (EN(5)) GEMM_RESID(AWS + WS_ACT + A_A3, Wb + W_LRU_OUT / 2, NBATCH * PT, LW, XS, CS, 0, XS, 1, 2 * D, 0, 1, 1); GRID_BAR();
    FFN_BLOCK(1);
    for (int g = 0; g < NG; ++g) {
        if (EN(3)) GEMM_BF16N(false, H + (size_t)g * TG * D, Wb + W_NA_QK / 2, TG, 2048, D, AWS + WS_ACT + A_QK, 2048, g * 144, TB_NAQK, 2048);
        if (EN(3)) GEMM_BF16N(true, Wb + W_NA_V / 2, H + (size_t)g * TG * D, 1024, TG, D, AWS + WS_ACT + A_VT, TG, g * 144, TB_NAV, 1024); GRID_BAR();
        if (EN(13)) na_attn_phase(F, AIN(I_NRPB), (size_t)g * 72 * MiB); GRID_BAR();
    }
    if (EN(5)) GEMM_RESID(AWS + WS_ACT + A_O, Wb + W_NA_O / 2, NBATCH * PT, D, XS, CS, 0, XS, 2, 2 * D, 0, 2, 1); GRID_BAR();
    FFN_BLOCK(2);
    for (int g = 0; g < NG; ++g) RET_MIXER(3, 1, XS, CS, 0, true);
    RET_OUT(3, 1, XS, CS, 0);
    FFN_BLOCK(3);
    if (EN(14)) final_norm_phase(F, XFIN, AOUT, AIN(I_FNORM));
    if (DBG) { GRID_BAR(); const unsigned code = __hip_atomic_load((unsigned*)(AWS + WS_CTL) + CW_DBG, RLX_AGENT);
        if (code != 0xffffffffu) { float* o = AOUT; for (size_t i = (size_t)blockIdx.x * NTHR + threadIdx.x; i < (size_t)NBATCH * SEQ * D; i += (size_t)gridDim.x * NTHR) o[i] = 1000.f * (float)code; } }
}

extern "C" void kernel_launch(void* const* d_in, const int* in_sizes, int n_in, void* d_out, int out_size, void* d_ws, size_t ws_size, hipStream_t stream) {
    static int grid = 0;
    if (grid == 0) {
        if (n_in != 27 || ws_size < WS_END) { fprintf(stderr, "kernel_launch: need 27 inputs and >= %zu bytes of workspace; got %d, %zu\n", (size_t)WS_END, n_in, ws_size); grid = -1; return; }
        int dev = 0, cus = 0, per_cu = 0;
        if (hipGetDevice(&dev) != hipSuccess || hipDeviceGetAttribute(&cus, hipDeviceAttributeMultiprocessorCount, dev) != hipSuccess) { grid = -1; return; }
        if (hipFuncSetAttribute((const void*)mega_fwd, hipFuncAttributeMaxDynamicSharedMemorySize, LDS_BYTES) != hipSuccess) { fprintf(stderr, "kernel_launch: hipFuncSetAttribute failed\n"); grid = -1; return; }
        if (hipOccupancyMaxActiveBlocksPerMultiprocessor(&per_cu, (const void*)mega_fwd, NTHR, LDS_BYTES) != hipSuccess || per_cu < 1) { fprintf(stderr, "kernel_launch: occupancy query says %d\n", per_cu); }
        (void)hipGetLastError();
        grid = cus;
    }
    if (grid < 0) return;
    (void)hipMemsetAsync((char*)d_ws + WS_CTL, 0, CTL_ZERO_BYTES, stream);
    Args a{};
    for (int i = 0; i < 27; ++i) a.in[i] = (const float*)d_in[i];
    a.out = (float*)d_out; a.ws = (unsigned char*)d_ws;
    hipLaunchKernelGGL(mega_fwd, dim3(grid), dim3(NTHR), LDS_BYTES, stream, a);
}
```

```cpp
#include <hip/hip_runtime.h>
#include <cstdio>
#include <cstdint>

#ifndef DBG
#define DBG 0
#endif
#ifndef ONLY
#define ONLY 0
#endif
#define EN(k) (ONLY == 0 || ONLY == (k))
#ifndef DUP
#define DUP 0
#endif

#define GAS __attribute__((address_space(1)))
#define LAS __attribute__((address_space(3)))
typedef unsigned short bf16;
typedef short bf16x8 __attribute__((ext_vector_type(8)));
typedef float f32x4 __attribute__((ext_vector_type(4)));
typedef float f32x2 __attribute__((ext_vector_type(2)));
typedef unsigned u32x4 __attribute__((ext_vector_type(4)));
typedef unsigned u32x2 __attribute__((ext_vector_type(2)));
typedef GAS unsigned gu32;

__device__ __forceinline__ int lane_id() { unsigned m = ~0u; asm volatile("" : "+s"(m)); return (int)__builtin_amdgcn_mbcnt_hi(m, __builtin_amdgcn_mbcnt_lo(m, 0u)); }
namespace pg8 {
#define PG8_LAS __attribute__((address_space(3)))
typedef unsigned short bf16_t;
constexpr int BM = 256, BK = 64, HALF = 128, HTB = HALF * BK * 2, STAGE_BYTES = 8 * HTB, NXCD = 8, WGM = 8;
__host__ __device__ __forceinline__ int lds_byte(int r, int c) { const int st = (r >> 4) * 2 + (c >> 5), rr = r & 15, cc = c & 31, ob = rr * 64 + cc * 2; return st * 1024 + (ob ^ (((ob >> 9) & 1) << 5)); }
__host__ __device__ __forceinline__ void stage_rc(int b, int& R, int& C) { const int st = b / 1024, sb = b % 1024, swz = sb ^ (((sb >> 9) & 1) << 5); R = (st >> 1) * 16 + swz / 64; C = (st & 1) * 32 + (swz % 64) / 2; }
__host__ __device__ __forceinline__ int perm32(int rho) { const int n = rho >> 4, i = rho & 15; return 8 * (i >> 2) + 4 * n + (i & 3); }
struct Unit { int pm, pn; };
struct Gemm { const bf16_t* A; const bf16_t* Bt; int M, N, K; };
struct StaticOrder {
    int nM, nN, nwg, G, c;
    __host__ __device__ __forceinline__ void init(int M, int N, int G_, int c_, int lat_ = 0) { nM = M / BM; if (lat_) nM = nM / 9 * 8; nN = N / BM; nwg = nM * nN; G = G_; c = c_; if (lat_) nN = -nN; }
    __host__ __device__ __forceinline__ bool next(int i, Unit& u) const {
        const long L = (long)i * G + c; if (L >= nwg) return false;
        const int nn = nN < 0 ? -nN : nN;
        int wgid = (int)L; { const int q = nwg / NXCD, r = nwg % NXCD, xcd = wgid % NXCD, off = wgid / NXCD; wgid = (xcd < r ? xcd * (q + 1) : r * (q + 1) + (xcd - r) * q) + off; }
        const int nig = WGM * nn, gid = wgid / nig, fm = gid * WGM, gsz = (nM - fm) < WGM ? (nM - fm) : WGM;
        u.pm = fm + ((wgid % nig) % gsz); u.pn = (wgid % nig) / gsz; if (nN < 0) u.pm += (u.pm >> 3) + 1; return true;
    }
    __device__ __forceinline__ void a_ready(const Unit&) const {}
    __device__ __forceinline__ void done(const Unit&) const {}
};
__device__ __forceinline__ unsigned cvt_pk_bf16(float lo, float hi) { unsigned r; asm volatile("v_cvt_pk_bf16_f32 %0, %1, %2" : "=v"(r) : "v"(lo), "v"(hi)); return r; }

struct EpiBf16 {
    static constexpr bool PERM = true, AFTER_DRAIN = false, PERMA = false;
    bf16_t* O; int ldc;
    __device__ __forceinline__ f32x2 pre(const Unit&, int, int) const { return (f32x2){0.f, 0.f}; }
    __device__ __forceinline__ void operator()(const f32x4 (&acc)[2][2][4][2], const Unit& u, int wr, int wc, int fr_, int fq_, f32x2) const {
        int fr = fr_, fq = fq_; asm volatile("" : "+v"(fr), "+v"(fq));
        const int row0 = u.pm * BM + wr * 64 + fr; const int col0 = u.pn * BM + wc * 32 + 8 * fq;
#pragma unroll
        for (int ai = 0; ai < 2; ++ai)
#pragma unroll
            for (int m = 0; m < 4; ++m) { bf16_t* rowp = O + (size_t)(row0 + ai * HALF + m * 16) * ldc + col0;
#pragma unroll
                for (int bj = 0; bj < 2; ++bj) { const f32x4 v0 = acc[ai][bj][m][0], v1 = acc[ai][bj][m][1];
                    u32x4 w; w.x = cvt_pk_bf16(v0[0], v0[1]); w.y = cvt_pk_bf16(v0[2], v0[3]); w.z = cvt_pk_bf16(v1[0], v1[1]); w.w = cvt_pk_bf16(v1[2], v1[3]);
                    *(u32x4*)(rowp + bj * HALF) = w; } }
    }
};
constexpr int NSLOT_BYTES = 5120;
__device__ __forceinline__ void norm_pre(const float* stat, const float* T, int ldt, int tok_tile, int feat_tile, PG8_LAS unsigned char* nl, int tid_, int slot) {
    int tid = tid_; asm volatile("" : "+v"(tid));
    const int wv = __builtin_amdgcn_readfirstlane(tid >> 6), lane = tid & 63;
    const int mr = (tok_tile % 9 == 0) ? 32 : tok_tile / 9;
    if (wv < 4) __builtin_amdgcn_global_load_lds((const unsigned*)(stat + ((size_t)tok_tile * 256 + wv * 64 + lane) * 4), (PG8_LAS unsigned*)(nl + slot * NSLOT_BYTES + wv * 1024), 16, 0, 0);
    else if (wv == 4) __builtin_amdgcn_global_load_lds((const unsigned*)(T + (size_t)mr * ldt + feat_tile * 256 + lane * 4), (PG8_LAS unsigned*)(nl + slot * NSLOT_BYTES + 4096), 16, 0, 0);
}
__device__ __forceinline__ float norm_rstd(const PG8_LAS float* NL, int tok) { const f32x4 p = *(const PG8_LAS f32x4*)(NL + tok * 4); return __builtin_amdgcn_rsqf(((p.x + p.y) + (p.z + p.w)) * (1.f / 1024.f) + 1e-6f); }
template <bool NORM>
struct EpiRopeQ {
    static constexpr bool PERM = true, AFTER_DRAIN = false, PERMA = false;
    bf16_t* O; const float* RT; const float* stat; const float* T; PG8_LAS unsigned char* nl; int tile0;
    __device__ __forceinline__ f32x2 pre(const Unit& u, int tid, int slot) const { if (NORM) norm_pre(stat, T, 4096, tile0 + u.pm, u.pn, nl, tid, slot); return (f32x2){__int_as_float(slot), 0.f}; }
    __device__ __forceinline__ void operator()(const f32x4 (&acc)[2][2][4][2], const Unit& u, int wr, int wc, int fr_, int fq_, f32x2 wpre) const {
        int fr = fr_, fq = fq_; asm volatile("" : "+v"(fr), "+v"(fq));
        const PG8_LAS float* NL = (const PG8_LAS float*)(nl + __builtin_amdgcn_readfirstlane(__float_as_int(wpre.x)) * NSLOT_BYTES);
        f32x4 tc[2][2];
#pragma unroll
        for (int bj = 0; bj < 2; ++bj)
#pragma unroll
            for (int n = 0; n < 2; ++n) tc[bj][n] = NORM ? *(const PG8_LAS f32x4*)(NL + 1024 + bj * HALF + wc * 32 + 8 * fq + 4 * n) : (f32x4){0.f, 0.f, 0.f, 0.f};
#define RQ_VAL(ai, bj, m, n, rs) (NORM ? acc[ai][bj][m][n] * (rs) + tc[bj][n] : acc[ai][bj][m][n])
        if (u.pn >= 8) {
            const int row0 = u.pm * BM + wr * 64 + fr; const int col0 = u.pn * BM + wc * 32 + 8 * fq;
#pragma unroll
            for (int ai = 0; ai < 2; ++ai)
#pragma unroll
                for (int m = 0; m < 4; ++m) { bf16_t* rowp = O + (size_t)(row0 + ai * HALF + m * 16) * 4096 + col0;
                    const float rs = NORM ? norm_rstd(NL, ai * HALF + wr * 64 + m * 16 + fr) : 1.f;
#pragma unroll
                    for (int bj = 0; bj < 2; ++bj) { const f32x4 v0 = RQ_VAL(ai, bj, m, 0, rs), v1 = RQ_VAL(ai, bj, m, 1, rs);
                        u32x4 w; w.x = cvt_pk_bf16(v0[0], v0[1]); w.y = cvt_pk_bf16(v0[2], v0[3]); w.z = cvt_pk_bf16(v1[0], v1[1]); w.w = cvt_pk_bf16(v1[2], v1[3]);
                        *(u32x4*)(rowp + bj * HALF) = w; } }
            return;
        }
        const int pt = u.pm % 9; const bool lat = pt != 0;
        const int hfj = wc >> 1, m0 = (32 * wc + 8 * fq) & 63;
#pragma unroll
        for (int ai = 0; ai < 2; ++ai)
#pragma unroll
            for (int m = 0; m < 4; ++m) { const int rl = ai * HALF + wr * 64 + m * 16 + fr;
                bf16_t* rowp = O + (size_t)(u.pm * BM + rl) * 4096 + u.pn * BM + 128 * hfj + m0;
                const float rs = NORM ? norm_rstd(NL, rl) : 1.f;
                f32x4 a0 = RQ_VAL(ai, 0, m, 0, rs), a1 = RQ_VAL(ai, 0, m, 1, rs), b0 = RQ_VAL(ai, 1, m, 0, rs), b1 = RQ_VAL(ai, 1, m, 1, rs);
                if (lat) { const int t = (pt - 1) * 256 + rl; const int pos = hfj == 0 ? (t >> 6) : (t & 63);
                    const float* cp = RT + 2 * (pos * 64 + m0);
                    const f32x4 c0 = *(const f32x4*)cp, c1 = *(const f32x4*)(cp + 4), c2 = *(const f32x4*)(cp + 8), c3 = *(const f32x4*)(cp + 12);
                    const f32x4 co0 = (f32x4){c0.x, c0.z, c1.x, c1.z}, si0 = (f32x4){c0.y, c0.w, c1.y, c1.w}, co1 = (f32x4){c2.x, c2.z, c3.x, c3.z}, si1 = (f32x4){c2.y, c2.w, c3.y, c3.w};
                    const f32x4 n0 = a0 * co0 - b0 * si0, n1 = a1 * co1 - b1 * si1; b0 = a0 * si0 + b0 * co0; b1 = a1 * si1 + b1 * co1; a0 = n0; a1 = n1; }
                u32x4 w; w.x = cvt_pk_bf16(a0[0], a0[1]); w.y = cvt_pk_bf16(a0[2], a0[3]); w.z = cvt_pk_bf16(a1[0], a1[1]); w.w = cvt_pk_bf16(a1[2], a1[3]);
                *(u32x4*)rowp = w;
                w.x = cvt_pk_bf16(b0[0], b0[1]); w.y = cvt_pk_bf16(b0[2], b0[3]); w.z = cvt_pk_bf16(b1[0], b1[1]); w.w = cvt_pk_bf16(b1[2], b1[3]);
                *(u32x4*)(rowp + 64) = w; }
#undef RQ_VAL
    }
};
template <bool NORM>
struct EpiRopeKT {
    static constexpr bool PERM = true, AFTER_DRAIN = false, PERMA = false;
    bf16_t* O; const float* RT; int ldc; const float* stat; const float* T; PG8_LAS unsigned char* nl; int tile0;
    __device__ __forceinline__ f32x2 pre(const Unit& u, int tid, int slot) const { if (NORM) norm_pre(stat, T, 3072, tile0 + u.pn, u.pm, nl, tid, slot); return (f32x2){__int_as_float(slot), 0.f}; }
    __device__ __forceinline__ void operator()(const f32x4 (&acc)[2][2][4][2], const Unit& u, int wr, int wc, int fr_, int fq_, f32x2 wpre) const {
        int fr = fr_, fq = fq_; asm volatile("" : "+v"(fr), "+v"(fq));
        const PG8_LAS float* NL = (const PG8_LAS float*)(nl + __builtin_amdgcn_readfirstlane(__float_as_int(wpre.x)) * NSLOT_BYTES);
        f32x4 rc[2][2];
#pragma unroll
        for (int bj = 0; bj < 2; ++bj)
#pragma unroll
            for (int n = 0; n < 2; ++n) { const int cl = bj * HALF + wc * 32 + 8 * fq + 4 * n;
                rc[bj][n] = NORM ? (f32x4){norm_rstd(NL, cl), norm_rstd(NL, cl + 1), norm_rstd(NL, cl + 2), norm_rstd(NL, cl + 3)} : (f32x4){1.f, 1.f, 1.f, 1.f}; }
#define RK_VAL(ai, bj, m, n) (NORM ? acc[ai][bj][m][n] * rc[bj][n] + NL[1024 + (ai) * HALF + wr * 64 + (m) * 16 + fr] : acc[ai][bj][m][n])
        const int col0 = u.pn * BM + wc * 32 + 8 * fq;
        if (u.pm >= 4) {
            const int row0 = u.pm * BM + wr * 64 + fr;
#pragma unroll
            for (int ai = 0; ai < 2; ++ai)
#pragma unroll
                for (int m = 0; m < 4; ++m) { bf16_t* rowp = O + (size_t)(row0 + ai * HALF + m * 16) * ldc + col0;
#pragma unroll
                    for (int bj = 0; bj < 2; ++bj) { const f32x4 v0 = RK_VAL(ai, bj, m, 0), v1 = RK_VAL(ai, bj, m, 1);
                        u32x4 w; w.x = cvt_pk_bf16(v0[0], v0[1]); w.y = cvt_pk_bf16(v0[2], v0[3]); w.z = cvt_pk_bf16(v1[0], v1[1]); w.w = cvt_pk_bf16(v1[2], v1[3]);
                        *(u32x4*)(rowp + bj * HALF) = w; } }
            return;
        }
        const int pt = u.pn % 9; const bool lat = pt != 0;
#pragma unroll
        for (int m = 0; m < 4; ++m) { const int mi = m * 16 + fr;
            bf16_t* rowp = O + (size_t)(u.pm * BM + 128 * wr + mi) * ldc + col0;
#pragma unroll
            for (int bj = 0; bj < 2; ++bj) {
                f32x4 a0 = RK_VAL(0, bj, m, 0), a1 = RK_VAL(0, bj, m, 1), b0 = RK_VAL(1, bj, m, 0), b1 = RK_VAL(1, bj, m, 1);
                if (lat) { const int tb = (pt - 1) * 256 + bj * HALF + wc * 32 + 8 * fq;
                    f32x4 co0, si0, co1, si1;
                    if (wr == 0) { const f32x2 c = *(const f32x2*)(RT + 2 * ((tb >> 6) * 64 + mi)); co0 = (f32x4){c.x, c.x, c.x, c.x}; si0 = (f32x4){c.y, c.y, c.y, c.y}; co1 = co0; si1 = si0; }
                    else { const float* cp = RT + 2 * ((tb & 63) * 64 + mi);
#pragma unroll
                        for (int e = 0; e < 4; ++e) { const f32x2 c = *(const f32x2*)(cp + 128 * e), d = *(const f32x2*)(cp + 128 * (e + 4)); co0[e] = c.x; si0[e] = c.y; co1[e] = d.x; si1[e] = d.y; } }
                    const f32x4 n0 = a0 * co0 - b0 * si0, n1 = a1 * co1 - b1 * si1; b0 = a0 * si0 + b0 * co0; b1 = a1 * si1 + b1 * co1; a0 = n0; a1 = n1; }
                u32x4 w; w.x = cvt_pk_bf16(a0[0], a0[1]); w.y = cvt_pk_bf16(a0[2], a0[3]); w.z = cvt_pk_bf16(a1[0], a1[1]); w.w = cvt_pk_bf16(a1[2], a1[3]);
                *(u32x4*)(rowp + bj * HALF) = w;
                w.x = cvt_pk_bf16(b0[0], b0[1]); w.y = cvt_pk_bf16(b0[2], b0[3]); w.z = cvt_pk_bf16(b1[0], b1[1]); w.w = cvt_pk_bf16(b1[2], b1[3]);
                *(u32x4*)(rowp + (size_t)64 * ldc + bj * HALF) = w; } }
#undef RK_VAL
    }
};
template <bool SWAP>
struct EpiBf16N {
    static constexpr bool PERM = true, AFTER_DRAIN = false, PERMA = false;
    bf16_t* O; int ldc; const float* stat; const float* T; int ldt; PG8_LAS unsigned char* nl; int tile0;
    __device__ __forceinline__ f32x2 pre(const Unit& u, int tid, int slot) const { norm_pre(stat, T, ldt, tile0 + (SWAP ? u.pn : u.pm), SWAP ? u.pm : u.pn, nl, tid, slot); return (f32x2){__int_as_float(slot), 0.f}; }
    __device__ __forceinline__ void operator()(const f32x4 (&acc)[2][2][4][2], const Unit& u, int wr, int wc, int fr_, int fq_, f32x2 wpre) const {
        int fr = fr_, fq = fq_; asm volatile("" : "+v"(fr), "+v"(fq));
        const PG8_LAS float* NL = (const PG8_LAS float*)(nl + __builtin_amdgcn_readfirstlane(__float_as_int(wpre.x)) * NSLOT_BYTES);
        const int row0 = u.pm * BM + wr * 64 + fr; const int col0 = u.pn * BM + wc * 32 + 8 * fq;
        f32x4 cv[2][2];
#pragma unroll
        for (int bj = 0; bj < 2; ++bj)
#pragma unroll
            for (int n = 0; n < 2; ++n) { const int cl = bj * HALF + wc * 32 + 8 * fq + 4 * n;
                if (!SWAP) cv[bj][n] = *(const PG8_LAS f32x4*)(NL + 1024 + cl);
                else cv[bj][n] = (f32x4){norm_rstd(NL, cl), norm_rstd(NL, cl + 1), norm_rstd(NL, cl + 2), norm_rstd(NL, cl + 3)}; }
#pragma unroll
        for (int ai = 0; ai < 2; ++ai)
#pragma unroll
            for (int m = 0; m < 4; ++m) { bf16_t* rowp = O + (size_t)(row0 + ai * HALF + m * 16) * ldc + col0;
                const int rl = ai * HALF + wr * 64 + m * 16 + fr;
                const float rv = SWAP ? NL[1024 + rl] : norm_rstd(NL, rl);
#pragma unroll
                for (int bj = 0; bj < 2; ++bj) { f32x4 v0, v1;
                    if (!SWAP) { v0 = acc[ai][bj][m][0] * rv + cv[bj][0]; v1 = acc[ai][bj][m][1] * rv + cv[bj][1]; }
                    else { v0 = acc[ai][bj][m][0] * cv[bj][0] + rv; v1 = acc[ai][bj][m][1] * cv[bj][1] + rv; }
                    u32x4 w; w.x = cvt_pk_bf16(v0[0], v0[1]); w.y = cvt_pk_bf16(v0[2], v0[3]); w.z = cvt_pk_bf16(v1[0], v1[1]); w.w = cvt_pk_bf16(v1[2], v1[3]);
                    *(u32x4*)(rowp + bj * HALF) = w; } }
    }
};
struct EpiResid {
    static constexpr bool PERM = true, AFTER_DRAIN = false, PERMA = false;
    const void* src_x; const void* src_c; bf16_t* dst_x; bf16_t* dst_c; const float* modl; int goff; int b0; int f32src;
    bf16_t* Hn; bf16_t* Hn2; const float* ngain; const float* nmodl; int nscoff; float* stat; PG8_LAS unsigned char* eb;
    __device__ __forceinline__ f32x2 pre(const Unit&, int, int) const { return (f32x2){0.f, 0.f}; }
    __device__ __forceinline__ void operator()(const f32x4 (&acc)[2][2][4][2], const Unit& u, int wr, int wc, int fr_, int fq_, f32x2) const {
        int fr = fr_, fq = fq_; asm volatile("" : "+v"(fr), "+v"(fq));
        const int bl = u.pm / 9, pt = u.pm % 9, b = b0 + bl;
        const float* gate = modl + (size_t)(pt == 0 ? 32 : b) * 6144 + goff;
        const size_t rbase = pt == 0 ? (size_t)b * 256 : (size_t)b * 2048 + (size_t)(pt - 1) * 256;
        const void* s = pt == 0 ? src_c : src_x; bf16_t* d = pt == 0 ? dst_c : dst_x;
        const int r0 = wr * 64 + fr, col0 = u.pn * BM + wc * 32 + 8 * fq;
        f32x4 gv[2][2], cf[2][2];
        const bool dn = Hn != nullptr;
#pragma unroll
        for (int bj = 0; bj < 2; ++bj)
#pragma unroll
            for (int n = 0; n < 2; ++n) { gv[bj][n] = *(const f32x4*)(gate + col0 + bj * HALF + 4 * n);
                if (dn) { const float* nsc = nmodl + (size_t)(pt == 0 ? 32 : b) * 6144 + nscoff; cf[bj][n] = *(const f32x4*)(ngain + col0 + bj * HALF + 4 * n) * (*(const f32x4*)(nsc + col0 + bj * HALF + 4 * n) + 1.f); } }
        float ss[2][4];
#pragma unroll
        for (int ai = 0; ai < 2; ++ai)
#pragma unroll
            for (int m = 0; m < 4; ++m) ss[ai][m] = 0.f;
#pragma unroll
        for (int ai = 0; ai < 2; ++ai)
#pragma unroll
            for (int m = 0; m < 4; ++m) { const size_t off = (rbase + (size_t)(r0 + ai * HALF + m * 16)) * 1024 + col0;
#pragma unroll
                for (int bj = 0; bj < 2; ++bj) { f32x4 x0, x1;
                    if (f32src) { const float* sf = (const float*)s + off + bj * HALF; x0 = *(const f32x4*)sf; x1 = *(const f32x4*)(sf + 4); }
                    else { const u32x4 xv = *(const u32x4*)((const bf16_t*)s + off + bj * HALF);
                        x0 = (f32x4){__builtin_bit_cast(float, xv.x << 16), __builtin_bit_cast(float, xv.x & 0xffff0000u), __builtin_bit_cast(float, xv.y << 16), __builtin_bit_cast(float, xv.y & 0xffff0000u)};
                        x1 = (f32x4){__builtin_bit_cast(float, xv.z << 16), __builtin_bit_cast(float, xv.z & 0xffff0000u), __builtin_bit_cast(float, xv.w << 16), __builtin_bit_cast(float, xv.w & 0xffff0000u)}; }
                    const f32x4 o0 = x0 + gv[bj][0] * acc[ai][bj][m][0], o1 = x1 + gv[bj][1] * acc[ai][bj][m][1];
                    u32x4 w; w.x = cvt_pk_bf16(o0[0], o0[1]); w.y = cvt_pk_bf16(o0[2], o0[3]); w.z = cvt_pk_bf16(o1[0], o1[1]); w.w = cvt_pk_bf16(o1[2], o1[3]);
                    *(u32x4*)(d + off + bj * HALF) = w;
                    if (dn) {
                        const f32x4 y0 = (f32x4){__builtin_bit_cast(float, w.x << 16), __builtin_bit_cast(float, w.x & 0xffff0000u), __builtin_bit_cast(float, w.y << 16), __builtin_bit_cast(float, w.y & 0xffff0000u)};
                        const f32x4 y1 = (f32x4){__builtin_bit_cast(float, w.z << 16), __builtin_bit_cast(float, w.z & 0xffff0000u), __builtin_bit_cast(float, w.w << 16), __builtin_bit_cast(float, w.w & 0xffff0000u)};
                        ss[ai][m] += ((y0[0] * y0[0] + y0[1] * y0[1]) + (y0[2] * y0[2] + y0[3] * y0[3])) + ((y1[0] * y1[0] + y1[1] * y1[1]) + (y1[2] * y1[2] + y1[3] * y1[3]));
                        const f32x4 h0 = y0 * cf[bj][0], h1 = y1 * cf[bj][1];
                        u32x4 hw; hw.x = cvt_pk_bf16(h0[0], h0[1]); hw.y = cvt_pk_bf16(h0[2], h0[3]); hw.z = cvt_pk_bf16(h1[0], h1[1]); hw.w = cvt_pk_bf16(h1[2], h1[3]);
                        *(u32x4*)((u.pm < 144 ? Hn : Hn2) + ((size_t)u.pm * BM + (size_t)(r0 + ai * HALF + m * 16)) * 1024 + col0 + bj * HALF) = hw; }
                } }
        if (dn) {
            PG8_LAS float* ST = (PG8_LAS float*)eb;
            const int ln = fr + 16 * fq;
#pragma unroll
            for (int ai = 0; ai < 2; ++ai)
#pragma unroll
                for (int m = 0; m < 4; ++m) { float v = ss[ai][m];
                    v += __builtin_bit_cast(float, __builtin_amdgcn_ds_bpermute((ln ^ 16) << 2, __builtin_bit_cast(int, v)));
                    v += __builtin_bit_cast(float, __builtin_amdgcn_ds_bpermute((ln ^ 32) << 2, __builtin_bit_cast(int, v)));
                    if (fq == 0) ST[(ai * HALF + r0 + m * 16) * 4 + wc] = v; }
            asm volatile("s_waitcnt lgkmcnt(0)" ::: "memory"); __builtin_amdgcn_s_barrier(); asm volatile("" ::: "memory");
            const int t = (wr * 4 + wc) * 64 + ln;
            if (t < 256) { const f32x4 p = *(const PG8_LAS f32x4*)(ST + t * 4); stat[((size_t)u.pm * BM + t) * 4 + u.pn] = (p.x + p.y) + (p.z + p.w); }
        }
    }
};

__device__ __forceinline__ float dpp_prev(float x) { return __int_as_float(__builtin_amdgcn_update_dpp(__float_as_int(x), __float_as_int(x), 0x121, 0xf, 0xf, false)); }
__device__ __forceinline__ float dpp_next(float x) { return __int_as_float(__builtin_amdgcn_update_dpp(__float_as_int(x), __float_as_int(x), 0x12F, 0xf, 0xf, false)); }
__device__ __forceinline__ f32x4 rot_prev(f32x4 v) { f32x4 r; r.x = dpp_prev(v.x); r.y = dpp_prev(v.y); r.z = dpp_prev(v.z); r.w = dpp_prev(v.w); return r; }
__device__ __forceinline__ f32x4 rot_next(f32x4 v) { f32x4 r; r.x = dpp_next(v.x); r.y = dpp_next(v.y); r.z = dpp_next(v.z); r.w = dpp_next(v.w); return r; }
struct EpiConvGate {
    static constexpr bool PERM = true, AFTER_DRAIN = false, PERMA = true;
    bf16_t* ACT; bf16_t* EDGE; const float* cw; const float* cb; PG8_LAS unsigned char* eb; PG8_LAS unsigned char* wl; const float* stat; const float* T; PG8_LAS unsigned char* nl;
    __device__ __forceinline__ f32x2 pre(const Unit& u, int tid, int slot) const { const int wv = __builtin_amdgcn_readfirstlane(tid >> 6), lane = tid & 63;
#pragma unroll
        for (int i = 0; i < 2; ++i) { const int idx = (2 * wv + i) * 64 + lane, k = idx >> 8, j = idx & 255, bj = j >> 7, jj = j & 127;
            const float* p = (k < 3 ? cw + k * 5632 : cb) + bj * 2816 + u.pn * 128 + jj;
            __builtin_amdgcn_global_load_lds((const unsigned*)p, (PG8_LAS unsigned*)(wl + slot * 4096 + (2 * wv + i) * 256), 4, 0, 0); }
        norm_pre(stat, T, 5632, u.pm, u.pn, nl, tid, slot);
        return (f32x2){__int_as_float(slot), 0.f}; }
    __device__ __forceinline__ void operator()(const f32x4 (&acc)[2][2][4][2], const Unit& u, int wr, int wc, int fr_, int fq_, f32x2 wpre) const {
        int fr = fr_, fq = fq_; asm volatile("" : "+v"(fr), "+v"(fq));
        const int slot = __builtin_amdgcn_readfirstlane(__float_as_int(wpre.x));
        PG8_LAS float* E = (PG8_LAS float*)eb; PG8_LAS float* WL = (PG8_LAS float*)(wl + slot * 4096); const PG8_LAS float* NL = (const PG8_LAS float*)(nl + slot * NSLOT_BYTES);
#define EB_IDX(wc_, wr_, ai_, wh_) (((((wc_) * 2 + (wr_)) * 2 + (ai_)) * 2 + (wh_)) * 64 + fq * 16)
        if (fr == 0) {
#pragma unroll
            for (int ai = 0; ai < 2; ++ai) { const float r = norm_rstd(NL, ai * HALF + wr * 64);
#pragma unroll
                for (int bj = 0; bj < 2; ++bj)
#pragma unroll
                    for (int n = 0; n < 2; ++n) *(PG8_LAS f32x4*)(E + EB_IDX(wc, wr, ai, 0) + bj * 8 + n * 4) = acc[ai][bj][0][n] * r; }
        }
        if (fr == 15) {
#pragma unroll
            for (int ai = 0; ai < 2; ++ai) { const float r = norm_rstd(NL, ai * HALF + wr * 64 + 63);
#pragma unroll
                for (int bj = 0; bj < 2; ++bj)
#pragma unroll
                    for (int n = 0; n < 2; ++n) *(PG8_LAS f32x4*)(E + EB_IDX(wc, wr, ai, 1) + bj * 8 + n * 4) = acc[ai][bj][3][n] * r; }
        }
        asm volatile("s_waitcnt lgkmcnt(0)" ::: "memory"); __builtin_amdgcn_s_barrier(); asm volatile("" ::: "memory");
        const f32x4 zero4 = (f32x4){0.f, 0.f, 0.f, 0.f};
        const int c8 = u.pn * 128 + wc * 32 + 8 * fq;
#pragma unroll
        for (int ai = 0; ai < 2; ++ai) {
            float rs[4];
#pragma unroll
            for (int m = 0; m < 4; ++m) rs[m] = norm_rstd(NL, ai * HALF + wr * 64 + 4 * fr + m);
            u32x2 actp[2][4];
#pragma unroll
            for (int n = 0; n < 2; ++n) {
                const int jc = wc * 32 + 8 * fq + 4 * n;
                f32x4 gt[4];
#pragma unroll
                for (int bj = 0; bj < 2; ++bj) {
                    f32x4 w[3];
#pragma unroll
                    for (int k = 0; k < 3; ++k) w[k] = *(const PG8_LAS f32x4*)(WL + k * 256 + bj * 128 + jc);
                    const f32x4 tq = *(const PG8_LAS f32x4*)(NL + 1024 + bj * 128 + jc);
                    const f32x4 bb = *(const PG8_LAS f32x4*)(WL + 3 * 256 + bj * 128 + jc) + tq * ((w[0] + w[1]) + w[2]);
                    f32x4 ep = zero4 - tq, en = zero4 - tq;
                    if (wr == 1) ep = *(const PG8_LAS f32x4*)(E + EB_IDX(wc, 0, ai, 1) + bj * 8 + n * 4);
                    else if (ai == 1) ep = *(const PG8_LAS f32x4*)(E + EB_IDX(wc, 1, 0, 1) + bj * 8 + n * 4);
                    if (wr == 0) en = *(const PG8_LAS f32x4*)(E + EB_IDX(wc, 1, ai, 0) + bj * 8 + n * 4);
                    else if (ai == 0) en = *(const PG8_LAS f32x4*)(E + EB_IDX(wc, 0, 1, 0) + bj * 8 + n * 4);
                    f32x4 a4[4];
#pragma unroll
                    for (int m = 0; m < 4; ++m) a4[m] = acc[ai][bj][m][n] * rs[m];
                    f32x4 pv0 = rot_prev(a4[3]), nv3 = rot_next(a4[0]);
                    pv0 = fr == 0 ? ep : pv0; nv3 = fr == 15 ? en : nv3;
#pragma unroll
                    for (int m = 0; m < 4; ++m) {
                        const f32x4 pv = m == 0 ? pv0 : a4[m == 0 ? 0 : m - 1];
                        const f32x4 nv = m == 3 ? nv3 : a4[m == 3 ? 3 : m + 1];
                        const f32x4 uv = bb + w[0] * pv + w[1] * a4[m] + w[2] * nv;
                        if (bj == 0) {
#pragma unroll
                            for (int e = 0; e < 4; ++e) gt[m][e] = uv[e] * __builtin_amdgcn_rcpf(1.f + __builtin_amdgcn_exp2f(uv[e] * -1.4426950408889634f));
                        } else { const f32x4 o = gt[m] * uv; actp[n][m].x = cvt_pk_bf16(o[0], o[1]); actp[n][m].y = cvt_pk_bf16(o[2], o[3]); }
                    }
                }
            }
#pragma unroll
            for (int m = 0; m < 4; ++m) { const u32x4 pk = (u32x4){actp[0][m].x, actp[0][m].y, actp[1][m].x, actp[1][m].y};
                *(u32x4*)(ACT + (size_t)(u.pm * BM + ai * HALF + wr * 64 + 4 * fr + m) * 2816 + c8) = pk; }
        }
        if ((wr == 0 && fr == 0) || (wr == 1 && fr == 15)) {
#pragma unroll
            for (int k = 0; k < 2; ++k) {
                const int rl = wr == 0 ? k : 254 + k; const float r = norm_rstd(NL, rl);
#pragma unroll
                for (int bj = 0; bj < 2; ++bj) { const int jc = bj * 128 + wc * 32 + 8 * fq;
                    const f32x4 q0 = wr == 0 ? acc[0][bj][k][0] : acc[1][bj][2 + k][0], q1 = wr == 0 ? acc[0][bj][k][1] : acc[1][bj][2 + k][1];
                    const f32x4 v0 = q0 * r + *(const PG8_LAS f32x4*)(NL + 1024 + jc), v1 = q1 * r + *(const PG8_LAS f32x4*)(NL + 1024 + jc + 4);
                    u32x4 pk; pk.x = cvt_pk_bf16(v0[0], v0[1]); pk.y = cvt_pk_bf16(v0[2], v0[3]); pk.z = cvt_pk_bf16(v1[0], v1[1]); pk.w = cvt_pk_bf16(v1[2], v1[3]);
                    *(u32x4*)(EDGE + ((size_t)u.pm * 4 + (wr == 0 ? k : 2 + k)) * 5632 + bj * 2816 + c8) = pk; }
            }
        }
#undef EB_IDX
    }
};

template <class Epi, class Sched, bool ALIGN_EPI = false>
__device__ __forceinline__ void gemm_phase(PG8_LAS unsigned char* lds, const Gemm g, const Sched& S, const Epi& E, int wave_id) {
    int tid_ = wave_id * 64 + lane_id(); asm volatile("" : "+v"(tid_)); const int tid = tid_, wid = __builtin_amdgcn_readfirstlane(tid >> 6), lane = tid & 63, wr = wid >> 2, wc = wid & 3, fr = lane & 15, fq = lane >> 4;
    const int K = g.K, nt = K / BK;
    unsigned voffA[2], voffB[2];
#pragma unroll
    for (int i = 0; i < 2; ++i) { int R, C; stage_rc(tid * 16 + i * 8192, R, C); const int Rb = Epi::PERM ? ((R & ~31) + perm32(R & 31)) : R;
        const int Ra = Epi::PERMA ? ((R & ~63) + 4 * (R & 15) + ((R >> 4) & 3)) : R;
        voffA[i] = (unsigned)(Ra * K + C) * 2u; voffB[i] = (unsigned)(Rb * K + C) * 2u; }
    const size_t kstep = (size_t)(BK * 2);
    const size_t hstep = (size_t)HALF * K * 2;
    const size_t tstep = 2 * hstep;
    const unsigned ldsw = (unsigned)wid * 1024u;
    const int aoff = lds_byte(wr * 64 + fr, fq * 8), boff = lds_byte(wc * 32 + fr, fq * 8);
#define PG8_SA(b, h) (((b) * 2 + (h)) * HTB)
#define PG8_SB(b, h) ((4 + (b) * 2 + (h)) * HTB)
#define PG8_STAGE(bufoff, gbase, voff) do { _Pragma("unroll") for (int _i = 0; _i < 2; ++_i) \
        __builtin_amdgcn_global_load_lds((const unsigned*)((const char*)(gbase) + (voff)[_i]), (PG8_LAS unsigned*)(lds + (bufoff) + ldsw + _i * 8192), 16, 0, 0); } while (0)
#define PG8_LDA(dst, b, h) do { _Pragma("unroll") for (int m = 0; m < 4; ++m) _Pragma("unroll") for (int k = 0; k < 2; ++k) dst[m][k] = *(const PG8_LAS bf16x8*)(lds + PG8_SA(b, h) + aoff + m * 2048 + k * 1024); } while (0)
#define PG8_LDB(dst, b, h) do { _Pragma("unroll") for (int n = 0; n < 2; ++n) _Pragma("unroll") for (int k = 0; k < 2; ++k) dst[n][k] = *(const PG8_LAS bf16x8*)(lds + PG8_SB(b, h) + boff + n * 2048 + k * 1024); } while (0)
#define PG8_MMA(ai, bj, At, Bt) do { __builtin_amdgcn_s_setprio(1); _Pragma("unroll") for (int m = 0; m < 4; ++m) _Pragma("unroll") for (int n = 0; n < 2; ++n) _Pragma("unroll") for (int k = 0; k < 2; ++k) \
        acc[ai][bj][m][n] = __builtin_amdgcn_mfma_f32_16x16x32_bf16(Bt[n][k], At[m][k], acc[ai][bj][m][n], 0, 0, 0); __builtin_amdgcn_s_setprio(0); } while (0)
#define PG8_WAIT_V(n) asm volatile("s_waitcnt vmcnt(" #n ")" ::: "memory")
#define PG8_WAIT_L(n) asm volatile("s_waitcnt lgkmcnt(" #n ")" ::: "memory")
#define PG8_BAR __builtin_amdgcn_s_barrier()
#define PG8_SCHED __builtin_amdgcn_sched_barrier(0)
    Unit cur, nxt; int ui = 0;
    if (!S.next(0, cur)) return;
    f32x4 acc[2][2][4][2];
#pragma unroll
    for (int a = 0; a < 2; ++a)
#pragma unroll
        for (int b = 0; b < 2; ++b)
#pragma unroll
            for (int m = 0; m < 4; ++m)
#pragma unroll
                for (int n = 0; n < 2; ++n) acc[a][b][m][n] = (f32x4){0.f, 0.f, 0.f, 0.f};
    bf16x8 At[4][2], B0[2][2], B1[2][2];
    const char* cA = (const char*)g.A + (size_t)cur.pm * tstep; const char* cB = (const char*)g.Bt + (size_t)cur.pn * tstep;
    S.a_ready(cur);
    (void)E.pre(cur, tid, 0);
    {
        PG8_STAGE(PG8_SB(0, 0), cB, voffB); PG8_STAGE(PG8_SB(0, 1), cB + hstep, voffB); PG8_STAGE(PG8_SA(0, 0), cA, voffA); PG8_STAGE(PG8_SA(0, 1), cA + hstep, voffA);
        if (wr == 1) PG8_BAR;
        PG8_WAIT_V(2); PG8_BAR;
        PG8_STAGE(PG8_SB(1, 0), cB + kstep, voffB); PG8_STAGE(PG8_SA(1, 0), cA + kstep, voffA); PG8_STAGE(PG8_SB(1, 1), cB + hstep + kstep, voffB);
        PG8_WAIT_V(6); PG8_BAR;
    }
    for (;;) {
        const bool has_next = S.next(ui + 1, nxt);
        const char* nA = has_next ? (const char*)g.A + (size_t)nxt.pm * tstep : cA; const char* nB = has_next ? (const char*)g.Bt + (size_t)nxt.pn * tstep : cB;
        for (int t = 0; t < nt; t += 2) {
            const bool last = (t == nt - 2);
            const char* a1 = cA + (size_t)(t + 1) * kstep;
            const char* a2 = last ? nA : cA + (size_t)(t + 2) * kstep; const char* b2 = last ? nB : cB + (size_t)(t + 2) * kstep;
            const char* a3 = a2 + kstep; const char* b3 = b2 + kstep;
            if (last && has_next) S.a_ready(nxt);
            PG8_LDB(B0, 0, 0); PG8_LDB(B1, 0, 1); PG8_SCHED; PG8_LDA(At, 0, 0); PG8_STAGE(PG8_SA(1, 1), a1 + hstep, voffA);
            PG8_WAIT_V(8); PG8_WAIT_L(0); PG8_BAR; PG8_MMA(0, 0, At, B0); PG8_MMA(0, 1, At, B1); PG8_BAR; PG8_SCHED;
            PG8_LDA(At, 0, 1); PG8_STAGE(PG8_SB(0, 0), b2, voffB); PG8_STAGE(PG8_SB(0, 1), b2 + hstep, voffB); PG8_STAGE(PG8_SA(0, 0), a2, voffA);
            PG8_WAIT_V(8); PG8_WAIT_L(0); PG8_BAR; PG8_MMA(1, 0, At, B0); PG8_MMA(1, 1, At, B1); PG8_BAR; PG8_SCHED;
            PG8_LDB(B0, 1, 0); PG8_LDB(B1, 1, 1); PG8_SCHED; PG8_LDA(At, 1, 0); PG8_STAGE(PG8_SA(0, 1), a2 + hstep, voffA);
            PG8_WAIT_V(8); PG8_WAIT_L(0); PG8_BAR; PG8_MMA(0, 0, At, B0); PG8_MMA(0, 1, At, B1); PG8_BAR; PG8_SCHED;
            PG8_LDA(At, 1, 1); PG8_STAGE(PG8_SB(1, 0), b3, voffB); PG8_STAGE(PG8_SB(1, 1), b3 + hstep, voffB); PG8_STAGE(PG8_SA(1, 0), a3, voffA);
            PG8_WAIT_V(8); PG8_WAIT_L(0); PG8_BAR; PG8_MMA(1, 0, At, B0); PG8_MMA(1, 1, At, B1); PG8_BAR; PG8_SCHED;
        }
        if constexpr (ALIGN_EPI) { if (wr == 0) PG8_BAR; }
        { const int l2 = lane_id(); E(acc, cur, wr, wc, l2 & 15, l2 >> 4, (f32x2){__int_as_float(ui & 1), 0.f}); } S.done(cur);
        if (!has_next) break;
        (void)E.pre(nxt, wave_id * 64 + lane_id(), (ui + 1) & 1);
#pragma unroll
        for (int a = 0; a < 2; ++a)
#pragma unroll
            for (int b = 0; b < 2; ++b)
#pragma unroll
                for (int m = 0; m < 4; ++m)
#pragma unroll
                    for (int n = 0; n < 2; ++n) acc[a][b][m][n] = (f32x4){0.f, 0.f, 0.f, 0.f};
        cur = nxt; cA = nA; cB = nB; ++ui;
        if constexpr (ALIGN_EPI) { if (wr == 1) PG8_BAR; }
    }
    PG8_WAIT_V(0);
    if constexpr (!ALIGN_EPI) { if (wr == 0) PG8_BAR; }
    PG8_BAR;
#undef PG8_SA
#undef PG8_SB
#undef PG8_STAGE
#undef PG8_LDA
#undef PG8_LDB
#undef PG8_MMA
#undef PG8_WAIT_V
#undef PG8_WAIT_L
#undef PG8_BAR
#undef PG8_SCHED
}
}

constexpr int D = 1024, NBATCH = 32, SEQ = 2048, CTXL = 256, PT = 2304, NB = 16, NG = 2, TG = NB * PT;
constexpr int FFN = 2816, FFN2 = 5632, LW = 1280, NMOD = 6144;
constexpr float EPS = 1e-6f;
constexpr int NWAVES = 8, NTHR = 512;

constexpr size_t MiB = 1u << 20;
constexpr size_t WS_CTL = 0, CTL_ZERO_BYTES = 1 * MiB;
constexpr size_t WS_MOD = 1 * MiB;
constexpr size_t WS_ROPE = 5 * MiB;
constexpr size_t WS_CTX = 8 * MiB;
constexpr size_t WS_T = 24 * MiB;
constexpr size_t WS_STAT = 30 * MiB;
constexpr int TB_FFN = 0, TB_FFN_SZ = 33 * 5632, TB_LRU = 4 * TB_FFN_SZ, TB_NAQK = TB_LRU + 33 * 2560, TB_NAV = TB_NAQK + 33 * 2048, TB_RETA = TB_NAV + 33 * 1024, TB_RETB = TB_RETA + 33 * 4096;
constexpr size_t WS_W = 40 * MiB;
constexpr size_t WS_ACT = 160 * MiB;
constexpr size_t WS_END = 1024 * MiB;
constexpr size_t W_RET = 0;
constexpr size_t W_FFN = 36 * MiB;
constexpr size_t W_LRU_IN = 102 * MiB, W_LRU_OUT = 107 * MiB, W_LRU_G = 109 * MiB + 512 * 1024;
constexpr size_t W_NA_QK = 112 * MiB, W_NA_V = 116 * MiB, W_NA_O = 118 * MiB;
constexpr size_t A_H = 0;
constexpr size_t A_QKG = 72 * MiB, A_KVT = 360 * MiB, A_Y = 576 * MiB;
constexpr size_t A_ACT = 144 * MiB, A_EDGE = 540 * MiB;
constexpr size_t A_YX = 144 * MiB, A_LA = 324 * MiB, A_U = 504 * MiB, A_A3 = 684 * MiB;
constexpr size_t A_QK = 144 * MiB, A_VT = 288 * MiB, A_O = 360 * MiB;
constexpr int CW_BAR = 4096, CW_DBG = 8192;

constexpr int RING_BYTES = 139264;
constexpr int MISC_OFF = RING_BYTES;
constexpr int NSLOT_OFF = MISC_OFF + 512 + 8192;
constexpr int LDS_BYTES = NSLOT_OFF + 2 * 5120;

#define RLX_AGENT __ATOMIC_RELAXED, __HIP_MEMORY_SCOPE_AGENT
__device__ __forceinline__ unsigned f2bf(float f) { unsigned u = __builtin_bit_cast(unsigned, f); return (u + 0x7fffu + ((u >> 16) & 1u)) >> 16; }
__device__ __forceinline__ unsigned pk2(float lo, float hi) { unsigned r; asm("v_cvt_pk_bf16_f32 %0, %1, %2" : "=v"(r) : "v"(lo), "v"(hi)); return r; }
__device__ __forceinline__ float bf2f(unsigned short h) { return __builtin_bit_cast(float, (unsigned)h << 16); }
__device__ __forceinline__ float bflo(unsigned w) { return __builtin_bit_cast(float, w << 16); }
__device__ __forceinline__ float bfhi(unsigned w) { return __builtin_bit_cast(float, w & 0xffff0000u); }
__device__ __forceinline__ float silu_f(float x) { return x * __builtin_amdgcn_rcpf(1.f + __expf(-x)); }
__device__ __forceinline__ float sigmoid_f(float x) { return __builtin_amdgcn_rcpf(1.f + __expf(-x)); }
__device__ __forceinline__ float lane_get(float v, int src) { return __builtin_bit_cast(float, __builtin_amdgcn_ds_bpermute(src << 2, __builtin_bit_cast(int, v))); }
__device__ __forceinline__ float wave_sum(float v, int lane) {
#pragma unroll
    for (int o = 1; o < 64; o <<= 1) v += lane_get(v, lane ^ o);
    return v;
}

#define XB_TMO      128
#define XB_XCNT(j)  (256  + 64 * (j))
#define XB_XSUB(j)  (1280 + 64 * (j))
#define XB_XGEN(j)  (2304 + 64 * (j))
#define XB_TOP      3328
#define XB_TOPGEN   3392
#define XCD_BAR_WORDS 3456
#define XB_SPIN_CAP (1u << 18)
__device__ __forceinline__ unsigned xb_ld(unsigned* p)              { return __hip_atomic_load(p, __ATOMIC_RELAXED, __HIP_MEMORY_SCOPE_AGENT); }
__device__ __forceinline__ unsigned xb_add(unsigned* p, unsigned v) { return __hip_atomic_fetch_add(p, v, __ATOMIC_RELAXED, __HIP_MEMORY_SCOPE_AGENT); }
__device__ __forceinline__ unsigned xb_xcc_id() { return (unsigned)__builtin_amdgcn_s_getreg((3 << 11) | 20) & 0xFu; }
#define XB_SPIN(cond, bar) do { unsigned _sp = 0; while (cond) { __builtin_amdgcn_s_sleep(1); \
    if ((++_sp & 255u) == 0u) { if (xb_ld(&(bar)[XB_TMO])) break; if (_sp > XB_SPIN_CAP) { atomicAdd(&(bar)[XB_TMO], 1u); break; } } } } while (0)
struct XcdBarrier { unsigned* bar; unsigned x; volatile LAS unsigned* st; bool t0; };
__device__ __forceinline__ XcdBarrier xcd_barrier_post(unsigned* bar, volatile LAS unsigned* st) {
    XcdBarrier b; b.bar = bar; b.x = xb_xcc_id(); b.st = st; b.t0 = threadIdx.x == 0;
    if (threadIdx.x == 0) (void)xb_add(&bar[XB_XCNT(b.x)], 1u);
    return b;
}
__device__ __forceinline__ void xcd_barrier_complete(unsigned* bar, unsigned x, unsigned& nloc, unsigned& nx) {
    const unsigned G = gridDim.x * gridDim.y * gridDim.z;
    unsigned sum, cnt, mine, sp = 0u;
    for (;;) {
        sum = 0u; cnt = 0u; mine = 0u;
#pragma unroll
        for (unsigned j = 0; j < 16; ++j) { const unsigned c = xb_ld(&bar[XB_XCNT(j)]); sum += c; cnt += (c > 0u) ? 1u : 0u; mine = (j == x) ? c : mine; }
        if (sum == G) break;
        __builtin_amdgcn_s_sleep(1);
        if ((++sp & 255u) == 0u) { if (xb_ld(&bar[XB_TMO])) break; if (sp > XB_SPIN_CAP) { atomicAdd(&bar[XB_TMO], 1u); break; } }
    }
    nloc = mine > 0u ? mine : 1u; nx = cnt > 0u ? cnt : 1u;
}
__device__ __forceinline__ void xcd_barrier(const XcdBarrier& b) {
    asm volatile("s_waitcnt vmcnt(0)" ::: "memory");
    __syncthreads();
    if (b.t0) {
        unsigned* bar = b.bar;
        __builtin_amdgcn_s_waitcnt(0);
        unsigned nloc = b.st[0], nx = b.st[1];
        if (nloc == 0u) { xcd_barrier_complete(bar, b.x, nloc, nx); b.st[0] = nloc; b.st[1] = nx; }
        const unsigned old = xb_add(&bar[XB_XSUB(b.x)], 1u);
        const unsigned gen = old / nloc;
        if (old + 1u == (gen + 1u) * nloc) {
            __builtin_amdgcn_fence(__ATOMIC_RELEASE, "agent");
            asm volatile("s_waitcnt vmcnt(0)" ::: "memory");
            const unsigned og = xb_add(&bar[XB_TOP], 1u);
            const unsigned tg = og / nx;
            if (og + 1u == (tg + 1u) * nx) xb_add(&bar[XB_TOPGEN], 1u);
            else XB_SPIN(xb_ld(&bar[XB_TOPGEN]) == tg, bar);
            __builtin_amdgcn_fence(__ATOMIC_ACQUIRE, "agent");
            xb_add(&bar[XB_XGEN(b.x)], 1u);
            asm volatile("s_waitcnt vmcnt(0)" ::: "memory");
        } else {
            XB_SPIN(xb_ld(&bar[XB_XGEN(b.x)]) == gen, bar);
            __builtin_amdgcn_fence(__ATOMIC_ACQUIRE, "agent");
            asm volatile("s_waitcnt vmcnt(0)" ::: "memory");
        }
    }
    __syncthreads();
}

struct Args { const float* in[27]; float* out; unsigned char* ws; };
enum { I_X = 0, I_C, I_CTX, I_CCTX, I_ADAW, I_ADAB, I_NMIX, I_NFFN, I_UP, I_FCW, I_FCB, I_DOWN, I_RWIN, I_RDEC, I_RGN, I_RWOUT,
       I_LWIN, I_LCW, I_LCB, I_LGW, I_LGB, I_LLAM, I_LWOUT, I_NQKV, I_NRPB, I_NWOUT, I_FNORM };

typedef const __attribute__((address_space(4))) Args* CArgsP;
__device__ __forceinline__ CArgsP fresh_args() { CArgsP p = (CArgsP)__builtin_amdgcn_kernarg_segment_ptr(); asm volatile("" : "+s"(p)); return p; }
#define AIN(i) (fresh_args()->in[(i)])
#define AOUT (fresh_args()->out)
#define AWS (fresh_args()->ws)
struct Frame {
    LAS unsigned char* lds;
    int tid, lane, wave, vcu, G, gw, NGW;
    unsigned char* ws;
};

__device__ __forceinline__ Frame refresh(const Frame& F0) {
    Frame F = F0; int t = F0.wave * 64 + lane_id(); asm volatile("" : "+v"(t));
    F.tid = t; F.lane = t & 63; F.gw = F.vcu * NWAVES + F.wave;
    return F;
}
__device__ __forceinline__ void transpose_item(const float* W, int K, int ldn, int c0, int ncols, bf16* WT, int row_off, float scale, LAS float* scr, int item, int lane) {
    const int nblk = ncols / 32, kb = item / nblk, nb = item % nblk, k0 = 64 * kb, n0 = 32 * nb;
    if (row_off <= -1000000) { const int dim = n0 & 255; row_off = (-1000000 - row_off) + (n0 & ~255) + 128 * ((dim & 127) >> 6) + 64 * (dim >> 7) + (dim & 63) - n0; }
    else if (row_off < 0) { const int cc = c0 + n0; row_off = (cc < 2816 ? 256 * (cc / 128) + (cc % 128) : 256 * ((cc - 2816) / 128) + 128 + ((cc - 2816) % 128)) - n0; }
    {
        f32x4 v[8];
#pragma unroll
        for (int i = 0; i < 8; ++i) v[i] = *(const f32x4*)(W + (size_t)(k0 + 8 * i + (lane >> 3)) * ldn + c0 + n0 + 4 * (lane & 7));
#pragma unroll
        for (int i = 0; i < 8; ++i) { LAS float* d = scr + (8 * i + (lane >> 3)) * 33 + 4 * (lane & 7); d[0] = v[i].x * scale; d[1] = v[i].y * scale; d[2] = v[i].z * scale; d[3] = v[i].w * scale; }
    }
    asm volatile("s_waitcnt lgkmcnt(0)" ::: "memory");
    const int c = lane & 7;
#pragma unroll
    for (int j = 0; j < 4; ++j) { const int n = (lane >> 3) + 8 * j; const LAS float* s = scr + (8 * c) * 33 + n;
        u32x4 o; o.x = pk2(s[0 * 33], s[1 * 33]); o.y = pk2(s[2 * 33], s[3 * 33]); o.z = pk2(s[4 * 33], s[5 * 33]); o.w = pk2(s[6 * 33], s[7 * 33]);
        *(u32x4*)(WT + (size_t)(row_off + n0 + n) * K + k0 + 8 * c) = o; }
    asm volatile("s_waitcnt lgkmcnt(0)" ::: "memory");
}

__device__ __forceinline__ void prologue(const Frame& F0) {
    const Frame F = refresh(F0);
    bf16* Wb = (bf16*)(F.ws + WS_W);
    if (F.vcu < 192) {
        const int l = F.vcu / 48, n0 = (F.vcu % 48) * 128;
        LAS float* s = (LAS float*)F.lds;
        for (int idx = F.tid; idx < 33 * 1024; idx += NTHR) { const int bb = idx >> 10, k = idx & 1023; const float v = bb < 32 ? AIN(I_C)[bb * 1024 + k] : AIN(I_CCTX)[k]; s[idx] = silu_f(v); }
        __syncthreads();
        const int cc = F.tid & 127, kq = F.tid >> 7;
        float acc[33];
#pragma unroll
        for (int bb = 0; bb < 33; ++bb) acc[bb] = 0.f;
        const float* wp = AIN(I_ADAW) + ((size_t)l * 1024 + kq * 256) * NMOD + n0 + cc;
        for (int k = 0; k < 256; k += 4) {
            const float w0 = wp[(size_t)(k + 0) * NMOD], w1 = wp[(size_t)(k + 1) * NMOD], w2 = wp[(size_t)(k + 2) * NMOD], w3 = wp[(size_t)(k + 3) * NMOD];
#pragma unroll
            for (int bb = 0; bb < 33; ++bb) { const f32x4 sv = *(const LAS f32x4*)(s + bb * 1024 + kq * 256 + k); acc[bb] += (sv.x * w0 + sv.y * w1) + (sv.z * w2 + sv.w * w3); }
        }
        __syncthreads();
        LAS float* red = (LAS float*)F.lds;
#pragma unroll
        for (int bb = 0; bb < 33; ++bb) red[(kq * 33 + bb) * 128 + cc] = acc[bb];
        __syncthreads();
        float* MOD = (float*)(F.ws + WS_MOD);
        for (int idx = F.tid; idx < 33 * 128; idx += NTHR) { const int bb = idx >> 7, c2 = idx & 127;
            const float v = (red[(0 * 33 + bb) * 128 + c2] + red[(1 * 33 + bb) * 128 + c2]) + (red[(2 * 33 + bb) * 128 + c2] + red[(3 * 33 + bb) * 128 + c2]);
            MOD[((size_t)l * 33 + bb) * NMOD + n0 + c2] = v + AIN(I_ADAB)[l * NMOD + n0 + c2]; }
        __syncthreads();
    }
    if (F.vcu == 192 + 8) {
        float* RT = (float*)(F.ws + WS_ROPE);
        for (int idx = F.tid; idx < 64 * 64; idx += NTHR) { const int pos = idx >> 6, m = idx & 63; const float fr = powf(10000.0f, -(float)(2 * m) / 128.0f); const float ang = (float)pos * fr;
            RT[2 * idx] = cosf(ang); RT[2 * idx + 1] = sinf(ang); }
    }
    {
        bf16* GW = (bf16*)(F.ws + WS_W + W_LRU_G); const float* gwsrc = AIN(I_LGW);
        for (int idx = F.vcu * NTHR + F.tid; idx < 8 * 640 * 160; idx += F.G * NTHR) { const int c = idx % 160, n = (idx / 160) % 640, blk = idx / (160 * 640); const int dg = n / 160, d = n % 160;
            GW[idx] = (bf16)f2bf(gwsrc[(((size_t)dg * 8 + blk) * 160 + c) * 160 + d]); }
    }
    {
        LAS float* scr = (LAS float*)(F.lds + F.wave * 16384);
        constexpr int TOTAL = 2 * (512 + 512 + 1024 + 512 + 1024 + 1024) + 4 * (2816 + 1408) + 1280 + 640 + 512 + 512 + 512 + 512;
        for (int it = F.gw; it < TOTAL; it += F.NGW) {
            int r = it;
#define JOB(Wp, K_, ldn_, c0_, nc_, dst_, ro_, sc_) { constexpr int items_ = ((K_) / 64) * ((nc_) / 32); if (r < items_) { transpose_item((Wp), (K_), (ldn_), (c0_), (nc_), (dst_), (ro_), (sc_), scr, r, F.lane); continue; } r -= items_; }
#define RETJOBS(j) { const float* win = AIN(I_RWIN) + (size_t)(j) * 1024 * 6144; bf16* Wa = Wb + (W_RET + (size_t)(j) * 18 * MiB) / 2; bf16* Wbb = Wa + (8 * MiB) / 2; bf16* Wo = Wa + (14 * MiB) / 2; \
            JOB(win, 1024, 6144, 0, 1024, Wa, -1000000, 1.f) JOB(win, 1024, 6144, 1024, 1024, Wa, -1000000 - 1024, 0.0625f) JOB(win, 1024, 6144, 4096, 2048, Wa, 2048, 1.f) \
            JOB(win, 1024, 6144, 1024, 1024, Wbb, -1000000, 0.0625f) JOB(win, 1024, 6144, 2048, 2048, Wbb, 1024, 1.f) \
            JOB(AIN(I_RWOUT) + (size_t)(j) * 2048 * 1024, 2048, 1024, 0, 1024, Wo, 0, 1.f) }
#define FFNJOBS(l) { bf16* Wup = Wb + (W_FFN + (size_t)(l) * (16 * MiB + 512 * 1024)) / 2; bf16* Wdn = Wup + (11 * MiB) / 2; \
            JOB(AIN(I_UP) + (size_t)(l) * 1024 * 5632, 1024, 5632, 0, 5632, Wup, -1, 1.f) JOB(AIN(I_DOWN) + (size_t)(l) * 2816 * 1024, 2816, 1024, 0, 1024, Wdn, 0, 1.f) }
            RETJOBS(0) RETJOBS(1) FFNJOBS(0) FFNJOBS(1) FFNJOBS(2) FFNJOBS(3)
            JOB(AIN(I_LWIN), 1024, 2560, 0, 2560, Wb + W_LRU_IN / 2, 0, 1.f) JOB(AIN(I_LWOUT), 1280, 1024, 0, 1024, Wb + W_LRU_OUT / 2, 0, 1.f)
            JOB(AIN(I_NQKV), 1024, 3072, 0, 1024, Wb + W_NA_QK / 2, 0, 0.125f * 1.4426950408889634f) JOB(AIN(I_NQKV), 1024, 3072, 1024, 1024, Wb + W_NA_QK / 2, 1024, 1.f)
            JOB(AIN(I_NQKV), 1024, 3072, 2048, 1024, Wb + W_NA_V / 2, 0, 1.f) JOB(AIN(I_NWOUT), 1024, 1024, 0, 1024, Wb + W_NA_O / 2, 0, 1.f)
#undef JOB
#undef RETJOBS
#undef FFNJOBS
        }
    }
}

__device__ __forceinline__ void norm_phase(const Frame& F0, int b0, int nrows, const void* xs, const void* cs, int f32src, const float* gain, const float* modl, int shoff, int scoff) {
    const Frame F = refresh(F0);
    bf16* H = (bf16*)(F.ws + WS_ACT + A_H);
    for (int row = F.gw; row < nrows; row += F.NGW) {
        const int bl = row / PT, p = row % PT, b = b0 + bl;
        const size_t soff = p < CTXL ? ((size_t)b * CTXL + p) * D : ((size_t)b * SEQ + (p - CTXL)) * D; const void* sbase = p < CTXL ? cs : xs;
        const float* mod = modl + (size_t)(p < CTXL ? 32 : b) * NMOD;
        f32x4 v[4]; float ss = 0.f;
#pragma unroll
        for (int j = 0; j < 4; ++j) {
            if (f32src) v[j] = *(const f32x4*)((const float*)sbase + soff + 4 * F.lane + 256 * j);
            else { const u32x2 w = *(const u32x2*)((const bf16*)sbase + soff + 4 * F.lane + 256 * j); v[j] = (f32x4){bflo(w.x), bfhi(w.x), bflo(w.y), bfhi(w.y)}; }
            ss += (v[j].x * v[j].x + v[j].y * v[j].y) + (v[j].z * v[j].z + v[j].w * v[j].w); }
        const float rstd = 1.f / sqrtf(wave_sum(ss, F.lane) * (1.f / D) + EPS);
#pragma unroll
        for (int j = 0; j < 4; ++j) { const int c = 4 * F.lane + 256 * j;
            const f32x4 gn = *(const f32x4*)(gain + c), sh = *(const f32x4*)(mod + shoff + c), sc = *(const f32x4*)(mod + scoff + c);
            const f32x4 h = (v[j] * rstd) * gn; const f32x4 o = h * (sc + 1.f) + sh;
            u32x2 w; w.x = pk2(o.x, o.y); w.y = pk2(o.z, o.w);
            *(u32x2*)(H + (size_t)row * D + c) = w; }
    }
}

__device__ __forceinline__ void ffn_fix_phase(const Frame& F0, const float* cw, const float* cb) {
    const Frame F = refresh(F0);
    const bf16* EDGE = (const bf16*)(F.ws + WS_ACT + A_EDGE); bf16* ACT = (bf16*)(F.ws + WS_ACT + A_ACT);
    const int NOCT = FFN / 8;
    for (int it = F.vcu * NTHR + F.tid; it < NBATCH * 7 * 2 * NOCT; it += F.G * NTHR) {
        const int oc = it % NOCT, r2 = it / NOCT, side = r2 & 1, bd = (r2 >> 1) % 7, b = (r2 >> 1) / 7; const int c = oc * 8;
        const int pml = 9 * b + 1 + bd, pmh = pml + 1;
        const bf16* pp = side == 0 ? EDGE + ((size_t)pml * 4 + 2) * FFN2 : EDGE + ((size_t)pml * 4 + 3) * FFN2;
        const bf16* pc = side == 0 ? EDGE + ((size_t)pml * 4 + 3) * FFN2 : EDGE + ((size_t)pmh * 4 + 0) * FFN2;
        const bf16* pn = side == 0 ? EDGE + ((size_t)pmh * 4 + 0) * FFN2 : EDGE + ((size_t)pmh * 4 + 1) * FFN2;
        const size_t trow = side == 0 ? (size_t)pml * 256 + 255 : (size_t)pmh * 256;
        float ug[8], uv[8];
#pragma unroll
        for (int half = 0; half < 2; ++half) {
            const int col = half * FFN + c;
            const u32x4 prv = *(const u32x4*)(pp + col), cur = *(const u32x4*)(pc + col), nxt = *(const u32x4*)(pn + col);
            float* dst = half == 0 ? ug : uv;
#pragma unroll
            for (int q = 0; q < 4; ++q) {
                const f32x2 w0 = *(const f32x2*)(cw + 0 * FFN2 + col + 2 * q), w1 = *(const f32x2*)(cw + 1 * FFN2 + col + 2 * q), w2 = *(const f32x2*)(cw + 2 * FFN2 + col + 2 * q), bb = *(const f32x2*)(cb + col + 2 * q);
                dst[2 * q] = bb.x + w0.x * bflo(prv[q]) + w1.x * bflo(cur[q]) + w2.x * bflo(nxt[q]);
                dst[2 * q + 1] = bb.y + w0.y * bfhi(prv[q]) + w1.y * bfhi(cur[q]) + w2.y * bfhi(nxt[q]);
            }
        }
        float o[8];
#pragma unroll
        for (int e = 0; e < 8; ++e) o[e] = silu_f(ug[e]) * uv[e];
        u32x4 w; w.x = pk2(o[0], o[1]); w.y = pk2(o[2], o[3]); w.z = pk2(o[4], o[5]); w.w = pk2(o[6], o[7]);
        *(u32x4*)(ACT + trow * FFN + c) = w;
    }
}

__device__ __forceinline__ void rope_phase(const Frame& F0) {
    const Frame F = refresh(F0);
    bf16* QKG = (bf16*)(F.ws + WS_ACT + A_QKG); bf16* KVT = (bf16*)(F.ws + WS_ACT + A_KVT); const float* RT = (const float*)(F.ws + WS_ROPE);
    const size_t n1 = (size_t)NB * SEQ * 128;
    for (size_t it = (size_t)F.vcu * NTHR + F.tid; it < n1; it += (size_t)F.G * NTHR) {
        const int sub = (int)(it & 127); const size_t lr = it >> 7; const int bl = (int)(lr / SEQ), t = (int)(lr % SEQ);
        const int oct = sub & 7, hf = (sub >> 3) & 1, h = (sub >> 4) & 3, tens = sub >> 6;
        const int pos = hf == 0 ? (t >> 6) : (t & 63);
        bf16* p1 = QKG + ((size_t)bl * PT + CTXL + t) * 4096 + tens * 1024 + h * 256 + hf * 128 + oct * 8; bf16* p2 = p1 + 64;
        const u32x4 a = *(const u32x4*)p1, b = *(const u32x4*)p2; u32x4 oa, ob;
#pragma unroll
        for (int q = 0; q < 4; ++q) {
            const f32x4 cs = *(const f32x4*)(RT + 2 * (pos * 64 + oct * 8 + 2 * q));
            const float x1l = bflo(a[q]), x1h = bfhi(a[q]), x2l = bflo(b[q]), x2h = bfhi(b[q]);
            oa[q] = pk2(x1l * cs.x - x2l * cs.y, x1h * cs.z - x2h * cs.w);
            ob[q] = pk2(x1l * cs.y + x2l * cs.x, x1h * cs.w + x2h * cs.z);
        }
        *(u32x4*)p1 = oa; *(u32x4*)p2 = ob;
    }
    const size_t n2 = (size_t)4 * 2 * 64 * NB * (SEQ / 8);
    for (size_t it = (size_t)F.vcu * NTHR + F.tid; it < n2; it += (size_t)F.G * NTHR) {
        const int to = (int)(it % (SEQ / 8)); size_t r = it / (SEQ / 8); const int bl = (int)(r % NB); r /= NB; const int d = (int)(r & 63), hf = (int)((r >> 6) & 1), h = (int)(r >> 7);
        const int t0 = to * 8;
        bf16* p1 = KVT + (size_t)(h * 256 + hf * 128 + d) * TG + (size_t)bl * PT + CTXL + t0; bf16* p2 = p1 + (size_t)64 * TG;
        const u32x4 a = *(const u32x4*)p1, b = *(const u32x4*)p2; u32x4 oa, ob;
#pragma unroll
        for (int q = 0; q < 4; ++q) {
            const int pos0 = hf == 0 ? (t0 >> 6) : ((t0 & 63) + 2 * q), pos1 = hf == 0 ? pos0 : pos0 + 1;
            const f32x2 c0 = *(const f32x2*)(RT + 2 * (pos0 * 64 + d)), c1 = *(const f32x2*)(RT + 2 * (pos1 * 64 + d));
            const float x1l = bflo(a[q]), x1h = bfhi(a[q]), x2l = bflo(b[q]), x2h = bfhi(b[q]);
            oa[q] = pk2(x1l * c0.x - x2l * c0.y, x1h * c1.x - x2h * c1.y);
            ob[q] = pk2(x1l * c0.y + x2l * c0.x, x1h * c1.y + x2h * c1.x);
        }
        *(u32x4*)p1 = oa; *(u32x4*)p2 = ob;
    }
}

#define MFMA16(a, b, c) __builtin_amdgcn_mfma_f32_16x16x32_bf16((a), (b), (c), 0, 0, 0)
constexpr int QS_STRIDE = 528, PS_STRIDE = 272;
constexpr int LDS_RA = 0, LDS_RB = 65536;
__device__ __forceinline__ float ex2(float x) { return __builtin_amdgcn_exp2f(x); }
__device__ __forceinline__ int st_off(int r, int cb, int ncg) { return ((r >> 4) * ncg + (cb >> 6)) * 1024 + ((((r & 15) << 6) + (cb & 63)) ^ (((r >> 3) & 1) << 5)); }
template <int DIR>
__device__ __forceinline__ void ret_scan_pass(const Frame& F, const bf16* QKG, const bf16* KVT, bf16* Y, int bl, int h, int vs, float lgf, float lgb) {
    LAS unsigned char* RA = F.lds + LDS_RA; LAS unsigned char* RB = F.lds + LDS_RB;
    const int v0 = vs * 128 + F.wave * 16;
    const float lg2 = DIR == 0 ? lgf : lgb;
    const float gch = ex2(lg2 * 128.f);
    f32x4 S[16];
#pragma unroll
    for (int i = 0; i < 16; ++i) S[i] = (f32x4){0.f, 0.f, 0.f, 0.f};
    u32x4 qv[8], kv[8];
#define RET_PF_Q(cc) do { const size_t Rn = (size_t)bl * PT + (size_t)(cc) * 128; int tp = F.tid; asm volatile("" : "+v"(tp)); \
        _Pragma("unroll") for (int e = 0; e < 8; ++e) { const int q = tp + NTHR * e; qv[e] = *(const u32x4*)(QKG + (Rn + (q >> 5)) * 4096 + h * 256 + (q & 31) * 8); } } while (0)
#define RET_PF_K(cc) do { const size_t Rn = (size_t)bl * PT + (size_t)(cc) * 128; int tp = F.tid; asm volatile("" : "+v"(tp)); \
        _Pragma("unroll") for (int e = 0; e < 8; ++e) { const int q = tp + NTHR * e; \
            if (DIR == 0) kv[e] = *(const u32x4*)(QKG + (Rn + (q >> 5)) * 4096 + 1024 + h * 256 + (q & 31) * 8); \
            else kv[e] = *(const u32x4*)(KVT + (size_t)(h * 256 + (q >> 4)) * TG + Rn + (q & 15) * 8); } } while (0)
    RET_PF_Q(DIR == 0 ? 0 : 1); RET_PF_K(DIR == 0 ? 0 : 1);
    for (int step = 0; step < 18; ++step) {
        const int c = DIR == 0 ? step : (step < 2 ? 1 - step : 19 - step);
        const int cn = step == 17 ? c : (DIR == 0 ? step + 1 : (step + 1 < 2 ? 1 - (step + 1) : 19 - (step + 1)));
        const size_t R0 = (size_t)bl * PT + (size_t)c * 128;
        int tl = F.tid; asm volatile("" : "+v"(tl));
        const int l15 = tl & 15, g4 = (tl >> 4) & 3;
#pragma unroll
        for (int e = 0; e < 8; ++e) { const int q = tl + NTHR * e; const int m8 = q & 31, mm = m8 & 3;
            const int o0 = st_off(q >> 5, 64 * (m8 >> 2) + 32 * (mm & 1) + 8 * (mm >> 1), 8), o1 = st_off(q >> 5, 64 * (m8 >> 2) + 32 * (mm & 1) + 8 * (mm >> 1) + 16, 8);
            *(LAS u32x2*)(RA + o0) = (u32x2){qv[e].x, qv[e].y}; *(LAS u32x2*)(RA + o1) = (u32x2){qv[e].z, qv[e].w};
            if (DIR == 0) { *(LAS u32x2*)(RB + o0) = (u32x2){kv[e].x, kv[e].y}; *(LAS u32x2*)(RB + o1) = (u32x2){kv[e].z, kv[e].w}; }
            else *(LAS u32x4*)(RB + st_off(q >> 4, 16 * (q & 15), 4)) = kv[e]; }
        const int loff = ((l15 << 6) + 16 * g4) ^ (((l15 >> 3) & 1) << 5);
        bf16x8 vf[4];
#pragma unroll
        for (int ks = 0; ks < 4; ++ks) vf[ks] = *(const bf16x8*)(KVT + (size_t)(1024 + h * 512 + v0 + l15) * TG + R0 + 32 * ks + 8 * g4);
        __syncthreads();
        if (DIR == 1) RET_PF_Q(cn);
        f32x4 ya[8];
#pragma unroll
        for (int it = 0; it < 8; ++it) ya[it] = (f32x4){0.f, 0.f, 0.f, 0.f};
        if (DIR == 0) {
            f32x4 pt[8];
#pragma unroll
            for (int it = 0; it < 8; ++it) pt[it] = (f32x4){0.f, 0.f, 0.f, 0.f};
#pragma unroll
            for (int ks = 0; ks < 8; ++ks) {
                __builtin_amdgcn_sched_barrier(0);
                const bf16x8 af = *(const LAS bf16x8*)(RB + (F.wave * 8 + ks) * 1024 + loff);
#pragma unroll
                for (int ih = 0; ih < 2; ++ih) {
                    bf16x8 bq[4];
#pragma unroll
                    for (int it = 0; it < 4; ++it) bq[it] = *(const LAS bf16x8*)(RA + ((4 * ih + it) * 8 + ks) * 1024 + loff);
                    __builtin_amdgcn_sched_barrier(0);
#pragma unroll
                    for (int it = 0; it < 4; ++it) pt[4 * ih + it] = MFMA16(af, bq[it], pt[4 * ih + it]);
                    __builtin_amdgcn_sched_barrier(0);
                }
            }
            __syncthreads();
#pragma unroll
            for (int it = 0; it < 8; ++it) {
                const int i = 16 * it + l15; float pv[4];
                const float ixi = ex2(-lgf * (float)(i + 1));
#pragma unroll
                for (int r = 0; r < 4; ++r) { const int j = 16 * F.wave + 4 * g4 + r; const int dd = i - j;
                    const float f = dd > 0 ? ex2(-lgf * (float)(j + 1)) : (dd < 0 ? ex2(lgb * (float)(-dd)) * ixi : 2.f * ixi); pv[r] = pt[it][r] * f; }
                u32x2 w; w.x = pk2(pv[0], pv[1]); w.y = pk2(pv[2], pv[3]);
                *(LAS u32x2*)(RB + st_off(i, 32 * F.wave + 8 * g4, 4)) = w;
            }
            __syncthreads();
#pragma unroll
            for (int ks = 0; ks < 4; ++ks) {
                __builtin_amdgcn_sched_barrier(0);
                bf16x8 ap[8];
#pragma unroll
                for (int it = 0; it < 8; ++it) ap[it] = *(const LAS bf16x8*)(RB + (it * 4 + ks) * 1024 + loff);
                __builtin_amdgcn_sched_barrier(0);
#pragma unroll
                for (int it = 0; it < 8; ++it) ya[it] = MFMA16(ap[it], vf[ks], ya[it]);
            }
        }
        u32x4 kt2[8];
        if (DIR == 0) {
#pragma unroll
            for (int e = 0; e < 8; ++e) { const int q = tl + NTHR * e; kt2[e] = *(const u32x4*)(KVT + (size_t)(h * 256 + (q >> 4)) * TG + R0 + (q & 15) * 8); }
        }
        bf16x8 vfs[4];
        {
            float z[8]; const float z32 = ex2(lg2 * (DIR == 0 ? -32.f : 32.f));
#pragma unroll
            for (int e = 0; e < 8; ++e) z[e] = ex2(lg2 * (float)(DIR == 0 ? 127 - (8 * g4 + e) : 8 * g4 + e));
#pragma unroll
            for (int ks = 0; ks < 4; ++ks) {
                const u32x4 vv = __builtin_bit_cast(u32x4, vf[ks]); u32x4 o;
#pragma unroll
                for (int w = 0; w < 4; ++w) o[w] = pk2(bflo(vv[w]) * z[2 * w], bfhi(vv[w]) * z[2 * w + 1]);
                vfs[ks] = __builtin_bit_cast(bf16x8, o);
#pragma unroll
                for (int e = 0; e < 8; ++e) z[e] *= z32;
            }
        }
#pragma unroll
        for (int s = 0; s < 8; ++s) {
            __builtin_amdgcn_sched_barrier(0);
            u32x4 sb; sb.x = pk2(S[2 * s][0], S[2 * s][1]); sb.y = pk2(S[2 * s][2], S[2 * s][3]); sb.z = pk2(S[2 * s + 1][0], S[2 * s + 1][1]); sb.w = pk2(S[2 * s + 1][2], S[2 * s + 1][3]);
            const bf16x8 bfr = __builtin_bit_cast(bf16x8, sb);
            bf16x8 aq[8];
#pragma unroll
            for (int it = 0; it < 8; ++it) aq[it] = *(const LAS bf16x8*)(RA + (it * 8 + s) * 1024 + loff);
            __builtin_amdgcn_sched_barrier(0);
#pragma unroll
            for (int it = 0; it < 8; ++it) ya[it] = MFMA16(aq[it], bfr, ya[it]);
        }
        __builtin_amdgcn_sched_barrier(0);
        {
            float x0[4]; const float x16 = ex2(lg2 * (DIR == 0 ? 16.f : -16.f));
#pragma unroll
            for (int r = 0; r < 4; ++r) x0[r] = ex2(lg2 * (float)(DIR == 0 ? 4 * g4 + r + 1 : 128 - (4 * g4 + r)));
            if (DIR == 0) __syncthreads();
            LAS unsigned char* wscr = F.lds + 139776 + F.wave * 2048;
#pragma unroll
            for (int it = 0; it < 8; ++it) {
#pragma unroll
                for (int r = 0; r < 4; ++r) {
                    const unsigned short o = (unsigned short)f2bf(x0[r] * ya[it][r]);
                    if (DIR == 0) *(LAS bf16*)(RB + st_off(16 * it + 4 * g4 + r, 32 * F.wave + 2 * l15, 4)) = o;
                    else *(LAS bf16*)(wscr + (16 * (it & 3) + 4 * g4 + r) * 32 + l15 * 2) = o;
                    x0[r] *= x16;
                }
                if (DIR == 1 && (it & 3) == 3) {
                    asm volatile("s_waitcnt lgkmcnt(0)" ::: "memory");
                    const int ln = tl & 63;
#pragma unroll
                    for (int cch = 0; cch < 2; ++cch) { const int cq = ln + 64 * cch; const u32x4 yv = *(const LAS u32x4*)(wscr + cq * 16);
                        *(u32x4*)(Y + (R0 + 64 * (it >> 2) + (cq >> 1)) * 2048 + h * 512 + v0 + 8 * (cq & 1)) = yv; }
                    asm volatile("s_waitcnt lgkmcnt(0)" ::: "memory");
                }
            }
        }
#pragma unroll
        for (int i = 0; i < 16; ++i) S[i] = S[i] * gch;
        if (DIR == 0) {
#pragma unroll
            for (int e = 0; e < 8; ++e) { const int q = tl + NTHR * e; *(LAS u32x4*)(RA + st_off(q >> 4, 16 * (q & 15), 4)) = kt2[e]; }
            __syncthreads();
            u32x4 yold[4];
#pragma unroll
            for (int e = 0; e < 4; ++e) { const int q = tl + NTHR * e; yold[e] = *(const u32x4*)(Y + (R0 + (q >> 4)) * 2048 + h * 512 + vs * 128 + (q & 15) * 8); }
            RET_PF_Q(cn); RET_PF_K(cn);
#pragma unroll
            for (int e = 0; e < 4; ++e) {
                const int q = tl + NTHR * e, row = q >> 4, ch = q & 15;
                bf16* yp = Y + (R0 + row) * 2048 + h * 512 + vs * 128 + ch * 8;
                const u32x4 yv = *(const LAS u32x4*)(RB + st_off(row, 16 * ch, 4)); u32x4 o;
#pragma unroll
                for (int w = 0; w < 4; ++w) o[w] = pk2(bflo(yv[w]) + bflo(yold[e][w]), bfhi(yv[w]) + bfhi(yold[e][w]));
                *(u32x4*)yp = o;
            }
        } else {
            RET_PF_K(cn);
        }
        {
            LAS unsigned char* KT = DIR == 0 ? RA : RB;
#pragma unroll
            for (int ks = 0; ks < 4; ++ks)
#pragma unroll
                for (int dh = 0; dh < 2; ++dh) {
                    __builtin_amdgcn_sched_barrier(0);
                    bf16x8 ak[8];
#pragma unroll
                    for (int d8 = 0; d8 < 8; ++d8) ak[d8] = *(const LAS bf16x8*)(KT + ((8 * dh + d8) * 4 + ks) * 1024 + loff);
                    __builtin_amdgcn_sched_barrier(0);
#pragma unroll
                    for (int d8 = 0; d8 < 8; ++d8) S[8 * dh + d8] = MFMA16(ak[d8], vfs[ks], S[8 * dh + d8]);
                }
        }
        __syncthreads();
    }
#undef RET_PF_Q
#undef RET_PF_K
}
__device__ __forceinline__ void ret_scan_phase(const Frame& F0, const float* logit  , size_t yoff) {
    const Frame F = refresh(F0);
    const bf16* QKG = (const bf16*)(F.ws + WS_ACT + A_QKG); const bf16* KVT = (const bf16*)(F.ws + WS_ACT + A_KVT); bf16* Y = (bf16*)(F.ws + WS_ACT + A_Y + yoff);
    for (int u = F.vcu; u < NB * 16; u += F.G) {
        const int bl = u >> 4, h = (u >> 2) & 3, vs = u & 3;
        const float lgf = -log1pf(expf(-logit[h])) * 1.4426950408889634f, lgb = -log1pf(expf(-logit[4 + h])) * 1.4426950408889634f;
        ret_scan_pass<1>(F, QKG, KVT, Y, bl, h, vs, lgf, lgb);
        ret_scan_pass<0>(F, QKG, KVT, Y, bl, h, vs, lgf, lgb);
    }
}

__device__ __forceinline__ void t_phase(const Frame& F0) {
    const Frame F = refresh(F0);
    for (int it = F.gw; it < 2208; it += F.NGW) {
    const bf16* W; int N, n0; const float* sh; float* T;
    const float* MODp = (const float*)(F.ws + WS_MOD); float* TB = (float*)(F.ws + WS_T);
    if (it < 1408) { const int l = it / 352; W = (const bf16*)(F.ws + WS_W + W_FFN + (size_t)l * (16 * MiB + 512 * 1024)); N = 5632; n0 = (it % 352) * 16; sh = MODp + (size_t)l * 33 * NMOD + 3 * D; T = TB + TB_FFN + (size_t)l * TB_FFN_SZ; }
    else if (it < 1568) { W = (const bf16*)(F.ws + WS_W + W_LRU_IN); N = 2560; n0 = (it - 1408) * 16; sh = MODp + (size_t)1 * 33 * NMOD; T = TB + TB_LRU; }
    else if (it < 1696) { W = (const bf16*)(F.ws + WS_W + W_NA_QK); N = 2048; n0 = (it - 1568) * 16; sh = MODp + (size_t)2 * 33 * NMOD; T = TB + TB_NAQK; }
    else if (it < 1760) { W = (const bf16*)(F.ws + WS_W + W_NA_V); N = 1024; n0 = (it - 1696) * 16; sh = MODp + (size_t)2 * 33 * NMOD; T = TB + TB_NAV; }
    else if (it < 2016) { W = (const bf16*)(F.ws + WS_W + W_RET + 18 * MiB); N = 4096; n0 = (it - 1760) * 16; sh = MODp + (size_t)3 * 33 * NMOD; T = TB + TB_RETA; }
    else { W = (const bf16*)(F.ws + WS_W + W_RET + 18 * MiB + 8 * MiB); N = 3072; n0 = (it - 2016) * 16; sh = MODp + (size_t)3 * 33 * NMOD; T = TB + TB_RETB; }
    const int l15 = F.lane & 15, g4 = F.lane >> 4;
    f32x4 acc[3];
#pragma unroll
    for (int ct = 0; ct < 3; ++ct) acc[ct] = (f32x4){0.f, 0.f, 0.f, 0.f};
    const bf16* wp = W + (size_t)(n0 + l15) * 1024 + 8 * g4;
    for (int ks = 0; ks < 32; ++ks) {
        const bf16x8 a = *(const bf16x8*)(wp + 32 * ks);
#pragma unroll
        for (int ct = 0; ct < 3; ++ct) { const int mr = 16 * ct + l15 < 32 ? 16 * ct + l15 : 32;
            const float* sp = sh + (size_t)mr * NMOD + 32 * ks + 8 * g4; const f32x4 s0 = *(const f32x4*)sp, s1 = *(const f32x4*)(sp + 4);
            u32x4 bw; bw.x = pk2(s0.x, s0.y); bw.y = pk2(s0.z, s0.w); bw.z = pk2(s1.x, s1.y); bw.w = pk2(s1.z, s1.w);
            acc[ct] = MFMA16(a, __builtin_bit_cast(bf16x8, bw), acc[ct]); }
    }
#pragma unroll
    for (int ct = 0; ct < 3; ++ct) { const int mr = 16 * ct + l15;
        if (mr < 33) {
#pragma unroll
            for (int r = 0; r < 4; ++r) T[(size_t)mr * N + n0 + 4 * g4 + r] = acc[ct][r]; } }
    }
}

__device__ __forceinline__ void ret_gn_phase(const Frame& F0, const float* gn, size_t yoff) {
    const Frame F = refresh(F0);
    const bf16* Y = (const bf16*)(F.ws + WS_ACT + A_Y + yoff); const bf16* QKG = (const bf16*)(F.ws + WS_ACT + A_QKG); bf16* A2 = (bf16*)(F.ws + WS_ACT + A_Y + yoff);
    for (int row = F.gw; row < TG; row += F.NGW) {
#pragma unroll
        for (int h = 0; h < 4; ++h) {
            const int c = h * 512 + 8 * F.lane;
            const u32x4 yv = *(const u32x4*)(Y + (size_t)row * 2048 + c), gv = *(const u32x4*)(QKG + (size_t)row * 4096 + 2048 + c);
            float y[8]; float s = 0.f;
#pragma unroll
            for (int q = 0; q < 4; ++q) { y[2 * q] = bflo(yv[q]); y[2 * q + 1] = bfhi(yv[q]); s += y[2 * q] + y[2 * q + 1]; }
            const float mu = wave_sum(s, F.lane) * (1.f / 512.f); float s2 = 0.f;
#pragma unroll
            for (int e = 0; e < 8; ++e) { y[e] -= mu; s2 += y[e] * y[e]; }
            const float rstd = 1.f / sqrtf(wave_sum(s2, F.lane) * (1.f / 512.f) + EPS);
            float o[8];
#pragma unroll
            for (int q = 0; q < 4; ++q) { const f32x2 gg = *(const f32x2*)(gn + c + 2 * q);
                o[2 * q] = silu_f(bflo(gv[q])) * (y[2 * q] * rstd * gg.x); o[2 * q + 1] = silu_f(bfhi(gv[q])) * (y[2 * q + 1] * rstd * gg.y); }
            u32x4 w; w.x = pk2(o[0], o[1]); w.y = pk2(o[2], o[3]); w.z = pk2(o[4], o[5]); w.w = pk2(o[6], o[7]);
            *(u32x4*)(A2 + (size_t)row * 2048 + c) = w;
        }
    }
}

__device__ __forceinline__ float gelu_tanh(float x) { const float z = 0.7978845608028654f * (x + 0.044715f * x * x * x); const float e = __expf(2.f * z); const float th = 1.f - 2.f * __builtin_amdgcn_rcpf(e + 1.f); return 0.5f * x * (1.f + th); }
constexpr int XC_STRIDE = 336;
__device__ __forceinline__ void lru_gate_phase(const Frame& F0, const float* cw, const float* cb, const float* gb  , const float* lam  ) {
    const Frame F = refresh(F0);
    const bf16* YX = (const bf16*)(F.ws + WS_ACT + A_YX); const bf16* GW = (const bf16*)(F.ws + WS_W + W_LRU_G);
    bf16* LA = (bf16*)(F.ws + WS_ACT + A_LA); bf16* U = (bf16*)(F.ws + WS_ACT + A_U);
    const int l15 = F.lane & 15, g4 = F.lane >> 4;
    const int oc = F.tid % 20, rg = F.tid / 20; const bool act = rg < 22;
    float cwv[4][8], cbv[8];
#define LRU_LOAD_CW(kb_) do { const int cch = (kb_) * 160 + oc * 8; _Pragma("unroll") for (int w = 0; w < 4; ++w) { const f32x2 bb = *(const f32x2*)(cb + cch + 2 * w); cbv[2 * w] = bb.x; cbv[2 * w + 1] = bb.y; \
        _Pragma("unroll") for (int k = 0; k < 4; ++k) { const f32x2 ww = *(const f32x2*)(cw + k * LW + cch + 2 * w); cwv[k][2 * w] = ww.x; cwv[k][2 * w + 1] = ww.y; } } } while (0)
    const bool kbfix = (F.G & 7) == 0;
    LRU_LOAD_CW(F.vcu & 7);
    for (int it = F.vcu; it < (TG / 128) * 8; it += F.G) {
        const int rb = it >> 3, kb = it & 7; const int row0 = rb * 128;
        if (!kbfix) LRU_LOAD_CW(kb);
        if (act) {
            const int skey = (row0 / PT) * 2 + ((row0 % PT) >= CTXL ? 1 : 0);
            u32x4 xin[9];
#pragma unroll
            for (int q = 0; q < 9; ++q) {
                const int gr = row0 + rg * 6 - 2 + q; const bool ok = gr >= 0 && gr < TG && ((gr / PT) * 2 + ((gr % PT) >= CTXL ? 1 : 0)) == skey;
                xin[q] = ok ? *(const u32x4*)(YX + (size_t)gr * 2560 + LW + kb * 160 + oc * 8) : (u32x4){0u, 0u, 0u, 0u};
            }
#pragma unroll
            for (int jr = 0; jr < 6; ++jr) {
                const int r = rg * 6 + jr;
                if (r < 128) {
                    float o[8];
#pragma unroll
                    for (int e = 0; e < 8; ++e) o[e] = cbv[e];
#pragma unroll
                    for (int k = 0; k < 4; ++k)
#pragma unroll
                        for (int w = 0; w < 4; ++w) { o[2 * w] += cwv[k][2 * w] * bflo(xin[jr + k][w]); o[2 * w + 1] += cwv[k][2 * w + 1] * bfhi(xin[jr + k][w]); }
                    u32x4 w4; w4.x = pk2(o[0], o[1]); w4.y = pk2(o[2], o[3]); w4.z = pk2(o[4], o[5]); w4.w = pk2(o[6], o[7]);
                    *(LAS u32x4*)(F.lds + r * XC_STRIDE + oc * 16) = w4;
                }
            }
        }
        __syncthreads();
        const int dir = F.wave & 1;
        for (int nt = F.wave >> 1; nt < 10; nt += 4) {
            bf16x8 wr[5], wi[5];
            const bf16* wp = GW + ((size_t)kb * 640 + (dir * 2 + 0) * 160 + 16 * nt + l15) * 160 + 8 * g4;
#pragma unroll
            for (int ks = 0; ks < 5; ++ks) { wr[ks] = *(const bf16x8*)(wp + 32 * ks); wi[ks] = *(const bf16x8*)(wp + 160 * 160 + 32 * ks); }
            const int c0 = kb * 160 + 16 * nt + 4 * g4;
            const f32x4 br = *(const f32x4*)(gb + (dir * 2 + 0) * LW + c0), bi = *(const f32x4*)(gb + (dir * 2 + 1) * LW + c0), lm = *(const f32x4*)(lam + dir * LW + c0);
            f32x4 sp;
#pragma unroll
            for (int r = 0; r < 4; ++r) sp[r] = -8.f * log1pf(__expf(-lm[r]));
            for (int rt = 0; rt < 8; ++rt) {
                f32x4 ar = (f32x4){0.f, 0.f, 0.f, 0.f}, ai = ar;
                const LAS unsigned char* xrow = F.lds + (16 * rt + l15) * XC_STRIDE;
#pragma unroll
                for (int ks = 0; ks < 5; ++ks) { const bf16x8 xb = *(const LAS bf16x8*)(xrow + (32 * ks + 8 * g4) * 2); ar = MFMA16(wr[ks], xb, ar); ai = MFMA16(wi[ks], xb, ai); }
                const u32x2 xv = *(const LAS u32x2*)(xrow + (16 * nt + 4 * g4) * 2);
                const float x4[4] = {bflo(xv.x), bfhi(xv.x), bflo(xv.y), bfhi(xv.y)};
                float la[4], uu[4];
#pragma unroll
                for (int r = 0; r < 4; ++r) {
                    const float rg = sigmoid_f(ar[r] + br[r]), ig = sigmoid_f(ai[r] + bi[r]);
                    la[r] = rg * sp[r]; const float a2 = __expf(2.f * la[r]);
                    uu[r] = sqrtf(fmaxf(1.f - a2, 0.f)) * (ig * x4[r]);
                }
                const size_t o = ((size_t)dir * TG + (size_t)(row0 + 16 * rt + l15)) * LW + c0;
                u32x2 w1, w2; w1.x = pk2(la[0], la[1]); w1.y = pk2(la[2], la[3]); w2.x = pk2(uu[0], uu[1]); w2.y = pk2(uu[2], uu[3]);
                *(u32x2*)(LA + o) = w1; *(u32x2*)(U + o) = w2;
            }
        }
        __syncthreads();
    }
}

__device__ __forceinline__ void lru_scan_phase(const Frame& F0, size_t aoff) {
    const Frame F = refresh(F0);
    const bf16* LA = (const bf16*)(F.ws + WS_ACT + A_LA); const bf16* U = (const bf16*)(F.ws + WS_ACT + A_U); const bf16* YX = (const bf16*)(F.ws + WS_ACT + A_YX);
    bf16* A3 = (bf16*)(F.ws + WS_ACT + A_A3 + aoff);
    LAS f32x4* cbuf = (LAS f32x4*)F.lds;
    const int cp = F.tid % 40, k = F.tid / 40; const bool act = F.tid < 360;
    for (int it = F.vcu; it < NB * 16; it += F.G) {
        const int bl = it >> 4, cg = it & 15; const int c0 = cg * 80 + 2 * cp;
        for (int dir = 0; dir < 2; ++dir) {
            const size_t base = ((size_t)dir * TG + (size_t)bl * PT) * LW + c0;
            const int pstart = dir == 0 ? 256 * k : 256 * k + 255, pstep = dir == 0 ? 1 : -1;
            if (act) {
                float hx = 0.f, hy = 0.f, sx = 0.f, sy = 0.f;
                for (int s0 = 0; s0 < 256; s0 += 32) {
                    unsigned lv[32], uv[32];
#pragma unroll
                    for (int e = 0; e < 32; ++e) { const size_t o = base + (size_t)(pstart + pstep * (s0 + e)) * LW; lv[e] = *(const unsigned*)(LA + o); uv[e] = *(const unsigned*)(U + o); }
#pragma unroll
                    for (int e = 0; e < 32; ++e) { const float lx = bflo(lv[e]), ly = bfhi(lv[e]); hx = __expf(lx) * hx + bflo(uv[e]); hy = __expf(ly) * hy + bfhi(uv[e]); sx += lx; sy += ly; }
                }
                cbuf[k * 40 + cp] = (f32x4){__expf(sx), hx, __expf(sy), hy};
            }
            __syncthreads();
            if (act) {
                const int ok = dir == 0 ? k : (k == 0 ? 0 : 9 - k);
                float hx = 0.f, hy = 0.f;
                for (int o = 0; o < ok; ++o) { const int kk = dir == 0 ? o : (o == 0 ? 0 : 9 - o); const f32x4 cv = cbuf[kk * 40 + cp]; hx = cv.x * hx + cv.y; hy = cv.z * hy + cv.w; }
                for (int s0 = 0; s0 < 256; s0 += 16) {
                    unsigned lv[16], uv[16], fv[16], yv[16];
#pragma unroll
                    for (int e = 0; e < 16; ++e) { const int p = pstart + pstep * (s0 + e); const size_t o = base + (size_t)p * LW; lv[e] = *(const unsigned*)(LA + o); uv[e] = *(const unsigned*)(U + o);
                        if (dir == 1) { const size_t r = (size_t)bl * PT + p; fv[e] = *(const unsigned*)(A3 + r * LW + c0); yv[e] = *(const unsigned*)(YX + r * 2560 + c0); } }
#pragma unroll
                    for (int e = 0; e < 16; ++e) { const int p = pstart + pstep * (s0 + e); const size_t r = (size_t)bl * PT + p;
                        hx = __expf(bflo(lv[e])) * hx + bflo(uv[e]); hy = __expf(bfhi(lv[e])) * hy + bfhi(uv[e]);
                        unsigned w;
                        if (dir == 0) w = pk2(hx, hy);
                        else w = pk2((hx + bflo(fv[e])) * gelu_tanh(bflo(yv[e])), (hy + bfhi(fv[e])) * gelu_tanh(bfhi(yv[e])));
                        *(unsigned*)(A3 + r * LW + c0) = w; }
                }
            }
            __syncthreads();
        }
    }
}

constexpr int CK_STRIDE = 144, CV_STRIDE = 528, NA_CK = 0, NA_CV = 36864, NA_RP = 36864 + 33792;
__device__ __forceinline__ void na_attn_phase(const Frame& F0, const float* rpb  , size_t ooff) {
    const Frame F = refresh(F0);
    const bf16* QK = (const bf16*)(F.ws + WS_ACT + A_QK); const bf16* VT = (const bf16*)(F.ws + WS_ACT + A_VT); bf16* O = (bf16*)(F.ws + WS_ACT + A_O + ooff);
    const float L2E = 1.4426950408889634f;
    LAS unsigned char* CK = F.lds + NA_CK; LAS unsigned char* CV = F.lds + NA_CV; LAS float* RP = (LAS float*)(F.lds + NA_RP);
    for (int item = F.vcu; item < NB * 16; item += F.G) {
        const int bl = item >> 4, h = item & 15; const size_t cbase = (size_t)bl * PT;
        {
            int ts = F.tid; asm volatile("" : "+v"(ts));
#pragma unroll
            for (int e = 0; e < 4; ++e) { const int q = ts + NTHR * e;
                *(LAS u32x4*)(CK + (q >> 3) * CK_STRIDE + (q & 7) * 16) = *(const u32x4*)(QK + (cbase + (q >> 3)) * 2048 + 1024 + h * 64 + (q & 7) * 8);
                *(LAS u32x4*)(CV + (q >> 5) * CV_STRIDE + (q & 31) * 16) = *(const u32x4*)(VT + (size_t)(h * 64 + (q >> 5)) * TG + cbase + (q & 31) * 8); }
            if (ts < 465) RP[ts] = rpb[h * 465 + ts] * L2E;
        }
        __syncthreads();
        int tl_ = F.tid; asm volatile("" : "+v"(tl_));
        const int l15 = tl_ & 15, g4 = (tl_ >> 4) & 3;
        bf16x8 qf[2], qn[2], kfa[4][2], kfb[4][2]; u32x2 vfa[2][4][2];
#define NA_CC0(qb_) ((qb_) == 0 ? 0 : ((qb_) == 1 ? 8 : ((qb_) == 2 ? 24 : 32)))
#define NA_START(r_) ((r_) - 4 < 0 ? 0 : ((r_) - 4 > 24 ? 24 : (r_) - 4))
        const unsigned qko = (unsigned)(l15 * 2048 + 8 * g4) * 2u, vto = (unsigned)(l15 * TG + 4 * g4) * 2u;
        const char* qkb = (const char*)(QK + cbase * 2048 + h * 64); const char* vtb = (const char*)(VT + (size_t)(h * 64) * TG + cbase);
#define NA_TK(st_, cc_, BLK, t) (CTXL + ((st_) + 2 * (BLK) + ((t) >> 1)) * 64 + (cc_) + 16 * ((t) & 1))
#define NA_LOADQ(dst, tq_) do { _Pragma("unroll") for (int s_ = 0; s_ < 2; ++s_) dst[s_] = *(const bf16x8*)(qkb + (size_t)(tq_) * 4096 + 64 * s_ + qko); } while (0)
#define NA_LOADK(kf, st_, cc_, BLK) do { _Pragma("unroll") for (int t = 0; t < 4; ++t) { const char* kp = qkb + (size_t)NA_TK(st_, cc_, BLK, t) * 4096 + 2048; \
            kf[t][0] = *(const bf16x8*)(kp + qko); kf[t][1] = *(const bf16x8*)(kp + 64 + qko); } } while (0)
#define NA_LOADV(vf, st_, cc_, BLK) do { _Pragma("unroll") for (int pr = 0; pr < 2; ++pr) _Pragma("unroll") for (int dt = 0; dt < 4; ++dt) { const char* vrow = vtb + (size_t)(16 * dt) * TG * 2; \
            vf[pr][dt][0] = *(const u32x2*)(vrow + (size_t)NA_TK(st_, cc_, BLK, 2 * pr) * 2 + vto); vf[pr][dt][1] = *(const u32x2*)(vrow + (size_t)NA_TK(st_, cc_, BLK, 2 * pr + 1) * 2 + vto); } } while (0)
#define NA_SOFTMAX() \
            float bm = -1e30f; \
            _Pragma("unroll") for (int t = 0; t < 4; ++t) bm = fmaxf(fmaxf(fmaxf(st[t][0], st[t][1]), fmaxf(st[t][2], st[t][3])), bm); \
            bm = fmaxf(bm, lane_get(bm, (tl_ & 63) ^ 16)); bm = fmaxf(bm, lane_get(bm, (tl_ & 63) ^ 32)); \
            const float mnew = fmaxf(mrun, bm); const float alpha = ex2(mrun - mnew); mrun = mnew; \
            float ps = 0.f; u32x4 pa[2]; \
            _Pragma("unroll") for (int t = 0; t < 4; ++t) { float pv[4]; \
                _Pragma("unroll") for (int e = 0; e < 4; ++e) { pv[e] = ex2(st[t][e] - mnew); ps += pv[e]; } \
                pa[t >> 1][2 * (t & 1)] = pk2(pv[0], pv[1]); pa[t >> 1][2 * (t & 1) + 1] = pk2(pv[2], pv[3]); } \
            lrun = lrun * alpha + ps; \
            { float ar[4]; _Pragma("unroll") for (int e = 0; e < 4; ++e) ar[e] = lane_get(alpha, 4 * g4 + e); \
              _Pragma("unroll") for (int dt = 0; dt < 4; ++dt) _Pragma("unroll") for (int e = 0; e < 4; ++e) o[dt][e] *= ar[e]; }
#define NA_BLOCK_WIN(kf, vf, BLK) do { f32x4 st[4]; \
            _Pragma("unroll") for (int t = 0; t < 4; ++t) { const int rr = start + 2 * (BLK) + (t >> 1), kc0 = cc0 + 16 * (t & 1); \
                f32x4 a = (f32x4){0.f, 0.f, 0.f, 0.f}; a = MFMA16(kf[t][0], qf[0], a); a = MFMA16(kf[t][1], qf[1], a); \
                const LAS float* bp = RP + (rr - r + 7) * 31 + (kc0 + 4 * g4 - qc + 15); \
                _Pragma("unroll") for (int e = 0; e < 4; ++e) { const bool ok = (unsigned)(kc0 + 4 * g4 + e - cs) < 16u; a[e] = ok ? a[e] + bp[e] : -1e30f; }     \
                st[t] = a; } \
            NA_SOFTMAX() \
            _Pragma("unroll") for (int pr = 0; pr < 2; ++pr) _Pragma("unroll") for (int dt = 0; dt < 4; ++dt) { \
                const u32x4 vb = (u32x4){vf[pr][dt][0].x, vf[pr][dt][0].y, vf[pr][dt][1].x, vf[pr][dt][1].y}; \
                o[dt] = MFMA16(__builtin_bit_cast(bf16x8, pa[pr]), __builtin_bit_cast(bf16x8, vb), o[dt]); } } while (0)
#define NA_BLOCK_CTX(BLK) do { f32x4 st[4]; \
            _Pragma("unroll") for (int t = 0; t < 4; ++t) { const LAS unsigned char* kp = CK + (64 * (BLK) + 16 * t) * CK_STRIDE + cko; \
                f32x4 a = (f32x4){0.f, 0.f, 0.f, 0.f}; a = MFMA16(*(const LAS bf16x8*)kp, qf[0], a); a = MFMA16(*(const LAS bf16x8*)(kp + 64), qf[1], a); st[t] = a; } \
            NA_SOFTMAX() \
            _Pragma("unroll") for (int pr = 0; pr < 2; ++pr) _Pragma("unroll") for (int dt = 0; dt < 4; ++dt) { const LAS unsigned char* vrow = CV + (16 * dt) * CV_STRIDE + (64 * (BLK) + 32 * pr) * 2 + cvo; \
                const u32x2 lo = *(const LAS u32x2*)vrow, hi = *(const LAS u32x2*)(vrow + 32); const u32x4 vb = (u32x4){lo.x, lo.y, hi.x, hi.y}; \
                o[dt] = MFMA16(__builtin_bit_cast(bf16x8, pa[pr]), __builtin_bit_cast(bf16x8, vb), o[dt]); } } while (0)
#define NA_FINISH(tq_) do { lrun += lane_get(lrun, (tl_ & 63) ^ 16); lrun += lane_get(lrun, (tl_ & 63) ^ 32); \
            _Pragma("unroll") for (int e = 0; e < 4; ++e) { const float inv = 1.f / lane_get(lrun, 4 * g4 + e); \
                _Pragma("unroll") for (int dt = 0; dt < 4; ++dt) O[(cbase + (tq_) + 4 * g4 + e) * 1024 + h * 64 + 16 * dt + l15] = (bf16)f2bf(o[dt][e] * inv); } } while (0)
        {
            const int r0_ = F.wave >> 2, qb0_ = F.wave & 3;
            NA_LOADQ(qn, CTXL + r0_ * 64 + 16 * qb0_); NA_LOADK(kfa, NA_START(r0_), NA_CC0(qb0_), 0); NA_LOADV(vfa, NA_START(r0_), NA_CC0(qb0_), 0);
        }
#pragma unroll 1
        for (int i = 0; i < 16; ++i) {
            const int uu = F.wave + 8 * i; const int r = uu >> 2, qb = uu & 3; const int Rq = CTXL + r * 64 + 16 * qb;
            const int start = NA_START(r), cc0 = NA_CC0(qb);
            const int qc = 16 * qb + l15; const int cs = qc - 8 < 0 ? 0 : (qc - 8 > 48 ? 48 : qc - 8);
            qf[0] = qn[0]; qf[1] = qn[1];
            int cko = l15 * CK_STRIDE + 16 * g4, cvo = l15 * CV_STRIDE + 8 * g4; asm volatile("" : "+v"(cko), "+v"(cvo));
            float mrun = -1e30f, lrun = 0.f;
            f32x4 o[4];
#pragma unroll
            for (int dt = 0; dt < 4; ++dt) o[dt] = (f32x4){0.f, 0.f, 0.f, 0.f};
            NA_LOADK(kfb, start, cc0, 1); __builtin_amdgcn_sched_barrier(0);
            NA_BLOCK_WIN(kfa, vfa, 0); __builtin_amdgcn_sched_barrier(0);
            NA_LOADV(vfa, start, cc0, 1); NA_LOADK(kfa, start, cc0, 2); __builtin_amdgcn_sched_barrier(0);
            NA_BLOCK_WIN(kfb, vfa, 1); __builtin_amdgcn_sched_barrier(0);
            NA_LOADV(vfa, start, cc0, 2); NA_LOADK(kfb, start, cc0, 3); __builtin_amdgcn_sched_barrier(0);
            NA_BLOCK_WIN(kfa, vfa, 2); __builtin_amdgcn_sched_barrier(0);
            NA_LOADV(vfa, start, cc0, 3); __builtin_amdgcn_sched_barrier(0);
            {
                const int un = uu + 8; const int rn = un >> 2, qbn = un & 3;
                if (i < 15) { NA_LOADQ(qn, CTXL + rn * 64 + 16 * qbn); NA_LOADK(kfa, NA_START(rn), NA_CC0(qbn), 0); }
                else NA_LOADQ(qn, 16 * (un - 128));
            }
            __builtin_amdgcn_sched_barrier(0);
            NA_BLOCK_WIN(kfb, vfa, 3); __builtin_amdgcn_sched_barrier(0);
            if (i < 15) { const int un = uu + 8; NA_LOADV(vfa, NA_START(un >> 2), NA_CC0(un & 3), 0); }
            __builtin_amdgcn_sched_barrier(0);
            NA_BLOCK_CTX(0); __builtin_amdgcn_sched_barrier(0); NA_BLOCK_CTX(1); __builtin_amdgcn_sched_barrier(0); NA_BLOCK_CTX(2); __builtin_amdgcn_sched_barrier(0); NA_BLOCK_CTX(3); __builtin_amdgcn_sched_barrier(0);
            NA_FINISH(Rq);
        }
#pragma unroll 1
        for (int i = 16; i < 18; ++i) {
            const int uu = F.wave + 8 * i; const int Rq = 16 * (uu - 128);
            qf[0] = qn[0]; qf[1] = qn[1];
            if (i == 16) NA_LOADQ(qn, 16 * (uu + 8 - 128));
            int cko = l15 * CK_STRIDE + 16 * g4, cvo = l15 * CV_STRIDE + 8 * g4; asm volatile("" : "+v"(cko), "+v"(cvo));
            float mrun = -1e30f, lrun = 0.f;
            f32x4 o[4];
#pragma unroll
            for (int dt = 0; dt < 4; ++dt) o[dt] = (f32x4){0.f, 0.f, 0.f, 0.f};
            NA_BLOCK_CTX(0); __builtin_amdgcn_sched_barrier(0); NA_BLOCK_CTX(1); __builtin_amdgcn_sched_barrier(0); NA_BLOCK_CTX(2); __builtin_amdgcn_sched_barrier(0); NA_BLOCK_CTX(3); __builtin_amdgcn_sched_barrier(0);
            NA_FINISH(Rq);
        }
#undef NA_CC0
#undef NA_START
#undef NA_TK
#undef NA_LOADQ
#undef NA_LOADK
#undef NA_LOADV
#undef NA_SOFTMAX
#undef NA_BLOCK_WIN
#undef NA_BLOCK_CTX
#undef NA_FINISH
        __syncthreads();
    }
}

__device__ __forceinline__ void final_norm_phase(const Frame& F0, const bf16* xfin, float* out, const float* gain) {
    const Frame F = refresh(F0);
    for (int row = F.gw; row < NBATCH * SEQ; row += F.NGW) {
        const bf16* src = xfin + (size_t)row * D; float* dst = out + (size_t)row * D;
        f32x4 v[4]; float ss = 0.f;
#pragma unroll
        for (int j = 0; j < 4; ++j) { const u32x2 w = *(const u32x2*)(src + 4 * F.lane + 256 * j); v[j] = (f32x4){bflo(w.x), bfhi(w.x), bflo(w.y), bfhi(w.y)};
            ss += (v[j].x * v[j].x + v[j].y * v[j].y) + (v[j].z * v[j].z + v[j].w * v[j].w); }
        const float rstd = 1.f / sqrtf(wave_sum(ss, F.lane) * (1.f / D) + EPS);
#pragma unroll
        for (int j = 0; j < 4; ++j) { const int c = 4 * F.lane + 256 * j; const f32x4 gn = *(const f32x4*)(gain + c); *(f32x4*)(dst + c) = (v[j] * rstd) * gn; }
    }
}

__device__ __forceinline__ void dbg_check_ffn(const Frame& F0, const float* up, const float* cw, const float* cb) {
    const Frame F = refresh(F0);
    if (F.vcu != 0 || F.tid >= 1) return;
    const bf16* Hh = (const bf16*)(F.ws + WS_ACT + A_H); const bf16* ACT = (const bf16*)(F.ws + WS_ACT + A_ACT);
    const int row = 276, c = 5;
    float u[2][5];
    for (int half = 0; half < 2; ++half) for (int k = 0; k < 5; ++k) {
        const int rr = row + (k == 0 ? -16 : (k == 4 ? 16 : k - 2)); const int col = half * FFN + c;
        float d = 0.f; for (int q = 0; q < 1024; ++q) d += bf2f(Hh[(size_t)rr * 1024 + q]) * up[(size_t)q * FFN2 + col]; u[half][k] = d; }
    const float got = bf2f(ACT[(size_t)row * FFN + c]);
    unsigned code = 9;
    for (int hyp = 8; hyp >= 1; --hyp) {
        float uv2[2];
        for (int half = 0; half < 2; ++half) { const int col = half * FFN + c; const float w0 = cw[col], w1 = cw[FFN2 + col], w2 = cw[2 * FFN2 + col], b = cb[col];
            float pv = u[half][1], cv = u[half][2], nv = u[half][3];
            if (hyp == 2) { pv = u[half][3]; nv = u[half][1]; }
            if (hyp == 3) { pv = 0.f; nv = 0.f; }
            if (hyp == 4) { pv = u[half][0]; nv = u[half][4]; }
            if (hyp == 5) { pv = u[half][4]; nv = u[half][0]; }
            if (hyp == 6) { pv = 0.f; }
            if (hyp == 7) { nv = 0.f; }
            if (hyp == 8) { pv = cv; nv = cv; }
            uv2[half] = b + w0 * pv + w1 * cv + w2 * nv; }
        const float ref = silu_f(uv2[0]) * uv2[1];
        if (fabsf(ref - got) <= 0.03f + 0.03f * fabsf(ref)) code = hyp;
    }
    atomicMin((unsigned*)(F.ws + WS_CTL) + CW_DBG, code);
}

__global__ void __launch_bounds__(NTHR, 2) mega_fwd(Args a) {
    extern __shared__ __attribute__((aligned(16))) unsigned char lds_raw[];
    Frame F;
    F.lds = (LAS unsigned char*)lds_raw;
    F.tid = threadIdx.x; F.lane = F.tid & 63; F.wave = __builtin_amdgcn_readfirstlane(F.tid >> 6);
    F.G = gridDim.x; { const int bx = blockIdx.x; F.vcu = (F.G % 8 == 0) ? (bx % 8) * (F.G / 8) + bx / 8 : bx; }
    F.gw = F.vcu * NWAVES + F.wave; F.NGW = F.G * NWAVES; F.ws = AWS;
    volatile LAS unsigned* MISC = (volatile LAS unsigned*)(F.lds + MISC_OFF);
    for (int u = F.tid; u < (LDS_BYTES - MISC_OFF) / 4; u += NTHR) ((LAS unsigned*)(F.lds + MISC_OFF))[u] = 0u;
    __syncthreads();
    unsigned* ctl = (unsigned*)(AWS + WS_CTL);
    XcdBarrier bar = xcd_barrier_post(ctl + CW_BAR, MISC + 8);
    (void)bar;
#define GRID_BAR() do { XcdBarrier b_; b_.bar = (unsigned*)(AWS + WS_CTL) + CW_BAR; unsigned x_ = xb_xcc_id(); asm volatile("" : "+s"(x_)); b_.x = x_; \
        b_.st = (volatile LAS unsigned*)(F.lds + MISC_OFF) + 8; b_.t0 = (F.wave == 0) && (lane_id() == 0); xcd_barrier(b_); } while (0)
#define MOD ((const float*)(AWS + WS_MOD))
#define XS ((bf16*)AOUT)
#define CS ((bf16*)(AWS + WS_CTX))
#define XFIN ((bf16*)(AWS + WS_ACT + A_H))
#define Wb ((bf16*)(AWS + WS_W))
#define H ((bf16*)(AWS + WS_ACT + A_H))
    const int bx = (int)blockIdx.x;

    if (DBG && blockIdx.x == 0 && threadIdx.x == 0) __hip_atomic_store((unsigned*)(AWS + WS_CTL) + CW_DBG, 0xffffffffu, RLX_AGENT);
    if (EN(1)) prologue(F); if (DUP & (1 << 1)) { GRID_BAR(); prologue(F); }
    GRID_BAR();

#define GEMM_BF16(Aptr, Btptr, M_, N_, K_, Optr, ldc_) do { pg8::Gemm gg{(const bf16*)(Aptr), (const bf16*)(Btptr), (M_), (N_), (K_)}; pg8::StaticOrder So; So.init((M_), (N_), F.G, bx); \
        pg8::EpiBf16 Ee{(bf16*)(Optr), (ldc_)}; pg8::gemm_phase<pg8::EpiBf16, pg8::StaticOrder, true>(F.lds, gg, So, Ee, F.wave); } while (0)
#define STATP ((float*)(AWS + WS_STAT))
#define TBP ((const float*)(AWS + WS_T))
#define GEMM_BF16N(SW, Aptr, Btptr, M_, N_, K_, Optr, ldc_, tile0_, Toff_, ldt_) do { pg8::Gemm gg{(const bf16*)(Aptr), (const bf16*)(Btptr), (M_), (N_), (K_)}; pg8::StaticOrder So; So.init((M_), (N_), F.G, bx); \
        pg8::EpiBf16N<SW> Ee{(bf16*)(Optr), (ldc_), STATP, TBP + (Toff_), (ldt_), F.lds + NSLOT_OFF, (tile0_)}; pg8::gemm_phase<pg8::EpiBf16N<SW>, pg8::StaticOrder, true>(F.lds, gg, So, Ee, F.wave); } while (0)
#define GEMM_RESID(Aptr, Btptr, M_, K_, sx, sc, f32s_, dx_, layer, goff_, b0_, NL_, NF_) do { pg8::Gemm gg{(const bf16*)(Aptr), (const bf16*)(Btptr), (M_), D, (K_)}; pg8::StaticOrder So; So.init((M_), D, F.G, bx, (layer) == 3 ? 1 : 0); \
        pg8::EpiResid Ee{(sx), (sc), (dx_), CS, MOD + (size_t)(layer) * 33 * NMOD, (goff_), (b0_), (f32s_), \
            (NF_) < 0 ? (bf16*)nullptr : H, ((NF_) == 0 && (NL_) == 3) ? HALT - (size_t)TG * D : H, ((NF_) > 0 ? AIN(I_NFFN) : AIN(I_NMIX)) + (NL_) * D, MOD + (size_t)(NL_) * 33 * NMOD, (NF_) > 0 ? 4 * D : D, STATP, F.lds + 131072}; \
        pg8::gemm_phase<pg8::EpiResid, pg8::StaticOrder, true>(F.lds, gg, So, Ee, F.wave); } while (0)
#define FFN_BLOCK(layer) do { \
        { bf16* Wup = Wb + (W_FFN + (size_t)(layer) * (16 * MiB + 512 * 1024)) / 2; bf16* Wdn = Wup + (11 * MiB) / 2; \
          for (int rep_ = 0; rep_ < ((DUP & (1 << 15)) ? 2 : 1); ++rep_) { if (rep_) GRID_BAR(); if (EN(3)) { pg8::Gemm gg{H, Wup, NBATCH * PT, FFN2, D}; pg8::StaticOrder So; So.init(NBATCH * PT, FFN2, F.G, bx, (layer) == 3 ? 1 : 0); \
              pg8::EpiConvGate Ee{(bf16*)(AWS + WS_ACT + A_ACT), (bf16*)(AWS + WS_ACT + A_EDGE), AIN(I_FCW) + (size_t)(layer) * 3 * FFN2, AIN(I_FCB) + (size_t)(layer) * FFN2, F.lds + 131072, F.lds + MISC_OFF + 512, STATP, TBP + TB_FFN + (size_t)(layer) * TB_FFN_SZ, F.lds + NSLOT_OFF}; \
              pg8::gemm_phase<pg8::EpiConvGate, pg8::StaticOrder, true>(F.lds, gg, So, Ee, F.wave); } } GRID_BAR(); \
          if (EN(4)) ffn_fix_phase(F, AIN(I_FCW) + (size_t)(layer) * 3 * FFN2, AIN(I_FCB) + (size_t)(layer) * FFN2); GRID_BAR(); \
          if (DBG && (layer) == 0) { dbg_check_ffn(F, AIN(I_UP), AIN(I_FCW), AIN(I_FCB)); GRID_BAR(); } \
          if (EN(5)) GEMM_RESID(AWS + WS_ACT + A_ACT, Wdn, NBATCH * PT, FFN, XS, CS, 0, (layer) == 3 ? XFIN : XS, (layer), 5 * D, 0, (layer) + 1, (layer) < 3 ? 0 : -1); GRID_BAR(); } } while (0)
#define HALT (XS + (size_t)NBATCH * SEQ * D)
#define RET_MIXER(layer, j, sx, sc, f32s_, DN_) do { \
        if (!(DN_)) { if (EN(2)) norm_phase(F, g * NB, TG, (sx), (sc), (f32s_), AIN(I_NMIX) + (layer) * D, MOD + (size_t)(layer) * 33 * NMOD, 0, D); GRID_BAR(); } \
        { bf16* Wa = Wb + (W_RET + (size_t)(j) * 18 * MiB) / 2; bf16* Wbb = Wa + (8 * MiB) / 2; const bf16* Hg = ((DN_) && g == 1) ? HALT : H; \
          if (EN(3)) { pg8::Gemm gg{Hg, Wa, TG, 4096, D}; pg8::StaticOrder So; So.init(TG, 4096, F.G, bx); pg8::EpiRopeQ<DN_> Ee{(bf16*)(AWS + WS_ACT + A_QKG), (const float*)(AWS + WS_ROPE), STATP, TBP + TB_RETA, F.lds + NSLOT_OFF, g * 144}; \
              pg8::gemm_phase<pg8::EpiRopeQ<DN_>, pg8::StaticOrder, true>(F.lds, gg, So, Ee, F.wave); } \
          if (EN(3)) { pg8::Gemm gg{Wbb, Hg, 3072, TG, D}; pg8::StaticOrder So; So.init(3072, TG, F.G, bx); pg8::EpiRopeKT<DN_> Ee{(bf16*)(AWS + WS_ACT + A_KVT), (const float*)(AWS + WS_ROPE), TG, STATP, TBP + TB_RETB, F.lds + NSLOT_OFF, g * 144}; \
              pg8::gemm_phase<pg8::EpiRopeKT<DN_>, pg8::StaticOrder, true>(F.lds, gg, So, Ee, F.wave); } GRID_BAR(); \
          if (EN(7)) ret_scan_phase(F, AIN(I_RDEC) + (j) * 8, (size_t)g * 144 * MiB); GRID_BAR(); \
          if (EN(8)) ret_gn_phase(F, AIN(I_RGN) + (j) * 2048, (size_t)g * 144 * MiB); GRID_BAR(); } } while (0)
#define RET_OUT(layer, j, sx, sc, f32s_) do { bf16* Wo = Wb + (W_RET + (size_t)(j) * 18 * MiB + 14 * MiB) / 2; \
        if (EN(5)) GEMM_RESID(AWS + WS_ACT + A_Y, Wo, NBATCH * PT, 2048, (sx), (sc), (f32s_), XS, (layer), 2 * D, 0, (layer), 1); GRID_BAR(); } while (0)

    if (EN(2)) t_phase(F);
    for (int g = 0; g < NG; ++g) RET_MIXER(0, 0, AIN(I_X), AIN(I_CTX), 1, false);
    RET_OUT(0, 0, AIN(I_X), AIN(I_CTX), 1);
    FFN_BLOCK(0);
    for (int g = 0; g < NG; ++g) {
        if (EN(3)) GEMM_BF16N(false, H + (size_t)g * TG * D, Wb + W_LRU_IN / 2, TG, 2560, D, AWS + WS_ACT + A_YX, 2560, g * 144, TB_LRU, 2560); GRID_BAR();
        if (EN(10)) lru_gate_phase(F, AIN(I_LCW), AIN(I_LCB), AIN(I_LGB), AIN(I_LLAM)); GRID_BAR();
        if (EN(11)) lru_scan_phase(F, (size_t)g * 90 * MiB); GRID_BAR();
    }
    if (EN(5)) GEMM_RESID(AWS + WS_ACT + A_A3, Wb + W_LRU_OUT / 2, NBATCH * PT, LW, XS, CS, 0, XS, 1, 2 * D, 0, 1, 1); GRID_BAR();
    FFN_BLOCK(1);
    for (int g = 0; g < NG; ++g) {
        if (EN(3)) GEMM_BF16N(false, H + (size_t)g * TG * D, Wb + W_NA_QK / 2, TG, 2048, D, AWS + WS_ACT + A_QK, 2048, g * 144, TB_NAQK, 2048);
        if (EN(3)) GEMM_BF16N(true, Wb + W_NA_V / 2, H + (size_t)g * TG * D, 1024, TG, D, AWS + WS_ACT + A_VT, TG, g * 144, TB_NAV, 1024); GRID_BAR();
        if (EN(13)) na_attn_phase(F, AIN(I_NRPB), (size_t)g * 72 * MiB); GRID_BAR();
    }
    if (EN(5)) GEMM_RESID(AWS + WS_ACT + A_O, Wb + W_NA_O / 2, NBATCH * PT, D, XS, CS, 0, XS, 2, 2 * D, 0, 2, 1); GRID_BAR();
    FFN_BLOCK(2);
    for (int g = 0; g < NG; ++g) RET_MIXER(3, 1, XS, CS, 0, true);
    RET_OUT(3, 1, XS, CS, 0);
    FFN_BLOCK(3);
    if (EN(14)) final_norm_phase(F, XFIN, AOUT, AIN(I_FNORM));
    if (DBG) { GRID_BAR(); const unsigned code = __hip_atomic_load((unsigned*)(AWS + WS_CTL) + CW_DBG, RLX_AGENT);
        if (code != 0xffffffffu) { float* o = AOUT; for (size_t i = (size_t)blockIdx.x * NTHR + threadIdx.x; i < (size_t)NBATCH * SEQ * D; i += (size_t)gridDim.x * NTHR) o[i] = 1000.f * (float)code; } }
}

extern "C" void kernel_launch(void* const* d_in, const int* in_sizes, int n_in, void* d_out, int out_size, void* d_ws, size_t ws_size, hipStream_t stream) {
    static int grid = 0;
    if (grid == 0) {
        if (n_in != 27 || ws_size < WS_END) { fprintf(stderr, "kernel_launch: need 27 inputs and >= %zu bytes of workspace; got %d, %zu\n", (size_t)WS_END, n_in, ws_size); grid = -1; return; }
        int dev = 0, cus = 0, per_cu = 0;
        if (hipGetDevice(&dev) != hipSuccess || hipDeviceGetAttribute(&cus, hipDeviceAttributeMultiprocessorCount, dev) != hipSuccess) { grid = -1; return; }
        if (hipFuncSetAttribute((const void*)mega_fwd, hipFuncAttributeMaxDynamicSharedMemorySize, LDS_BYTES) != hipSuccess) { fprintf(stderr, "kernel_launch: hipFuncSetAttribute failed\n"); grid = -1; return; }
        if (hipOccupancyMaxActiveBlocksPerMultiprocessor(&per_cu, (const void*)mega_fwd, NTHR, LDS_BYTES) != hipSuccess || per_cu < 1) { fprintf(stderr, "kernel_launch: occupancy query says %d\n", per_cu); }
        (void)hipGetLastError();
        grid = cus;
    }
    if (grid < 0) return;
    (void)hipMemsetAsync((char*)d_ws + WS_CTL, 0, CTL_ZERO_BYTES, stream);
    Args a{};
    for (int i = 0; i < 27; ++i) a.in[i] = (const float*)d_in[i];
    a.out = (float*)d_out; a.ws = (unsigned char*)d_ws;
    hipLaunchKernelGGL(mega_fwd, dim3(grid), dim3(NTHR), LDS_BYTES, stream, a);
}
```
